# Optimizing an MI355X kernel written in HIP

```python
import jax, jax.numpy as jnp
from jax import lax
import numpy as np

D_MODEL = 1024
BATCH = 16
SEQ = 256
DEPTH = 4
DEC_BATCH = 4
DEC_SEQ = 4096
PAST_LEN = 256

GRID_W = 64
HEAD_DIM = 64
GLA_HEADS = 4
GLA_DK = 64
GLA_DV = 64
GLA_GATE_RANK = 16
GLA_TAU = 16.0
GLA_CHUNK = 64
SWA_Q_HEADS = 4
SWA_KV_HEADS = 2
SWA_REP = SWA_Q_HEADS // SWA_KV_HEADS
SWA_WINDOW = 128
SWA_BLOCK = 128
FNET_GROUPS = 4
FNET_GROUP_CH = 64
MLA_HEADS = 4
MLA_Q_RANK = 256
MLA_KV_RANK = 128
MLA_NOPE = 64
MLA_ROPE = 32
MLA_V = 64
D_FF = 2816
FFN_RES = 0.5
N_MOD = 9
ROPE_BASE = 10000.0
EPS = 1e-6
Q_BLOCK = 128
NEG_INF = -1e30

IN_SIZES = (
    GLA_HEADS * GLA_DK, GLA_HEADS * GLA_DK, GLA_HEADS * GLA_DV, GLA_HEADS * GLA_DV,
    GLA_GATE_RANK, GLA_GATE_RANK,
    SWA_Q_HEADS * HEAD_DIM, SWA_KV_HEADS * HEAD_DIM, SWA_KV_HEADS * HEAD_DIM,
    FNET_GROUPS * FNET_GROUP_CH,
    MLA_Q_RANK, MLA_KV_RANK, MLA_ROPE,
)
D_IN = sum(IN_SIZES)
MIX_WIDTH = GLA_HEADS * GLA_DV + SWA_Q_HEADS * HEAD_DIM + FNET_GROUPS * FNET_GROUP_CH + MLA_HEADS * MLA_V

kernel_name = "hybrid_flow_trunk_step"


def _rmsnorm(x, g):
    xf = x.astype(jnp.float32)
    y = xf * lax.rsqrt(jnp.mean(xf * xf, axis=-1, keepdims=True) + EPS)
    return (y * g.astype(jnp.float32)).astype(x.dtype)


def _split_cols(z):
    offs = np.cumsum(IN_SIZES)[:-1].tolist()
    return jnp.split(z, offs, axis=-1)


def _split_heads(z, n_heads):
    b, s, _ = z.shape
    return z.reshape(b, s, n_heads, -1).transpose(0, 2, 1, 3)


def _merge_heads(z):
    b, h, s, d = z.shape
    return z.transpose(0, 2, 1, 3).reshape(b, s, h * d)


def _rope_1d(x, pos):
    dim = x.shape[-1]
    inv = ROPE_BASE ** (-jnp.arange(0, dim, 2, dtype=jnp.float32) / dim)
    ang = pos[:, None] * inv[None, :]
    cos, sin = jnp.cos(ang), jnp.sin(ang)
    x1, x2 = jnp.split(x.astype(jnp.float32), 2, axis=-1)
    return jnp.concatenate([x1 * cos - x2 * sin, x2 * cos + x1 * sin], axis=-1).astype(x.dtype)


def _rope_axial(x):
    t = jnp.arange(x.shape[-2])
    rows = (t // GRID_W).astype(jnp.float32)
    cols = (t % GRID_W).astype(jnp.float32)
    half = x.shape[-1] // 2
    return jnp.concatenate([_rope_1d(x[..., :half], rows), _rope_1d(x[..., half:], cols)], axis=-1)


def _softmax_with_sink(s, sink):
    if sink is None:
        return jax.nn.softmax(s, axis=-1)
    sk = sink.astype(jnp.float32).reshape(sink.shape + (1,) * (s.ndim - 3))[None]
    m = jnp.maximum(jnp.max(s, axis=-1, keepdims=True), sk)
    e = jnp.exp(s - m)
    return e / (jnp.sum(e, axis=-1, keepdims=True) + jnp.exp(sk - m))


def _dense_attention(q, k, v, sink=None):
    b, g, r, sq, d = q.shape
    nq = sq // Q_BLOCK
    scale = d ** -0.5
    qb = jnp.moveaxis(q.reshape(b, g, r, nq, Q_BLOCK, d), 3, 0)

    def one_block(qblk):
        s = jnp.einsum("bgrqd,bgkd->bgrqk", qblk, k).astype(jnp.float32) * scale
        p = _softmax_with_sink(s, sink)
        return jnp.einsum("bgrqk,bgkd->bgrqd", p.astype(v.dtype), v)

    o = lax.map(one_block, qb)
    return jnp.moveaxis(o, 0, 3).reshape(b, g, r, sq, v.shape[-1])


def _window_attention(q, k, v, k_ctx, v_ctx, sink):
    b, g, r, s, d = q.shape
    nb = s // SWA_BLOCK
    kw_len = 3 * SWA_BLOCK

    def bands(t):
        tb = jnp.pad(t, ((0, 0), (0, 0), (SWA_BLOCK, SWA_BLOCK), (0, 0))).reshape(b, g, nb + 2, SWA_BLOCK, t.shape[-1])
        return jnp.concatenate([tb[:, :, :-2], tb[:, :, 1:-1], tb[:, :, 2:]], axis=3)

    kw, vw = bands(k), bands(v)
    qb = q.reshape(b, g, r, nb, SWA_BLOCK, d)
    scale = d ** -0.5
    s_loc = jnp.einsum("bgrnqd,bgnkd->bgrnqk", qb, kw).astype(jnp.float32) * scale
    s_ctx = jnp.einsum("bgrnqd,bgcd->bgrnqc", qb, k_ctx).astype(jnp.float32) * scale
    qpos = jnp.arange(nb)[:, None, None] * SWA_BLOCK + jnp.arange(SWA_BLOCK)[None, :, None]
    kpos = jnp.arange(nb)[:, None, None] * SWA_BLOCK - SWA_BLOCK + jnp.arange(kw_len)[None, None, :]
    valid = (jnp.abs(qpos - kpos) <= SWA_WINDOW) & (kpos >= 0) & (kpos < s)
    s_loc = jnp.where(valid, s_loc, NEG_INF)
    p = _softmax_with_sink(jnp.concatenate([s_loc, s_ctx], axis=-1), sink).astype(v.dtype)
    o = (jnp.einsum("bgrnqk,bgnkd->bgrnqd", p[..., :kw_len], vw)
         + jnp.einsum("bgrnqc,bgcd->bgrnqd", p[..., kw_len:], v_ctx))
    return o.reshape(b, g, r, s, d)


def _gla_scan(q, k, v, log_a, s0):
    b, h, s, _ = q.shape
    dv = v.shape[-1]
    n = s // GLA_CHUNK

    def chunks(t):
        return jnp.moveaxis(t.astype(jnp.float32).reshape(b, h, n, GLA_CHUNK, t.shape[-1]), 2, 0)

    causal = jnp.tril(jnp.ones((GLA_CHUNK, GLA_CHUNK), dtype=bool))

    def step(state, inp):
        qc, kc, vc, ac = inp
        cum = jnp.cumsum(ac, axis=-2)
        last = cum[..., -1:, :]
        q_dec = qc * jnp.exp(cum)
        k_inv = kc * jnp.exp(-cum)
        att = jnp.where(causal, jnp.einsum("bhid,bhjd->bhij", q_dec, k_inv), 0.0)
        o = jnp.einsum("bhij,bhjv->bhiv", att, vc) + jnp.einsum("bhid,bhdv->bhiv", q_dec, state)
        state = (jnp.exp(last)[..., 0, :, None] * state
                 + jnp.einsum("bhjd,bhjv->bhdv", kc * jnp.exp(last - cum), vc))
        return state, o

    state, o = lax.scan(step, s0.astype(jnp.float32), (chunks(q), chunks(k), chunks(v), chunks(log_a)))
    return jnp.moveaxis(o, 0, 2).reshape(b, h, s, dv), state


def _gla_mixer(q, k, v, r, a_f, a_b, lp, s0_f, s0_b):
    qh = _split_heads(q, GLA_HEADS) * (GLA_DK ** -0.5)
    kh = _split_heads(k, GLA_HEADS)
    vh = _split_heads(v, GLA_HEADS)

    def log_decay(a, i):
        logit = (a @ lp["gla_w_gate"][i] + lp["gla_b_gate"][i]).astype(jnp.float32)
        return _split_heads(jax.nn.log_sigmoid(logit) / GLA_TAU, GLA_HEADS)

    def flip(t):
        return jnp.flip(t, axis=2)

    o_f, st_f = _gla_scan(qh, kh, vh, log_decay(a_f, 0), s0_f)
    o_b, st_b = _gla_scan(flip(qh), flip(kh), flip(vh), flip(log_decay(a_b, 1)), s0_b)
    o = _rmsnorm(o_f + flip(o_b), lp["gla_g_out"]).astype(r.dtype)
    return _merge_heads(o) * jax.nn.silu(r), st_f, st_b


def _fourier_mix(z):
    b, s, _ = z.shape
    zg = z.astype(jnp.float32).reshape(b, s, FNET_GROUPS, FNET_GROUP_CH)
    y = jnp.fft.fft2(zg, axes=(1, 3), norm="ortho").real
    return y.reshape(b, s, FNET_GROUPS * FNET_GROUP_CH).astype(z.dtype)


def _mla_expand(c_kv, w_kv_b):
    b, s, _ = c_kv.shape
    kv = (c_kv @ w_kv_b).reshape(b, s, MLA_HEADS, MLA_NOPE + MLA_V).transpose(0, 2, 1, 3)
    return kv[..., :MLA_NOPE], kv[..., MLA_NOPE:]


def _token_mix(h, lp, ctx):
    b, s, _ = h.shape
    latent = ctx is not None
    (q_g, k_g, v_g, r_g, a_f, a_b, q_s, k_s, v_s, z_f, q_a, kv_a, k_r) = _split_cols(h @ lp["w_in"])

    if latent:
        s0_f, s0_b = ctx["gla"][:, 0], ctx["gla"][:, 1]
    else:
        s0_f = jnp.zeros((b, GLA_HEADS, GLA_DK, GLA_DV), jnp.float32)
        s0_b = s0_f
    o_gla, st_f, st_b = _gla_mixer(q_g, k_g, v_g, r_g, a_f, a_b, lp, s0_f, s0_b)

    qs = _split_heads(q_s, SWA_Q_HEADS)
    ks = _split_heads(k_s, SWA_KV_HEADS)
    vs = _split_heads(v_s, SWA_KV_HEADS)
    sink = lp["swa_sink"].reshape(SWA_KV_HEADS, SWA_REP)
    if latent:
        qs = _rope_axial(qs).reshape(b, SWA_KV_HEADS, SWA_REP, s, HEAD_DIM)
        o_swa = _window_attention(qs, _rope_axial(ks), vs, ctx["swa_k"], ctx["swa_v"], sink)
    else:
        o_swa = _dense_attention(qs.reshape(b, SWA_KV_HEADS, SWA_REP, s, HEAD_DIM), ks, vs, sink)
    o_swa = _merge_heads(o_swa.reshape(b, SWA_Q_HEADS, s, HEAD_DIM))

    o_fft = _fourier_mix(z_f)

    c_kv = _rmsnorm(kv_a, lp["mla_g_kv"])
    q_m = (_rmsnorm(q_a, lp["mla_g_q"]) @ lp["mla_w_q_b"]).reshape(b, s, MLA_HEADS, MLA_NOPE + MLA_ROPE).transpose(0, 2, 1, 3)
    k_nope, v_m = _mla_expand(c_kv, lp["mla_w_kv_b"])
    k_rope = k_r[:, None]
    if latent:
        q_m = jnp.concatenate([q_m[..., :MLA_NOPE], _rope_axial(q_m[..., MLA_NOPE:])], axis=-1)
        k_rope = _rope_axial(k_rope)
    k_m = jnp.concatenate([k_nope, jnp.broadcast_to(k_rope, (b, MLA_HEADS, s, MLA_ROPE))], axis=-1)
    if latent:
        c_len = ctx["mla_ckv"].shape[1]
        kc_nope, v_c = _mla_expand(ctx["mla_ckv"], lp["mla_w_kv_b"])
        k_c = jnp.concatenate([kc_nope, jnp.broadcast_to(ctx["mla_kr"][:, None], (b, MLA_HEADS, c_len, MLA_ROPE))], axis=-1)
        k_m = jnp.concatenate([k_c, k_m], axis=2)
        v_m = jnp.concatenate([v_c, v_m], axis=2)
    o_mla = _merge_heads(_dense_attention(q_m[:, :, None], k_m, v_m)[:, :, 0])

    out = jnp.concatenate([o_gla, o_swa, o_fft, o_mla], axis=-1) @ lp["w_out"]
    if latent:
        return out, None
    new_ctx = (jnp.stack([st_f, st_b], axis=1),
               k_s.reshape(b, s, SWA_KV_HEADS, HEAD_DIM),
               v_s.reshape(b, s, SWA_KV_HEADS, HEAD_DIM),
               c_kv, k_r)
    return out, new_ctx


def _swiglu(h, lp, i):
    return (jax.nn.silu(h @ lp["ffn_gate"][i]) * (h @ lp["ffn_up"][i])) @ lp["ffn_down"][i]


def _layer(x, mod, lp, ctx):
    sh1, sc1, gt1, sh2, sc2, gt2, sh3, sc3, gt3 = jnp.split(mod[:, None, :].astype(x.dtype), N_MOD, axis=-1)
    g = lp["g_norm"]
    h = _rmsnorm(x, g[0]) * (1 + sc1) + sh1
    x = x + FFN_RES * gt1 * _rmsnorm(_swiglu(h, lp, 0), g[1])
    h = _rmsnorm(x, g[2]) * (1 + sc2) + sh2
    o, new_ctx = _token_mix(h, lp, ctx)
    x = x + gt2 * _rmsnorm(o, g[3])
    h = _rmsnorm(x, g[4]) * (1 + sc3) + sh3
    x = x + FFN_RES * gt3 * _rmsnorm(_swiglu(h, lp, 1), g[5])
    return x, new_ctx


def setup_inputs(seed: int = 0) -> dict:
    key = jax.random.key(seed)
    ks = jax.random.split(key, 26)
    D = D_MODEL

    def nrm(k, shape, scale):
        return jax.random.normal(k, shape, jnp.float32) * scale

    return {
        "x_prompt": nrm(ks[0], (BATCH, SEQ, D), 1.0),
        "x_sample": nrm(ks[1], (DEC_BATCH, DEC_SEQ, D), 1.0),
        "c": nrm(ks[2], (DEC_BATCH, D), 1.0),
        "state_gla": nrm(ks[3], (DEC_BATCH, DEPTH, 2, GLA_HEADS, GLA_DK, GLA_DV), 1.0),
        "cache_swa_k": nrm(ks[4], (DEC_BATCH, DEPTH, PAST_LEN, SWA_KV_HEADS, HEAD_DIM), 1.0),
        "cache_swa_v": nrm(ks[5], (DEC_BATCH, DEPTH, PAST_LEN, SWA_KV_HEADS, HEAD_DIM), 1.0),
        "cache_mla_ckv": nrm(ks[6], (DEC_BATCH, DEPTH, PAST_LEN, MLA_KV_RANK), 1.0),
        "cache_mla_krope": nrm(ks[7], (DEC_BATCH, DEPTH, PAST_LEN, MLA_ROPE), 1.0),
        "c_ctx": nrm(ks[8], (D,), 1.0),
        "w_mod": nrm(ks[9], (DEPTH, D, N_MOD * D), 0.5 * D ** -0.5),
        "b_mod": nrm(ks[10], (DEPTH, N_MOD * D), 0.02),
        "g_norm": 1.0 + nrm(ks[11], (DEPTH, 6, D), 0.02),
        "w_ffn_gate": nrm(ks[12], (DEPTH, 2, D, D_FF), D ** -0.5),
        "w_ffn_up": nrm(ks[13], (DEPTH, 2, D, D_FF), D ** -0.5),
        "w_ffn_down": nrm(ks[14], (DEPTH, 2, D_FF, D), D_FF ** -0.5),
        "w_in": nrm(ks[15], (DEPTH, D, D_IN), D ** -0.5),
        "gla_w_gate": nrm(ks[16], (DEPTH, 2, GLA_GATE_RANK, GLA_HEADS * GLA_DK), GLA_GATE_RANK ** -0.5),
        "gla_b_gate": nrm(ks[17], (DEPTH, 2, GLA_HEADS * GLA_DK), 0.1),
        "gla_g_out": 1.0 + nrm(ks[18], (DEPTH, GLA_DV), 0.02),
        "swa_sink": nrm(ks[19], (DEPTH, SWA_Q_HEADS), 0.1),
        "mla_g_q": 1.0 + nrm(ks[20], (DEPTH, MLA_Q_RANK), 0.02),
        "mla_g_kv": 1.0 + nrm(ks[21], (DEPTH, MLA_KV_RANK), 0.02),
        "mla_w_q_b": nrm(ks[22], (DEPTH, MLA_Q_RANK, MLA_HEADS * (MLA_NOPE + MLA_ROPE)), MLA_Q_RANK ** -0.5),
        "mla_w_kv_b": nrm(ks[23], (DEPTH, MLA_KV_RANK, MLA_HEADS * (MLA_NOPE + MLA_V)), MLA_KV_RANK ** -0.5),
        "w_out": nrm(ks[24], (DEPTH, MIX_WIDTH, D), MIX_WIDTH ** -0.5),
    }


def reference(x_prompt, x_sample, c, state_gla, cache_swa_k, cache_swa_v, cache_mla_ckv, cache_mla_krope,
              c_ctx, w_mod, b_mod, g_norm, w_ffn_gate, w_ffn_up, w_ffn_down, w_in, gla_w_gate, gla_b_gate,
              gla_g_out, swa_sink, mla_g_q, mla_g_kv, mla_w_q_b, mla_w_kv_b, w_out):
    y_prompt, y_sample = x_prompt, x_sample
    st_gla, st_k, st_v, st_ckv, st_kr = [], [], [], [], []
    for l in range(DEPTH):
        lp = {
            "w_in": w_in[l], "w_out": w_out[l], "g_norm": g_norm[l],
            "ffn_gate": w_ffn_gate[l], "ffn_up": w_ffn_up[l], "ffn_down": w_ffn_down[l],
            "gla_w_gate": gla_w_gate[l], "gla_b_gate": gla_b_gate[l], "gla_g_out": gla_g_out[l],
            "swa_sink": swa_sink[l], "mla_g_q": mla_g_q[l], "mla_g_kv": mla_g_kv[l],
            "mla_w_q_b": mla_w_q_b[l], "mla_w_kv_b": mla_w_kv_b[l],
        }
        mod_ctx = jax.nn.silu(c_ctx)[None, :] @ w_mod[l] + b_mod[l]
        mod_lat = jax.nn.silu(c) @ w_mod[l] + b_mod[l]

        y_prompt, (g_st, k_c, v_c, ckv_c, kr_c) = _layer(y_prompt, mod_ctx, lp, None)
        st_gla.append(g_st)
        st_k.append(k_c)
        st_v.append(v_c)
        st_ckv.append(ckv_c)
        st_kr.append(kr_c)

        ctx = {
            "gla": state_gla[:, l],
            "swa_k": cache_swa_k[:, l].transpose(0, 2, 1, 3),
            "swa_v": cache_swa_v[:, l].transpose(0, 2, 1, 3),
            "mla_ckv": cache_mla_ckv[:, l],
            "mla_kr": cache_mla_krope[:, l],
        }
        y_sample, _ = _layer(y_sample, mod_lat, lp, ctx)

    return (y_prompt, y_sample, jnp.stack(st_gla, axis=1), jnp.stack(st_k, axis=1), jnp.stack(st_v, axis=1),
            jnp.stack(st_ckv, axis=1), jnp.stack(st_kr, axis=1))
```

```cpp
#include <hip/hip_runtime.h>
#include <hip/hip_cooperative_groups.h>
#include <cstdio>
#include <cstdint>
namespace cg = cooperative_groups;

#ifndef MULTI_LAUNCH
#define MULTI_LAUNCH 0
#endif

#define DI __device__ __forceinline__
typedef unsigned short bf16_t;
typedef short bf16x8 __attribute__((ext_vector_type(8)));
typedef short bf16x4 __attribute__((ext_vector_type(4)));
typedef float f32x16 __attribute__((ext_vector_type(16)));
typedef unsigned u32x4 __attribute__((ext_vector_type(4)));
typedef unsigned u32x2 __attribute__((ext_vector_type(2)));
#define MFMA32(a, b, c) __builtin_amdgcn_mfma_f32_32x32x16_bf16((a), (b), (c), 0, 0, 0)

constexpr int NT = 256, NW = NT / 64;
constexpr int DM = 1024, M_CTX = 4096, M_LAT = 16384, M_TOT = 20480, M_EXT = 21504;
constexpr int DFF = 2816, DIN = 2240;
constexpr float EPS = 1e-6f;
constexpr int SMEM_BYTES = 60 * 1024;
constexpr int PITCH = 72;
constexpr int ZQG = 0, ZKG = 256, ZVG = 512, ZRG = 768, ZAF = 1024, ZQS = 1056, ZKS = 1312, ZVS = 1440, ZF = 1568, ZQA = 1824, ZKVA = 2080, ZKR = 2208;
constexpr size_t O_YP = 0, O_YS = 4194304, O_ST = 20971520, O_SK = 23068672, O_SV = 25165824, O_CKV = 27262976, O_KR = 29360128;

struct Params {
  const float *x_prompt, *x_sample, *c, *state_gla, *cache_swa_k, *cache_swa_v, *cache_mla_ckv, *cache_mla_krope, *c_ctx,
      *w_mod, *b_mod, *g_norm, *w_gate, *w_up, *w_down, *w_in, *gla_w_gate, *gla_b_gate, *gla_g_out, *swa_sink, *mla_g_q,
      *mla_g_kv, *w_qb, *w_kvb, *w_out;
  float* out;
  float *X, *F, *MOD, *ROPE_S, *ROPE_M, *GLA_B, *GLA_DL;
  bf16_t *H, *TWL, *TWC, *WGU, *WD, *WIN, *WOUT, *WQB, *WKVB, *ACT, *Z, *QS, *KS, *VS, *CKV, *QLAT, *KR, *QM, *KV, *ABTL,
      *ABTC, *GLA_S, *MIX;
};

constexpr size_t al256(size_t x) { return (x + 255) & ~(size_t)255; }
constexpr size_t OFF_X = 0;
constexpr size_t OFF_H = OFF_X + al256((size_t)M_TOT * DM * 4);
constexpr size_t OFF_MOD = OFF_H + al256((size_t)M_TOT * DM * 2);
constexpr size_t OFF_ROPE_S = OFF_MOD + al256((size_t)4 * 5 * 9216 * 4);
constexpr size_t OFF_ROPE_M = OFF_ROPE_S + al256(64 * 16 * 2 * 4);
constexpr size_t OFF_TWL = OFF_ROPE_M + al256(64 * 8 * 2 * 4);
constexpr size_t OFF_TWC = OFF_TWL + al256((size_t)4096 * 8192 * 2);
constexpr size_t OFF_WGU = OFF_TWC + al256((size_t)256 * 512 * 2);
constexpr size_t OFF_WD = OFF_WGU + al256((size_t)2 * 5632 * 1024 * 2);
constexpr size_t OFF_WIN = OFF_WD + al256((size_t)2 * 1024 * DFF * 2);
constexpr size_t OFF_WOUT = OFF_WIN + al256((size_t)2304 * 1024 * 2);
constexpr size_t OFF_WQB = OFF_WOUT + al256((size_t)1024 * 1024 * 2);
constexpr size_t OFF_WKVB = OFF_WQB + al256((size_t)384 * 256 * 2);
constexpr size_t OFF_Z = OFF_WKVB + al256((size_t)512 * 128 * 2);
constexpr size_t OFF_QS = OFF_Z + al256((size_t)M_TOT * DIN * 2);
constexpr size_t OFF_KS = OFF_QS + al256((size_t)M_TOT * 256 * 2);
constexpr size_t OFF_VS = OFF_KS + al256((size_t)M_EXT * 128 * 2);
constexpr size_t OFF_CKV = OFF_VS + al256((size_t)M_EXT * 128 * 2);
constexpr size_t OFF_QLAT = OFF_CKV + al256((size_t)M_EXT * 128 * 2);
constexpr size_t OFF_KR = OFF_QLAT + al256((size_t)M_TOT * 256 * 2);
constexpr size_t OFF_QM = OFF_KR + al256((size_t)M_EXT * 32 * 2);
constexpr size_t OFF_KV = OFF_QM + al256((size_t)M_TOT * 384 * 2);
constexpr size_t OFF_ABTL = OFF_KV + al256((size_t)M_EXT * 512 * 2);
constexpr size_t OFF_ABTC = OFF_ABTL + al256((size_t)4 * 256 * 8192 * 2);
constexpr size_t OFF_GLA_B = OFF_ABTC + al256((size_t)16 * 256 * 512 * 2);
constexpr size_t OFF_GLA_DL = OFF_GLA_B + al256((size_t)2560 * 4096 * 4);
constexpr size_t OFF_GLA_S = OFF_GLA_DL + al256((size_t)2560 * 64 * 4);
constexpr size_t OFF_MIX = OFF_GLA_S + al256((size_t)2560 * 4096 * 2);
constexpr size_t OFF_END0 = OFF_MIX + al256((size_t)M_TOT * 1024 * 2);
constexpr size_t OFF_ACTEND = OFF_QS + al256((size_t)M_TOT * DFF * 2);
constexpr size_t WS_NEED = OFF_END0 > OFF_ACTEND ? OFF_END0 : OFF_ACTEND;
struct PArg { const float* in[25]; float* out; unsigned char* ws; };
DI Params make_params(const PArg& a) {
  Params p;
  p.x_prompt = a.in[0];
  p.x_sample = a.in[1];
  p.c = a.in[2];
  p.state_gla = a.in[3];
  p.cache_swa_k = a.in[4];
  p.cache_swa_v = a.in[5];
  p.cache_mla_ckv = a.in[6];
  p.cache_mla_krope = a.in[7];
  p.c_ctx = a.in[8];
  p.w_mod = a.in[9];
  p.b_mod = a.in[10];
  p.g_norm = a.in[11];
  p.w_gate = a.in[12];
  p.w_up = a.in[13];
  p.w_down = a.in[14];
  p.w_in = a.in[15];
  p.gla_w_gate = a.in[16];
  p.gla_b_gate = a.in[17];
  p.gla_g_out = a.in[18];
  p.swa_sink = a.in[19];
  p.mla_g_q = a.in[20];
  p.mla_g_kv = a.in[21];
  p.w_qb = a.in[22];
  p.w_kvb = a.in[23];
  p.w_out = a.in[24];
  p.out = a.out;
  p.X = (float*)(a.ws + OFF_X);
  p.H = (bf16_t*)(a.ws + OFF_H);
  p.MOD = (float*)(a.ws + OFF_MOD);
  p.ROPE_S = (float*)(a.ws + OFF_ROPE_S);
  p.ROPE_M = (float*)(a.ws + OFF_ROPE_M);
  p.TWL = (bf16_t*)(a.ws + OFF_TWL);
  p.TWC = (bf16_t*)(a.ws + OFF_TWC);
  p.WGU = (bf16_t*)(a.ws + OFF_WGU);
  p.WD = (bf16_t*)(a.ws + OFF_WD);
  p.WIN = (bf16_t*)(a.ws + OFF_WIN);
  p.WOUT = (bf16_t*)(a.ws + OFF_WOUT);
  p.WQB = (bf16_t*)(a.ws + OFF_WQB);
  p.WKVB = (bf16_t*)(a.ws + OFF_WKVB);
  p.Z = (bf16_t*)(a.ws + OFF_Z);
  p.QS = (bf16_t*)(a.ws + OFF_QS);
  p.KS = (bf16_t*)(a.ws + OFF_KS);
  p.VS = (bf16_t*)(a.ws + OFF_VS);
  p.CKV = (bf16_t*)(a.ws + OFF_CKV);
  p.QLAT = (bf16_t*)(a.ws + OFF_QLAT);
  p.KR = (bf16_t*)(a.ws + OFF_KR);
  p.QM = (bf16_t*)(a.ws + OFF_QM);
  p.KV = (bf16_t*)(a.ws + OFF_KV);
  p.ABTL = (bf16_t*)(a.ws + OFF_ABTL);
  p.ABTC = (bf16_t*)(a.ws + OFF_ABTC);
  p.GLA_B = (float*)(a.ws + OFF_GLA_B);
  p.GLA_DL = (float*)(a.ws + OFF_GLA_DL);
  p.GLA_S = (bf16_t*)(a.ws + OFF_GLA_S);
  p.MIX = (bf16_t*)(a.ws + OFF_MIX);
  p.F = (float*)(a.ws + OFF_Z);
  p.ACT = (bf16_t*)(a.ws + OFF_QS);
  return p;
}

DI int ltid() { int t = __builtin_amdgcn_workitem_id_x(); asm volatile("" : "+v"(t)); return t; }
DI int lbid() { int t = __builtin_amdgcn_workgroup_id_x(); asm volatile("" : "+s"(t)); return t; }
DI bf16_t f2bf(float x) { unsigned u = __float_as_uint(x); u += 0x7fffu + ((u >> 16) & 1u); return (bf16_t)(u >> 16); }
DI float bf2f(bf16_t b) { return __uint_as_float(((unsigned)b) << 16); }
DI unsigned pack2(float a, float b) { return (unsigned)f2bf(a) | ((unsigned)f2bf(b) << 16); }
DI float wave_sum(float v) {
#pragma unroll
  for (int o = 32; o > 0; o >>= 1) v += __shfl_xor(v, o);
  return v;
}
DI float silu_f(float x) { return x / (1.f + __expf(-x)); }
DI int crow(int r, int h) { return (r & 3) + 8 * (r >> 2) + 4 * h; }

template <class Epi>
DI void gemm_tile(const bf16_t* __restrict__ A, int lda, const bf16_t* __restrict__ Bt, int ldb, int K, int m0, int n0,
                  unsigned char* smem, const Epi& epi) {
  bf16_t* sA = (bf16_t*)smem;
  bf16_t* sB = sA + 128 * PITCH;
  const int tid = ltid(), lane = tid & 63, wid = tid >> 6, wm = wid >> 1, wn = wid & 1, l31 = lane & 31, h = lane >> 5;
  f32x16 acc[2][2];
#pragma unroll
  for (int a = 0; a < 2; ++a)
#pragma unroll
    for (int b = 0; b < 2; ++b)
#pragma unroll
      for (int i = 0; i < 16; ++i) acc[a][b][i] = 0.f;
  const int lrow = tid >> 3, lkc = tid & 7;
  u32x4 ra0, ra1, ra2, ra3, rb0, rb1, rb2, rb3;
  const bf16_t* Ap = A + (size_t)(m0 + lrow) * lda + lkc * 8;
  const bf16_t* Bp = Bt + (size_t)(n0 + lrow) * ldb + lkc * 8;
  const size_t sa32 = (size_t)32 * lda, sb32 = (size_t)32 * ldb;
  ra0 = *(const u32x4*)(Ap); ra1 = *(const u32x4*)(Ap + sa32); ra2 = *(const u32x4*)(Ap + 2 * sa32); ra3 = *(const u32x4*)(Ap + 3 * sa32);
  rb0 = *(const u32x4*)(Bp); rb1 = *(const u32x4*)(Bp + sb32); rb2 = *(const u32x4*)(Bp + 2 * sb32); rb3 = *(const u32x4*)(Bp + 3 * sb32);
  bf16_t* wA = sA + lrow * PITCH + lkc * 8;
  bf16_t* wB = sB + lrow * PITCH + lkc * 8;
  for (int k0 = 0; k0 < K; k0 += 64) {
    __syncthreads();
    *(u32x4*)(wA) = ra0; *(u32x4*)(wA + 32 * PITCH) = ra1; *(u32x4*)(wA + 64 * PITCH) = ra2; *(u32x4*)(wA + 96 * PITCH) = ra3;
    *(u32x4*)(wB) = rb0; *(u32x4*)(wB + 32 * PITCH) = rb1; *(u32x4*)(wB + 64 * PITCH) = rb2; *(u32x4*)(wB + 96 * PITCH) = rb3;
    __syncthreads();
    {
      const int kn = (k0 + 64 < K) ? k0 + 64 : k0;
      const bf16_t* a2 = Ap + kn; const bf16_t* b2 = Bp + kn;
      ra0 = *(const u32x4*)(a2); ra1 = *(const u32x4*)(a2 + sa32); ra2 = *(const u32x4*)(a2 + 2 * sa32); ra3 = *(const u32x4*)(a2 + 3 * sa32);
      rb0 = *(const u32x4*)(b2); rb1 = *(const u32x4*)(b2 + sb32); rb2 = *(const u32x4*)(b2 + 2 * sb32); rb3 = *(const u32x4*)(b2 + 3 * sb32);
    }
#pragma unroll
    for (int ks = 0; ks < 4; ++ks) {
      bf16x8 af[2], bfr[2];
#pragma unroll
      for (int b = 0; b < 2; ++b) {
        af[b] = *(const bf16x8*)(sA + (wm * 64 + b * 32 + l31) * PITCH + ks * 16 + h * 8);
        bfr[b] = *(const bf16x8*)(sB + (wn * 64 + b * 32 + l31) * PITCH + ks * 16 + h * 8);
      }
#pragma unroll
      for (int nb = 0; nb < 2; ++nb)
#pragma unroll
        for (int mb = 0; mb < 2; ++mb) acc[nb][mb] = MFMA32(bfr[nb], af[mb], acc[nb][mb]);
    }
  }
  epi(acc, m0 + wm * 64, n0 + wn * 64, l31, h);
}

struct EpiF32 {
  float* C; int ldc;
  DI void operator()(const f32x16 (&acc)[2][2], int mb0, int nb0, int l31, int h) const {
#pragma unroll
    for (int nb = 0; nb < 2; ++nb)
#pragma unroll
      for (int mb = 0; mb < 2; ++mb) {
        float* row = C + (size_t)(mb0 + mb * 32 + l31) * ldc + nb0 + nb * 32 + 4 * h;
#pragma unroll
        for (int g = 0; g < 4; ++g)
          *(float4*)(row + 8 * g) = make_float4(acc[nb][mb][4 * g], acc[nb][mb][4 * g + 1], acc[nb][mb][4 * g + 2], acc[nb][mb][4 * g + 3]);
      }
  }
};
struct EpiBf16 {
  bf16_t* C; int ldc; float scale; int ncols;
  DI void operator()(const f32x16 (&acc)[2][2], int mb0, int nb0, int l31, int h) const {
#pragma unroll
    for (int nb = 0; nb < 2; ++nb)
#pragma unroll
      for (int mb = 0; mb < 2; ++mb) {
        const int col0 = nb0 + nb * 32 + 4 * h;
        bf16_t* row = C + (size_t)(mb0 + mb * 32 + l31) * ldc + col0;
#pragma unroll
        for (int g = 0; g < 4; ++g) {
          if (col0 + 8 * g < ncols) {
            uint2 w;
            w.x = pack2(acc[nb][mb][4 * g] * scale, acc[nb][mb][4 * g + 1] * scale);
            w.y = pack2(acc[nb][mb][4 * g + 2] * scale, acc[nb][mb][4 * g + 3] * scale);
            *(uint2*)(row + 8 * g) = w;
          }
        }
      }
  }
};
struct EpiGateUp {
  bf16_t* C;
  DI void operator()(const f32x16 (&acc)[2][2], int mb0, int nb0, int l31, int h) const {
#pragma unroll
    for (int mb = 0; mb < 2; ++mb) {
      bf16_t* row = C + (size_t)(mb0 + mb * 32 + l31) * DFF + (nb0 >> 1) + 4 * h;
#pragma unroll
      for (int g = 0; g < 4; ++g) {
        float v[4];
#pragma unroll
        for (int i = 0; i < 4; ++i) v[i] = silu_f(acc[0][mb][4 * g + i]) * acc[1][mb][4 * g + i];
        uint2 w; w.x = pack2(v[0], v[1]); w.y = pack2(v[2], v[3]);
        *(uint2*)(row + 8 * g) = w;
      }
    }
  }
};
struct EpiWin {
  bf16_t* Z; float* out; int l;
  DI void operator()(const f32x16 (&acc)[2][2], int mb0, int nb0, int l31, int h) const {
#pragma unroll
    for (int nb = 0; nb < 2; ++nb)
#pragma unroll
      for (int mb = 0; mb < 2; ++mb) {
        const int m = mb0 + mb * 32 + l31;
        const int col0 = nb0 + nb * 32 + 4 * h;
        bf16_t* row = Z + (size_t)m * DIN + col0;
#pragma unroll
        for (int g = 0; g < 4; ++g) {
          const int col = col0 + 8 * g;
          if (col < DIN) {
            uint2 w;
            w.x = pack2(acc[nb][mb][4 * g], acc[nb][mb][4 * g + 1]);
            w.y = pack2(acc[nb][mb][4 * g + 2], acc[nb][mb][4 * g + 3]);
            *(uint2*)(row + 8 * g) = w;
            if (m < M_CTX) {
              const int b = m >> 8, s = m & 255;
              const size_t tok = (size_t)((b * 4 + l) * 256 + s);
              float* dst = nullptr;
              if (col >= ZKS && col < ZVS) dst = out + O_SK + tok * 128 + (col - ZKS);
              else if (col >= ZVS && col < ZF) dst = out + O_SV + tok * 128 + (col - ZVS);
              else if (col >= ZKR) dst = out + O_KR + tok * 32 + (col - ZKR);
              if (dst) *(float4*)dst = make_float4(acc[nb][mb][4 * g], acc[nb][mb][4 * g + 1], acc[nb][mb][4 * g + 2], acc[nb][mb][4 * g + 3]);
            }
          }
        }
      }
  }
};
struct EpiQm {
  bf16_t* C; const float* rope_m;
  DI void operator()(const f32x16 (&acc)[2][2], int mb0, int nb0, int l31, int h) const {
#pragma unroll
    for (int nb = 0; nb < 2; ++nb) {
      const int cb = nb0 + nb * 32;
      const bool isrope = ((cb >> 5) % 3) == 2;
#pragma unroll
      for (int mb = 0; mb < 2; ++mb) {
        const int m = mb0 + mb * 32 + l31;
        float v[16];
#pragma unroll
        for (int i = 0; i < 16; ++i) v[i] = acc[nb][mb][i];
        if (isrope && m >= M_CTX) {
          const int t = (m - M_CTX) & 4095;
          const int prow = t >> 6, pcol = t & 63;
#pragma unroll
          for (int half = 0; half < 2; ++half) {
            const int pos = half ? pcol : prow;
#pragma unroll
            for (int i = 0; i < 4; ++i) {
              const int j = 4 * h + i;
              const float cs = rope_m[(pos * 8 + j) * 2], sn = rope_m[(pos * 8 + j) * 2 + 1];
              const float x1 = v[8 * half + i], x2 = v[8 * half + 4 + i];
              v[8 * half + i] = x1 * cs - x2 * sn;
              v[8 * half + 4 + i] = x2 * cs + x1 * sn;
            }
          }
        }
        bf16_t* row = C + (size_t)m * 384 + cb + 4 * h;
#pragma unroll
        for (int g = 0; g < 4; ++g) {
          uint2 w; w.x = pack2(v[4 * g], v[4 * g + 1]); w.y = pack2(v[4 * g + 2], v[4 * g + 3]);
          *(uint2*)(row + 8 * g) = w;
        }
      }
    }
  }
};

DI void mod_item(const Params& p, int it, unsigned char* smem) {
  float* sc = (float*)smem;
  float* red = sc + 5 * 1024;
  const int tid = ltid(), lane = tid & 63, wid = tid >> 6;
  const int l = it / 144, n = (it % 144) * 64 + lane;
  __syncthreads();
  for (int e = tid; e < 5 * 1024; e += NT) {
    const int i = e >> 10, k = e & 1023;
    const float v = i == 0 ? p.c_ctx[k] : p.c[(i - 1) * 1024 + k];
    sc[e] = v / (1.f + expf(-v));
  }
  __syncthreads();
  float a0 = 0, a1 = 0, a2 = 0, a3 = 0, a4 = 0;
  const float* w = p.w_mod + ((size_t)l * 1024 + wid * 256) * 9216 + n;
#pragma unroll 8
  for (int k = 0; k < 256; ++k) {
    const float wv = w[(size_t)k * 9216];
    const int kk = wid * 256 + k;
    a0 += sc[kk] * wv; a1 += sc[1024 + kk] * wv; a2 += sc[2048 + kk] * wv; a3 += sc[3072 + kk] * wv; a4 += sc[4096 + kk] * wv;
  }
  red[(wid * 5 + 0) * 64 + lane] = a0; red[(wid * 5 + 1) * 64 + lane] = a1; red[(wid * 5 + 2) * 64 + lane] = a2;
  red[(wid * 5 + 3) * 64 + lane] = a3; red[(wid * 5 + 4) * 64 + lane] = a4;
  __syncthreads();
  for (int e = tid; e < 320; e += NT) {
    const int i = e >> 6, cl = e & 63;
    float s = 0.f;
    for (int w4 = 0; w4 < 4; ++w4) s += red[(w4 * 5 + i) * 64 + cl];
    const int col = (it % 144) * 64 + cl;
    p.MOD[(size_t)(l * 5 + i) * 9216 + col] = s + p.b_mod[(size_t)l * 9216 + col];
  }
}

DI void phase_init(const Params& p, unsigned char* smem) {
  const int nb = gridDim.x, bid = lbid(), tid = ltid();
  for (int it = bid; it < 1602; it += nb) {
    if (it < 576) mod_item(p, it, smem);
    else if (it < 1600) {
      const int r0 = (it - 576) * 4;
      for (int e = tid; e < 4 * 1024; e += NT) {
        const int r = r0 + (e >> 10), k8 = (e & 1023) * 8;
        unsigned w[4];
#pragma unroll
        for (int j = 0; j < 4; ++j) {
          float v[2];
#pragma unroll
          for (int q = 0; q < 2; ++q) {
            const int k = k8 + 2 * j + q;
            const int idx = (r * (k & 4095)) & 4095;
            const float ang = (float)idx * (1.0f / 2048.0f);
            v[q] = k < 4096 ? cospif(ang) : -sinpif(ang);
          }
          w[j] = pack2(v[0], v[1]);
        }
        *(uint4*)(p.TWL + (size_t)r * 8192 + k8) = make_uint4(w[0], w[1], w[2], w[3]);
      }
    } else if (it == 1600) {
      for (int e = tid; e < 256 * 512; e += NT) {
        const int r = e >> 9, k = e & 511;
        const int idx = (r * (k & 255)) & 255;
        const float ang = (float)idx * (1.0f / 128.0f);
        p.TWC[e] = f2bf(k < 256 ? cospif(ang) : -sinpif(ang));
      }
    } else {
      for (int e = tid; e < 64 * 16; e += NT) {
        const int pos = e >> 4, j = e & 15;
        const float inv = powf(10000.0f, -(float)(2 * j) / 32.0f);
        const float ang = (float)pos * inv;
        p.ROPE_S[e * 2] = cosf(ang); p.ROPE_S[e * 2 + 1] = sinf(ang);
      }
      for (int e = tid; e < 64 * 8; e += NT) {
        const int pos = e >> 3, j = e & 7;
        const float inv = powf(10000.0f, -(float)(2 * j) / 16.0f);
        const float ang = (float)pos * inv;
        p.ROPE_M[e * 2] = cosf(ang); p.ROPE_M[e * 2 + 1] = sinf(ang);
      }
    }
  }
}

DI void conv_tile(const float* __restrict__ src, int N, bf16_t* __restrict__ dst, int K, int kt, int nt, int mode, unsigned char* smem) {
  float* ts = (float*)smem;
  const int tid = ltid();
  __syncthreads();
#pragma unroll
  for (int i = 0; i < 4; ++i) {
    const int r = (tid >> 4) + 16 * i, c4 = (tid & 15) * 4;
    const float4 v = *(const float4*)(src + (size_t)(kt * 64 + r) * N + nt * 64 + c4);
    ts[r * 65 + c4] = v.x; ts[r * 65 + c4 + 1] = v.y; ts[r * 65 + c4 + 2] = v.z; ts[r * 65 + c4 + 3] = v.w;
  }
  __syncthreads();
  const int nl = tid >> 2, ks = (tid & 3) * 16;
  const int n = nt * 64 + nl;
  int drow = n;
  if (mode == 1) drow = (n >> 5) * 64 + (n & 31);
  else if (mode == 2) drow = (n >> 5) * 64 + 32 + (n & 31);
  unsigned w[8];
#pragma unroll
  for (int j = 0; j < 8; ++j) w[j] = pack2(ts[(ks + 2 * j) * 65 + nl], ts[(ks + 2 * j + 1) * 65 + nl]);
  bf16_t* d = dst + (size_t)drow * K + kt * 64 + ks;
  *(uint4*)d = make_uint4(w[0], w[1], w[2], w[3]);
  *(uint4*)(d + 8) = make_uint4(w[4], w[5], w[6], w[7]);
}
DI void convert_layer(const Params& p, int l, unsigned char* smem) {
  for (int t = lbid(); t < 5080; t += gridDim.x) {
    if (t < 2816) {
      const int q = t / 704, r = t % 704, i = q >> 1, which = q & 1;
      const float* src = (which ? p.w_up : p.w_gate) + (size_t)(l * 2 + i) * 1024 * DFF;
      conv_tile(src, DFF, p.WGU + (size_t)i * 5632 * 1024, 1024, r / 44, r % 44, 1 + which, smem);
    } else if (t < 4224) {
      const int q = (t - 2816) / 704, r = (t - 2816) % 704;
      conv_tile(p.w_down + (size_t)(l * 2 + q) * DFF * 1024, 1024, p.WD + (size_t)q * 1024 * DFF, DFF, r / 16, r % 16, 0, smem);
    } else if (t < 4784) {
      const int r = t - 4224;
      conv_tile(p.w_in + (size_t)l * 1024 * DIN, DIN, p.WIN, 1024, r / 35, r % 35, 0, smem);
    } else if (t < 5040) {
      const int r = t - 4784;
      conv_tile(p.w_out + (size_t)l * 1024 * 1024, 1024, p.WOUT, 1024, r / 16, r % 16, 0, smem);
    } else if (t < 5064) {
      const int r = t - 5040;
      conv_tile(p.w_qb + (size_t)l * 256 * 384, 384, p.WQB, 256, r / 6, r % 6, 0, smem);
    } else {
      const int r = t - 5064;
      conv_tile(p.w_kvb + (size_t)l * 128 * 512, 512, p.WKVB, 128, r / 8, r % 8, 0, smem);
    }
  }
}

struct EwArgs {
  const float *xin_ctx, *xin_lat; float *xout_ctx, *xout_lat;
  const float* F; int lu, gate_idx, gpost_idx; float res_w;
  int do_norm, ln, sc_idx, sh_idx, gpre_idx;
};
DI void phase_ew(const Params& p, const EwArgs& a) {
  const int lane = ltid() & 63, gw = lbid() * NW + (ltid() >> 6), gs = gridDim.x * NW;
  for (int r = gw; r < M_TOT; r += gs) {
    const int mi = r < M_CTX ? 0 : 1 + ((r - M_CTX) >> 12);
    const float* xs = r < M_CTX ? a.xin_ctx + (size_t)r * DM : a.xin_lat + (size_t)(r - M_CTX) * DM;
    float4 x[4];
#pragma unroll
    for (int j = 0; j < 4; ++j) x[j] = *(const float4*)(xs + lane * 4 + 256 * j);
    if (a.F) {
      const float* fr = a.F + (size_t)r * DM;
      const float* gate = p.MOD + (size_t)(a.lu * 5 + mi) * 9216 + a.gate_idx * 1024;
      const float* gp = p.g_norm + (size_t)(a.lu * 6 + a.gpost_idx) * 1024;
      float4 f[4]; float ss = 0.f;
#pragma unroll
      for (int j = 0; j < 4; ++j) { f[j] = *(const float4*)(fr + lane * 4 + 256 * j); ss += f[j].x * f[j].x + f[j].y * f[j].y + f[j].z * f[j].z + f[j].w * f[j].w; }
      ss = wave_sum(ss);
      const float rs = rsqrtf(ss * (1.f / 1024.f) + EPS) * a.res_w;
      float* xo = r < M_CTX ? a.xout_ctx + (size_t)r * DM : a.xout_lat + (size_t)(r - M_CTX) * DM;
#pragma unroll
      for (int j = 0; j < 4; ++j) {
        const float4 g = *(const float4*)(gate + lane * 4 + 256 * j), q = *(const float4*)(gp + lane * 4 + 256 * j);
        x[j].x += g.x * (f[j].x * rs * q.x); x[j].y += g.y * (f[j].y * rs * q.y); x[j].z += g.z * (f[j].z * rs * q.z); x[j].w += g.w * (f[j].w * rs * q.w);
        *(float4*)(xo + lane * 4 + 256 * j) = x[j];
      }
    }
    if (a.do_norm) {
      float ss = 0.f;
#pragma unroll
      for (int j = 0; j < 4; ++j) ss += x[j].x * x[j].x + x[j].y * x[j].y + x[j].z * x[j].z + x[j].w * x[j].w;
      ss = wave_sum(ss);
      const float rs = rsqrtf(ss * (1.f / 1024.f) + EPS);
      const float* sc = p.MOD + (size_t)(a.ln * 5 + mi) * 9216 + a.sc_idx * 1024;
      const float* sh = p.MOD + (size_t)(a.ln * 5 + mi) * 9216 + a.sh_idx * 1024;
      const float* gp = p.g_norm + (size_t)(a.ln * 6 + a.gpre_idx) * 1024;
      bf16_t* hr = p.H + (size_t)r * DM;
#pragma unroll
      for (int j = 0; j < 4; ++j) {
        const float4 s = *(const float4*)(sc + lane * 4 + 256 * j), t = *(const float4*)(sh + lane * 4 + 256 * j), q = *(const float4*)(gp + lane * 4 + 256 * j);
        uint2 w;
        w.x = pack2(x[j].x * rs * q.x * (1.f + s.x) + t.x, x[j].y * rs * q.y * (1.f + s.y) + t.y);
        w.y = pack2(x[j].z * rs * q.z * (1.f + s.z) + t.z, x[j].w * rs * q.w * (1.f + s.w) + t.w);
        *(uint2*)(hr + lane * 4 + 256 * j) = w;
      }
    }
  }
}

DI void prep_item(const Params& p, int l, int it, unsigned char* smem) {
  const int tid = ltid(), lane = tid & 63, wid = tid >> 6;
  const int r0 = it * 32;
  if (r0 >= M_TOT) {
    for (int e = tid; e < 32 * 128; e += NT) {
      const int rr = e >> 7, cc = e & 127, idx = r0 - M_TOT + rr, b = idx >> 8, j = idx & 255;
      const size_t src = ((size_t)(b * 4 + l) * 256 + j) * 128 + cc;
      const size_t dst = (size_t)(r0 + rr) * 128 + cc;
      p.KS[dst] = f2bf(p.cache_swa_k[src]);
      p.VS[dst] = f2bf(p.cache_swa_v[src]);
      p.CKV[dst] = f2bf(p.cache_mla_ckv[src]);
    }
    for (int e = tid; e < 32 * 32; e += NT) {
      const int rr = e >> 5, cc = e & 31, idx = r0 - M_TOT + rr, b = idx >> 8, j = idx & 255;
      p.KR[(size_t)(r0 + rr) * 32 + cc] = f2bf(p.cache_mla_krope[((size_t)(b * 4 + l) * 256 + j) * 32 + cc]);
    }
    return;
  }
  const bool lat = r0 >= M_CTX;
  for (int e = tid; e < 32 * 128; e += NT) {
    const int rr = e >> 7, rem = e & 127, head = rem >> 5, half = (rem >> 4) & 1, j = rem & 15;
    const int r = r0 + rr;
    const bf16_t* z = p.Z + (size_t)r * DIN;
    const int d1 = head * 64 + half * 32 + j, d2 = d1 + 16;
    float x1 = bf2f(z[ZQS + d1]), x2 = bf2f(z[ZQS + d2]);
    float cs = 1.f, sn = 0.f;
    if (lat) { const int t = (r - M_CTX) & 4095; const int pos = half ? (t & 63) : (t >> 6); cs = p.ROPE_S[(pos * 16 + j) * 2]; sn = p.ROPE_S[(pos * 16 + j) * 2 + 1]; }
    p.QS[(size_t)r * 256 + d1] = f2bf((x1 * cs - x2 * sn) * 0.125f);
    p.QS[(size_t)r * 256 + d2] = f2bf((x2 * cs + x1 * sn) * 0.125f);
    if (head < 2) {
      x1 = bf2f(z[ZKS + d1]); x2 = bf2f(z[ZKS + d2]);
      p.KS[(size_t)r * 128 + d1] = f2bf(x1 * cs - x2 * sn);
      p.KS[(size_t)r * 128 + d2] = f2bf(x2 * cs + x1 * sn);
      p.VS[(size_t)r * 128 + d1] = z[ZVS + d1];
      p.VS[(size_t)r * 128 + d2] = z[ZVS + d2];
    }
  }
  for (int e = tid; e < 32 * 16; e += NT) {
    const int rr = e >> 4, half = (e >> 3) & 1, j = e & 7, r = r0 + rr;
    const bf16_t* z = p.Z + (size_t)r * DIN + ZKR;
    const int d1 = half * 16 + j, d2 = d1 + 8;
    const float x1 = bf2f(z[d1]), x2 = bf2f(z[d2]);
    float cs = 1.f, sn = 0.f;
    if (lat) { const int t = (r - M_CTX) & 4095; const int pos = half ? (t & 63) : (t >> 6); cs = p.ROPE_M[(pos * 8 + j) * 2]; sn = p.ROPE_M[(pos * 8 + j) * 2 + 1]; }
    p.KR[(size_t)r * 32 + d1] = f2bf(x1 * cs - x2 * sn);
    p.KR[(size_t)r * 32 + d2] = f2bf(x2 * cs + x1 * sn);
  }
  for (int rr = wid; rr < 32; rr += NW) {
    const int r = r0 + rr;
    const bf16_t* z = p.Z + (size_t)r * DIN;
    {
      const float a = bf2f(z[ZKVA + lane]), b = bf2f(z[ZKVA + 64 + lane]);
      const float rs = rsqrtf(wave_sum(a * a + b * b) * (1.f / 128.f) + EPS);
      const float o0 = a * rs * p.mla_g_kv[l * 128 + lane], o1 = b * rs * p.mla_g_kv[l * 128 + 64 + lane];
      p.CKV[(size_t)r * 128 + lane] = f2bf(o0); p.CKV[(size_t)r * 128 + 64 + lane] = f2bf(o1);
      if (!lat) {
        const int b_ = r >> 8, s = r & 255;
        float* dst = p.out + O_CKV + ((size_t)(b_ * 4 + l) * 256 + s) * 128;
        dst[lane] = o0; dst[64 + lane] = o1;
      }
    }
    {
      float v[4]; float ss = 0.f;
#pragma unroll
      for (int j = 0; j < 4; ++j) { v[j] = bf2f(z[ZQA + lane + 64 * j]); ss += v[j] * v[j]; }
      const float rs = rsqrtf(wave_sum(ss) * (1.f / 256.f) + EPS);
#pragma unroll
      for (int j = 0; j < 4; ++j) p.QLAT[(size_t)r * 256 + lane + 64 * j] = f2bf(v[j] * rs * p.mla_g_q[l * 256 + lane + 64 * j]);
    }
  }
  {
    float* tw = (float*)smem;
    __syncthreads();
    if (tid < 64) tw[tid] = cospif((float)tid * (1.f / 32.f));
    __syncthreads();
    const int tk = tid & 31, og = tid >> 5, g = og >> 1, type = og & 1;
    const int r = r0 + tk;
    float zr[64];
    {
      const uint4* zp = (const uint4*)(p.Z + (size_t)r * DIN + ZF + g * 64);
#pragma unroll
      for (int q = 0; q < 8; ++q) {
        const uint4 u = zp[q];
        const unsigned uu[4] = {u.x, u.y, u.z, u.w};
#pragma unroll
        for (int j = 0; j < 4; ++j) { zr[q * 8 + 2 * j] = __uint_as_float(uu[j] << 16); zr[q * 8 + 2 * j + 1] = __uint_as_float(uu[j] & 0xffff0000u); }
      }
    }
    bf16_t* dst;
    int dstride;
    if (lat) { const int b = (r - M_CTX) >> 12, s = (r - M_CTX) & 4095; dst = p.ABTL + ((size_t)b * 256 + g * 64) * 8192 + type * 4096 + s; dstride = 8192; }
    else { const int b = r >> 8, s = r & 255; dst = p.ABTC + ((size_t)b * 256 + g * 64) * 512 + type * 256 + s; dstride = 512; }
    const int off = type ? 48 : 0;
    for (int cp = 0; cp < 64; ++cp) {
      float acc = 0.f; int idx = off;
#pragma unroll
      for (int c = 0; c < 64; ++c) { acc += zr[c] * tw[idx & 63]; idx += cp; }
      dst[(size_t)cp * dstride] = f2bf(acc);
    }
  }
}

DI void gla_cum(const Params& p, int l, int head, int dir, int row0, int rstep, float* sa, float* qt, f32x16& cum, float& last) {
  const int tid = ltid(), dk = tid & 63, quarter = tid >> 6;
  __syncthreads();
  for (int e = tid; e < 64 * 16; e += NT) {
    const int i = e >> 4, rr = e & 15;
    sa[e] = bf2f(p.Z[(size_t)(row0 + i * rstep) * DIN + ZAF + dir * 16 + rr]);
  }
  __syncthreads();
  float wg[16];
  const float* W = p.gla_w_gate + ((size_t)(l * 2 + dir) * 16) * 256 + head * 64 + dk;
#pragma unroll
  for (int rr = 0; rr < 16; ++rr) wg[rr] = W[rr * 256];
  const float bg = p.gla_b_gate[(l * 2 + dir) * 256 + head * 64 + dk];
  float run = 0.f;
#pragma unroll
  for (int ii = 0; ii < 16; ++ii) {
    const int i = quarter * 16 + ii;
    float lg = bg;
#pragma unroll
    for (int rr = 0; rr < 16; ++rr) lg += sa[i * 16 + rr] * wg[rr];
    const float ls = -(fmaxf(-lg, 0.f) + log1pf(expf(-fabsf(lg))));
    run += ls * (1.f / 16.f);
    cum[ii] = run;
  }
  qt[quarter * 64 + dk] = run;
  __syncthreads();
  float offs = 0.f, tot = 0.f;
#pragma unroll
  for (int q = 0; q < 4; ++q) { const float v = qt[q * 64 + dk]; tot += v; if (q < quarter) offs += v; }
#pragma unroll
  for (int ii = 0; ii < 16; ++ii) cum[ii] += offs;
  last = tot;
}

DI void gla_seq_info(int sq_global, int& grp, int& b, int& head, int& dir, int& S, int& base) {
  if (sq_global < 32) { grp = 1; b = sq_global >> 3; head = (sq_global >> 1) & 3; dir = sq_global & 1; S = 4096; base = M_CTX + b * 4096; }
  else { const int s = sq_global - 32; grp = 0; b = s >> 3; head = (s >> 1) & 3; dir = s & 1; S = 256; base = b * 256; }
}

DI void gla_pass_a(const Params& p, int l, int ci, unsigned char* smem) {
  float* sa = (float*)smem;
  float* qt = sa + 1024;
  bf16_t* kdT = (bf16_t*)(qt + 256);
  bf16_t* vT = kdT + 64 * PITCH;
  const int tid = ltid(), lane = tid & 63, wid = tid >> 6, dk = tid & 63, quarter = tid >> 6, l31 = lane & 31, h = lane >> 5;
  int sqg, c;
  if (ci < 2048) { sqg = ci >> 6; c = ci & 63; } else { sqg = 32 + ((ci - 2048) >> 2); c = (ci - 2048) & 3; }
  int grp, b, head, dir, S, base;
  gla_seq_info(sqg, grp, b, head, dir, S, base);
  const int row0 = dir ? base + S - 1 - 64 * c : base + 64 * c, rstep = dir ? -1 : 1;
  f32x16 cum; float last;
  gla_cum(p, l, head, dir, row0, rstep, sa, qt, cum, last);
  unsigned kw[8], vw[8];
#pragma unroll
  for (int j = 0; j < 8; ++j) {
    float kv[2], vv[2];
#pragma unroll
    for (int q = 0; q < 2; ++q) {
      const int ii = 2 * j + q, i = quarter * 16 + ii;
      const bf16_t* z = p.Z + (size_t)(row0 + i * rstep) * DIN;
      kv[q] = bf2f(z[ZKG + head * 64 + dk]) * expf(last - cum[ii]);
      vv[q] = bf2f(z[ZVG + head * 64 + dk]);
    }
    kw[j] = pack2(kv[0], kv[1]); vw[j] = pack2(vv[0], vv[1]);
  }
  *(uint4*)(kdT + dk * PITCH + quarter * 16) = make_uint4(kw[0], kw[1], kw[2], kw[3]);
  *(uint4*)(kdT + dk * PITCH + quarter * 16 + 8) = make_uint4(kw[4], kw[5], kw[6], kw[7]);
  *(uint4*)(vT + dk * PITCH + quarter * 16) = make_uint4(vw[0], vw[1], vw[2], vw[3]);
  *(uint4*)(vT + dk * PITCH + quarter * 16 + 8) = make_uint4(vw[4], vw[5], vw[6], vw[7]);
  if (quarter == 0) p.GLA_DL[(size_t)ci * 64 + dk] = expf(last);
  __syncthreads();
  const int wr = wid >> 1, wc = wid & 1;
  f32x16 acc;
#pragma unroll
  for (int i = 0; i < 16; ++i) acc[i] = 0.f;
#pragma unroll
  for (int ks = 0; ks < 4; ++ks) {
    const bf16x8 a = *(const bf16x8*)(kdT + (wr * 32 + l31) * PITCH + ks * 16 + h * 8);
    const bf16x8 bb = *(const bf16x8*)(vT + (wc * 32 + l31) * PITCH + ks * 16 + h * 8);
    acc = MFMA32(a, bb, acc);
  }
  float* Bc = p.GLA_B + (size_t)ci * 4096;
#pragma unroll
  for (int i = 0; i < 16; ++i) Bc[(wr * 32 + crow(i, h)) * 64 + wc * 32 + l31] = acc[i];
}

DI void gla_pass_b(const Params& p, int l, int sqg) {
  const int tid = ltid(), dv = tid >> 2, dk0 = (tid & 3) * 16;
  int grp, b, head, dir, S, base;
  gla_seq_info(sqg, grp, b, head, dir, S, base);
  const int nch = S >> 6;
  const int ci0 = grp ? sqg * 64 : 2048 + (sqg - 32) * 4;
  f32x16 s;
  if (grp) {
    const float* s0 = p.state_gla + ((((size_t)b * 4 + l) * 2 + dir) * 4 + head) * 4096;
#pragma unroll
    for (int j = 0; j < 16; ++j) s[j] = s0[(dk0 + j) * 64 + dv];
  } else {
#pragma unroll
    for (int j = 0; j < 16; ++j) s[j] = 0.f;
  }
  for (int c = 0; c < nch; ++c) {
    const size_t ci = ci0 + c;
    unsigned w[8];
#pragma unroll
    for (int j = 0; j < 8; ++j) w[j] = pack2(s[2 * j], s[2 * j + 1]);
    bf16_t* Sd = p.GLA_S + ci * 4096 + dv * 64 + dk0;
    *(uint4*)Sd = make_uint4(w[0], w[1], w[2], w[3]);
    *(uint4*)(Sd + 8) = make_uint4(w[4], w[5], w[6], w[7]);
    const float* Bc = p.GLA_B + ci * 4096;
    const float* dl = p.GLA_DL + ci * 64;
#pragma unroll
    for (int j = 0; j < 16; ++j) s[j] = dl[dk0 + j] * s[j] + Bc[(dk0 + j) * 64 + dv];
  }
  if (!grp) {
    float* so = p.out + O_ST + ((((size_t)b * 4 + l) * 2 + dir) * 4 + head) * 4096;
#pragma unroll
    for (int j = 0; j < 16; ++j) so[(dk0 + j) * 64 + dv] = s[j];
  }
}

DI void gla_pass_c(const Params& p, int l, int item, unsigned char* smem) {
  float* sa = (float*)smem;
  float* qt = sa + 1024;
  bf16_t* qd = (bf16_t*)(qt + 256);
  bf16_t* ki = qd + 64 * PITCH;
  bf16_t* vT = ki + 64 * PITCH;
  bf16_t* stT = vT + 64 * PITCH;
  float* osum = (float*)(stT + 64 * PITCH);
  const int tid = ltid(), lane = tid & 63, wid = tid >> 6, dk = tid & 63, quarter = tid >> 6, l31 = lane & 31, h = lane >> 5;
  int grp, b, head, c, S, base, nch;
  if (item < 1024) { grp = 1; b = item >> 8; head = (item >> 6) & 3; c = item & 63; S = 4096; base = M_CTX + b * 4096; nch = 64; }
  else { const int it = item - 1024; grp = 0; b = it >> 4; head = (it >> 2) & 3; c = it & 3; S = 256; base = b * 256; nch = 4; }
  const int wd = wid >> 1, wp = wid & 1;
  for (int dir = 0; dir < 2; ++dir) {
    const int cs = dir ? nch - 1 - c : c;
    const int sq = b * 8 + head * 2 + dir;
    const size_t ci = grp ? (size_t)sq * 64 + cs : 2048 + (size_t)sq * 4 + cs;
    const int row0 = dir ? base + S - 1 - 64 * cs : base + 64 * cs, rstep = dir ? -1 : 1;
    f32x16 cum; float last;
    gla_cum(p, l, head, dir, row0, rstep, sa, qt, cum, last);
    unsigned vw[8];
#pragma unroll
    for (int j = 0; j < 8; ++j) {
      float vv[2];
#pragma unroll
      for (int q = 0; q < 2; ++q) {
        const int ii = 2 * j + q, i = quarter * 16 + ii;
        const bf16_t* z = p.Z + (size_t)(row0 + i * rstep) * DIN;
        const float e = expf(cum[ii]);
        qd[i * PITCH + dk] = f2bf(bf2f(z[ZQG + head * 64 + dk]) * 0.125f * e);
        ki[i * PITCH + dk] = f2bf(bf2f(z[ZKG + head * 64 + dk]) / e);
        vv[q] = bf2f(z[ZVG + head * 64 + dk]);
      }
      vw[j] = pack2(vv[0], vv[1]);
    }
    *(uint4*)(vT + dk * PITCH + quarter * 16) = make_uint4(vw[0], vw[1], vw[2], vw[3]);
    *(uint4*)(vT + dk * PITCH + quarter * 16 + 8) = make_uint4(vw[4], vw[5], vw[6], vw[7]);
    {
      const bf16_t* Sg = p.GLA_S + ci * 4096;
      for (int e = tid; e < 512; e += NT) { const int r = e >> 3, cc = (e & 7) * 8; *(uint4*)(stT + r * PITCH + cc) = *(const uint4*)(Sg + r * 64 + cc); }
    }
    __syncthreads();
    f32x16 acco;
#pragma unroll
    for (int i = 0; i < 16; ++i) acco[i] = 0.f;
#pragma unroll
    for (int ks = 0; ks < 4; ++ks) {
      const bf16x8 a = *(const bf16x8*)(stT + (wd * 32 + l31) * PITCH + ks * 16 + h * 8);
      const bf16x8 bb = *(const bf16x8*)(qd + (wp * 32 + l31) * PITCH + ks * 16 + h * 8);
      acco = MFMA32(a, bb, acco);
    }
    for (int jb = 0; jb <= wp; ++jb) {
      f32x16 att;
#pragma unroll
      for (int i = 0; i < 16; ++i) att[i] = 0.f;
#pragma unroll
      for (int ks = 0; ks < 4; ++ks) {
        const bf16x8 a = *(const bf16x8*)(ki + (jb * 32 + l31) * PITCH + ks * 16 + h * 8);
        const bf16x8 bb = *(const bf16x8*)(qd + (wp * 32 + l31) * PITCH + ks * 16 + h * 8);
        att = MFMA32(a, bb, att);
      }
      const int ipos = wp * 32 + l31;
#pragma unroll
      for (int i = 0; i < 16; ++i) if (jb * 32 + crow(i, h) > ipos) att[i] = 0.f;
#pragma unroll
      for (int s = 0; s < 2; ++s) {
        union { bf16x8 v; unsigned u[4]; } pf;
#pragma unroll
        for (int j = 0; j < 4; ++j) pf.u[j] = pack2(att[8 * s + 2 * j], att[8 * s + 2 * j + 1]);
        union { bf16x8 v; bf16x4 hlf[2]; } vf;
        vf.hlf[0] = *(const bf16x4*)(vT + (wd * 32 + l31) * PITCH + jb * 32 + 16 * s + 4 * h);
        vf.hlf[1] = *(const bf16x4*)(vT + (wd * 32 + l31) * PITCH + jb * 32 + 16 * s + 8 + 4 * h);
        acco = MFMA32(vf.v, pf.v, acco);
      }
    }
    {
      const int i = wp * 32 + l31, tl = dir ? 63 - i : i;
#pragma unroll
      for (int r = 0; r < 16; ++r) {
        float* o = osum + tl * 65 + wd * 32 + crow(r, h);
        if (dir) *o += acco[r]; else *o = acco[r];
      }
    }
  }
  __syncthreads();
  const float g = p.gla_g_out[l * 64 + lane];
  for (int t = wid; t < 64; t += NW) {
    const float v = osum[t * 65 + lane];
    const float rs = rsqrtf(wave_sum(v * v) * (1.f / 64.f) + EPS);
    const int row = base + 64 * c + t;
    const float rg = bf2f(p.Z[(size_t)row * DIN + ZRG + head * 64 + lane]);
    p.MIX[(size_t)row * 1024 + head * 64 + lane] = f2bf(v * rs * g * silu_f(rg));
  }
}

struct AttnJob {
  const bf16_t* Q; int ldq;
  const bf16_t* K1; int ldk1;
  const bf16_t* K2; int ldk2;
  const bf16_t* V; int ldv;
  int ctx_row0, nctx;
  int loc_row0, loc_pos0, nloc;
  int qrow0, qpos0;
  int window;
  float scale; int has_sink; float sink;
  bf16_t* O; int ldo;
};
template <int DQ>
DI void attn_block(const AttnJob& jb, unsigned char* smem) {
  constexpr int NKS = DQ / 16, KP = DQ + 8, NCH = DQ / 8;
  bf16_t* sK = (bf16_t*)smem;
  bf16_t* sVt = sK + 64 * KP;
  const int tid = ltid(), lane = tid & 63, wid = tid >> 6, l31 = lane & 31, h = lane >> 5;
  const int qr = jb.qrow0 + wid * 32 + l31;
  bf16x8 qf[NKS];
#pragma unroll
  for (int ks = 0; ks < NKS; ++ks) qf[ks] = *(const bf16x8*)(jb.Q + (size_t)qr * jb.ldq + ks * 16 + h * 8);
  const int qpos = jb.qpos0 + wid * 32 + l31;
  f32x16 o[2];
#pragma unroll
  for (int d = 0; d < 2; ++d)
#pragma unroll
    for (int i = 0; i < 16; ++i) o[d][i] = 0.f;
  float m = -1e30f, lsum = 0.f;
  const int nt = jb.nctx + jb.nloc;
  for (int t = 0; t < nt; ++t) {
    int krow, kpos0; bool masked;
    if (t < jb.nctx) { krow = jb.ctx_row0 + 64 * t; kpos0 = 0; masked = false; }
    else { kpos0 = jb.loc_pos0 + 64 * (t - jb.nctx); krow = jb.loc_row0 + kpos0; masked = jb.window > 0; }
    __syncthreads();
    for (int ch = tid; ch < 64 * NCH; ch += NT) {
      const int key = ch / NCH, dc = ch % NCH;
      uint4 v;
      if (dc < 8) v = *(const uint4*)(jb.K1 + (size_t)(krow + key) * jb.ldk1 + dc * 8);
      else v = *(const uint4*)(jb.K2 + (size_t)(krow + key) * jb.ldk2 + (dc - 8) * 8);
      *(uint4*)(sK + key * KP + dc * 8) = v;
    }
    for (int ch = tid; ch < 512; ch += NT) {
      const int key = ch & 63, dc = ch >> 6;
      const uint4 v = *(const uint4*)(jb.V + (size_t)(krow + key) * jb.ldv + dc * 8);
      const unsigned uu[4] = {v.x, v.y, v.z, v.w};
#pragma unroll
      for (int j = 0; j < 4; ++j) {
        sVt[(dc * 8 + 2 * j) * PITCH + key] = (bf16_t)(uu[j] & 0xffffu);
        sVt[(dc * 8 + 2 * j + 1) * PITCH + key] = (bf16_t)(uu[j] >> 16);
      }
    }
    __syncthreads();
    f32x16 st[2];
#pragma unroll
    for (int kb = 0; kb < 2; ++kb) {
#pragma unroll
      for (int i = 0; i < 16; ++i) st[kb][i] = 0.f;
#pragma unroll
      for (int ks = 0; ks < NKS; ++ks) {
        const bf16x8 a = *(const bf16x8*)(sK + (kb * 32 + l31) * KP + ks * 16 + h * 8);
        st[kb] = MFMA32(a, qf[ks], st[kb]);
      }
    }
    float mx = -1e30f;
#pragma unroll
    for (int kb = 0; kb < 2; ++kb)
#pragma unroll
      for (int i = 0; i < 16; ++i) {
        float s = st[kb][i] * jb.scale;
        if (masked) {
          const int kp = kpos0 + kb * 32 + crow(i, h);
          const int d = qpos - kp;
          if (d > jb.window || d < -jb.window) s = -1e30f;
        }
        st[kb][i] = s;
        mx = fmaxf(mx, s);
      }
    mx = fmaxf(mx, __shfl_xor(mx, 32));
    const float mn = fmaxf(m, mx);
    const float alpha = __expf(m - mn);
    m = mn;
    float ps = 0.f;
#pragma unroll
    for (int kb = 0; kb < 2; ++kb)
#pragma unroll
      for (int i = 0; i < 16; ++i) { const float pv = __expf(st[kb][i] - mn); st[kb][i] = pv; ps += pv; }
    lsum = lsum * alpha + ps;
#pragma unroll
    for (int d = 0; d < 2; ++d)
#pragma unroll
      for (int i = 0; i < 16; ++i) o[d][i] *= alpha;
#pragma unroll
    for (int kb = 0; kb < 2; ++kb)
#pragma unroll
      for (int s = 0; s < 2; ++s) {
        union { bf16x8 v; unsigned u[4]; } pf;
#pragma unroll
        for (int j = 0; j < 4; ++j) pf.u[j] = pack2(st[kb][8 * s + 2 * j], st[kb][8 * s + 2 * j + 1]);
#pragma unroll
        for (int d = 0; d < 2; ++d) {
          union { bf16x8 v; bf16x4 hlf[2]; } vf;
          vf.hlf[0] = *(const bf16x4*)(sVt + (d * 32 + l31) * PITCH + kb * 32 + 16 * s + 4 * h);
          vf.hlf[1] = *(const bf16x4*)(sVt + (d * 32 + l31) * PITCH + kb * 32 + 16 * s + 8 + 4 * h);
          o[d] = MFMA32(vf.v, pf.v, o[d]);
        }
      }
  }
  lsum += __shfl_xor(lsum, 32);
  float inv;
  if (jb.has_sink) {
    const float mf = fmaxf(m, jb.sink);
    const float corr = __expf(m - mf);
    inv = corr / (lsum * corr + __expf(jb.sink - mf));
  } else inv = 1.f / lsum;
  bf16_t* orow = jb.O + (size_t)qr * jb.ldo;
#pragma unroll
  for (int d = 0; d < 2; ++d)
#pragma unroll
    for (int g = 0; g < 4; ++g) {
      uint2 w;
      w.x = pack2(o[d][4 * g] * inv, o[d][4 * g + 1] * inv);
      w.y = pack2(o[d][4 * g + 2] * inv, o[d][4 * g + 3] * inv);
      *(uint2*)(orow + d * 32 + 8 * g + 4 * h) = w;
    }
}

DI void mla_item(const Params& p, int l, int grp, int it, unsigned char* smem) {
  AttnJob j;
  int b, head, qb;
  if (grp) { b = it >> 7; head = (it >> 5) & 3; qb = it & 31; } else { b = it >> 3; head = (it >> 1) & 3; qb = it & 1; }
  const int base = grp ? M_CTX + b * 4096 : b * 256;
  j.Q = p.QM + head * 96; j.ldq = 384;
  j.K1 = p.KV + head * 128; j.ldk1 = 512; j.K2 = p.KR; j.ldk2 = 32; j.V = p.KV + head * 128 + 64; j.ldv = 512;
  j.ctx_row0 = M_TOT + b * 256; j.nctx = grp ? 4 : 0;
  j.loc_row0 = base; j.loc_pos0 = 0; j.nloc = grp ? 64 : 4;
  j.qrow0 = base + qb * 128; j.qpos0 = qb * 128; j.window = 0;
  j.scale = 0.10206207261596577f; j.has_sink = 0; j.sink = 0.f;
  j.O = p.MIX + 768 + head * 64; j.ldo = 1024;
  attn_block<96>(j, smem);
}
DI void swa_item(const Params& p, int l, int grp, int it, unsigned char* smem) {
  AttnJob j;
  int b, hq, qb;
  if (grp) { b = it >> 7; hq = (it >> 5) & 3; qb = it & 31; } else { b = it >> 3; hq = (it >> 1) & 3; qb = it & 1; }
  const int base = grp ? M_CTX + b * 4096 : b * 256;
  const int g = hq >> 1;
  j.Q = p.QS + hq * 64; j.ldq = 256;
  j.K1 = p.KS + g * 64; j.ldk1 = 128; j.K2 = p.KS; j.ldk2 = 128; j.V = p.VS + g * 64; j.ldv = 128;
  j.ctx_row0 = M_TOT + b * 256; j.nctx = grp ? 4 : 0;
  if (grp) {
    const int lo = qb > 0 ? (qb - 1) * 128 : 0, hi = qb < 31 ? (qb + 2) * 128 : 4096;
    j.loc_pos0 = lo; j.nloc = (hi - lo) >> 6; j.window = 128;
  } else { j.loc_pos0 = 0; j.nloc = 4; j.window = 0; }
  j.loc_row0 = base;
  j.qrow0 = base + qb * 128; j.qpos0 = qb * 128;
  j.scale = 1.0f;
  j.has_sink = 1; j.sink = p.swa_sink[l * 4 + hq];
  j.O = p.MIX + 256 + hq * 64; j.ldo = 1024;
  attn_block<64>(j, smem);
}

DI void phase_gemm_gu(const Params& p, int i, unsigned char* smem) {
  EpiGateUp epi{p.ACT};
  const bf16_t* W = p.WGU + (size_t)i * 5632 * 1024;
  for (int t = lbid(); t < 160 * 44; t += gridDim.x) { const int tm = t / 44, tn = t % 44; gemm_tile(p.H, 1024, W, 1024, 1024, tm * 128, tn * 128, smem, epi); }
}
DI void phase_gemm_down(const Params& p, int i, unsigned char* smem) {
  EpiF32 epi{p.F, 1024};
  const bf16_t* W = p.WD + (size_t)i * 1024 * DFF;
  for (int t = lbid(); t < 160 * 8; t += gridDim.x) { const int tm = t / 8, tn = t % 8; gemm_tile(p.ACT, DFF, W, DFF, DFF, tm * 128, tn * 128, smem, epi); }
}
DI void phase_gemm_win(const Params& p, int l, unsigned char* smem) {
  EpiWin epi{p.Z, p.out, l};
  for (int t = lbid(); t < 160 * 18; t += gridDim.x) { const int tm = t / 18, tn = t % 18; gemm_tile(p.H, 1024, p.WIN, 1024, 1024, tm * 128, tn * 128, smem, epi); }
}
DI void phase_gemm_wout(const Params& p, unsigned char* smem) {
  EpiF32 epi{p.F, 1024};
  for (int t = lbid(); t < 160 * 8; t += gridDim.x) { const int tm = t / 8, tn = t % 8; gemm_tile(p.MIX, 1024, p.WOUT, 1024, 1024, tm * 128, tn * 128, smem, epi); }
}
DI void phase_prep(const Params& p, int l, unsigned char* smem) {
  for (int t = lbid(); t < 672 + 2560; t += gridDim.x) {
    if (t < 672) prep_item(p, l, t, smem); else gla_pass_a(p, l, t - 672, smem);
  }
}
DI void phase_qkv(const Params& p, int l, unsigned char* smem) {
  EpiQm eq{p.QM, p.ROPE_M};
  EpiBf16 ekv{p.KV, 512, 1.f, 512};
  for (int t = lbid(); t < 160 + 480 + 672; t += gridDim.x) {
    if (t < 160) gla_pass_b(p, l, t);
    else if (t < 640) { const int u = t - 160, tm = u / 3, tn = u % 3; gemm_tile(p.QLAT, 256, p.WQB, 256, 256, tm * 128, tn * 128, smem, eq); }
    else { const int u = t - 640, tm = u >> 2, tn = u & 3; gemm_tile(p.CKV, 128, p.WKVB, 128, 128, tm * 128, tn * 128, smem, ekv); }
  }
}
DI void phase_mixers(const Params& p, int l, unsigned char* smem) {
  for (int t = lbid(); t < 2880; t += gridDim.x) {
    if (t < 512) mla_item(p, l, 1, t, smem);
    else if (t < 768) {
      const int u = t - 512, b = u >> 6, tm = (u >> 1) & 31, tn = u & 1;
      EpiBf16 e{p.MIX + (size_t)(M_CTX + b * 4096) * 1024 + 512, 1024, 1.f / 512.f, 256};
      gemm_tile(p.TWL, 8192, p.ABTL + (size_t)b * 256 * 8192, 8192, 8192, tm * 128, tn * 128, smem, e);
    } else if (t < 1280) swa_item(p, l, 1, t - 768, smem);
    else if (t < 2304) gla_pass_c(p, l, t - 1280, smem);
    else if (t < 2432) mla_item(p, l, 0, t - 2304, smem);
    else if (t < 2560) swa_item(p, l, 0, t - 2432, smem);
    else if (t < 2624) {
      const int u = t - 2560, b = u >> 2, tm = (u >> 1) & 1, tn = u & 1;
      EpiBf16 e{p.MIX + (size_t)(b * 256) * 1024 + 512, 1024, 1.f / 128.f, 256};
      gemm_tile(p.TWC, 512, p.ABTC + (size_t)b * 256 * 512, 512, 512, tm * 128, tn * 128, smem, e);
    } else gla_pass_c(p, l, 1024 + (t - 2624), smem);
  }
}

#ifndef ONLY_J
#define ONLY_J -1
#endif
#define EN(x) (ONLY_J < 0 || ONLY_J == (x))
constexpr int N_PHASES = 50;
#define MKP const PArg* kq = kp; asm volatile("" : "+s"(kq)); const Params p = make_params(*kq)
DI void run_phase(const PArg* kp, int ph, unsigned char* smem) {
  if (ph == 0) { if (EN(100)) { MKP; phase_init(p, smem); } return; }
  if (ph == 49) {
    MKP;
    EwArgs a{p.X, p.X + (size_t)M_CTX * DM, p.out + O_YP, p.out + O_YS, p.F, 3, 8, 5, 0.5f, 0, 0, 0, 0, 0};
    if (EN(101)) phase_ew(p, a);
    return;
  }
  const int l = (ph - 1) / 12, j = (ph - 1) % 12;
  switch (j) {
    case 0: if (EN(0)) {
      MKP; float* Xl = p.X + (size_t)M_CTX * DM;
      convert_layer(p, l, smem);
      if (l == 0) { EwArgs a{p.x_prompt, p.x_sample, p.X, Xl, nullptr, 0, 0, 0, 0.f, 1, 0, 1, 0, 0}; phase_ew(p, a); }
      else { EwArgs a{p.X, Xl, p.X, Xl, p.F, l - 1, 8, 5, 0.5f, 1, l, 1, 0, 0}; phase_ew(p, a); }
    } break;
    case 1: if (EN(1)) { MKP; phase_gemm_gu(p, 0, smem); } break;
    case 2: if (EN(2)) { MKP; phase_gemm_down(p, 0, smem); } break;
    case 3: if (EN(3)) {
      MKP; float* Xl = p.X + (size_t)M_CTX * DM;
      if (l == 0) { EwArgs a{p.x_prompt, p.x_sample, p.X, Xl, p.F, l, 2, 1, 0.5f, 1, l, 4, 3, 2}; phase_ew(p, a); }
      else { EwArgs a{p.X, Xl, p.X, Xl, p.F, l, 2, 1, 0.5f, 1, l, 4, 3, 2}; phase_ew(p, a); }
    } break;
    case 4: if (EN(4)) { MKP; phase_gemm_win(p, l, smem); } break;
    case 5: if (EN(5)) { MKP; phase_prep(p, l, smem); } break;
    case 6: if (EN(6)) { MKP; phase_qkv(p, l, smem); } break;
    case 7: if (EN(7)) { MKP; phase_mixers(p, l, smem); } break;
    case 8: if (EN(8)) { MKP; phase_gemm_wout(p, smem); } break;
    case 9: if (EN(9)) { MKP; float* Xl = p.X + (size_t)M_CTX * DM; EwArgs a{p.X, Xl, p.X, Xl, p.F, l, 5, 3, 1.0f, 1, l, 7, 6, 4}; phase_ew(p, a); } break;
    case 10: if (EN(10)) { MKP; phase_gemm_gu(p, 1, smem); } break;
    case 11: if (EN(11)) { MKP; phase_gemm_down(p, 1, smem); } break;
  }
}

__global__ void __launch_bounds__(NT, 2) fwd_kernel(PArg pa, int ph_lo, int ph_hi) {
  __shared__ __attribute__((aligned(16))) unsigned char smem[SMEM_BYTES];
  const PArg* kp = (const PArg*)__builtin_amdgcn_kernarg_segment_ptr();
#if MULTI_LAUNCH
  for (int ph = ph_lo; ph < ph_hi; ++ph) run_phase(kp, ph, smem);
#else
  cg::grid_group grid = cg::this_grid();
  for (int ph = ph_lo; ph < ph_hi; ++ph) {
    run_phase(kp, ph, smem);
    if (ph + 1 < ph_hi) grid.sync();
  }
#endif
}

extern "C" void kernel_launch(void* const* d_in, const int* in_sizes, int n_in, void* d_out, int out_size, void* d_ws, size_t ws_size,
                              hipStream_t stream) {
  PArg p{};
  for (int i = 0; i < 25; ++i) p.in[i] = (const float*)d_in[i];
  p.out = (float*)d_out;
  p.ws = (unsigned char*)d_ws;
  if (WS_NEED > ws_size) { fprintf(stderr, "workspace too small: need %zu have %zu\n", (size_t)WS_NEED, ws_size); return; }
#if MULTI_LAUNCH
  for (int ph = 0; ph < N_PHASES; ++ph) hipLaunchKernelGGL(fwd_kernel, dim3(512), dim3(NT), 0, stream, p, ph, ph + 1);
#else
  static int grid_blocks = 0;
  if (!grid_blocks) {
    int dev = 0, cus = 0, per_cu = 0;
    hipGetDevice(&dev);
    hipDeviceGetAttribute(&cus, hipDeviceAttributeMultiprocessorCount, dev);
    hipOccupancyMaxActiveBlocksPerMultiprocessor(&per_cu, fwd_kernel, NT, 0);
    if (per_cu > 2) per_cu = 2;
    grid_blocks = cus * per_cu;
  }
  int lo = 0, hi = N_PHASES;
  void* args[] = {&p, &lo, &hi};
  hipError_t e = hipLaunchCooperativeKernel((void*)fwd_kernel, dim3(grid_blocks), dim3(NT), args, 0, stream);
  if (e != hipSuccess) fprintf(stderr, "cooperative launch failed: %s (grid %d)\n", hipGetErrorString(e), grid_blocks);
#endif
}
```

```cpp
#include <hip/hip_runtime.h>
#include <hip/hip_cooperative_groups.h>
#include <cstdio>
#include <cstdint>
namespace cg = cooperative_groups;

#ifndef MULTI_LAUNCH
#define MULTI_LAUNCH 0
#endif

#define DI __device__ __forceinline__
typedef unsigned short bf16_t;
typedef short bf16x8 __attribute__((ext_vector_type(8)));
typedef short bf16x4 __attribute__((ext_vector_type(4)));
typedef float f32x16 __attribute__((ext_vector_type(16)));
typedef unsigned u32x4 __attribute__((ext_vector_type(4)));
typedef unsigned u32x2 __attribute__((ext_vector_type(2)));
#define MFMA32(a, b, c) __builtin_amdgcn_mfma_f32_32x32x16_bf16((a), (b), (c), 0, 0, 0)

constexpr int NT = 256, NW = NT / 64;
constexpr int DM = 1024, M_CTX = 4096, M_LAT = 16384, M_TOT = 20480, M_EXT = 21504;
constexpr int DFF = 2816, DIN = 2240;
constexpr float EPS = 1e-6f;
constexpr int SMEM_BYTES = 60 * 1024;
constexpr int PITCH = 72;
constexpr int ZQG = 0, ZKG = 256, ZVG = 512, ZRG = 768, ZAF = 1024, ZQS = 1056, ZKS = 1312, ZVS = 1440, ZF = 1568, ZQA = 1824, ZKVA = 2080, ZKR = 2208;
constexpr size_t O_YP = 0, O_YS = 4194304, O_ST = 20971520, O_SK = 23068672, O_SV = 25165824, O_CKV = 27262976, O_KR = 29360128;

struct Params {
  const float *x_prompt, *x_sample, *c, *state_gla, *cache_swa_k, *cache_swa_v, *cache_mla_ckv, *cache_mla_krope, *c_ctx,
      *w_mod, *b_mod, *g_norm, *w_gate, *w_up, *w_down, *w_in, *gla_w_gate, *gla_b_gate, *gla_g_out, *swa_sink, *mla_g_q,
      *mla_g_kv, *w_qb, *w_kvb, *w_out;
  float* out;
  float *X, *F, *MOD, *ROPE_S, *ROPE_M, *GLA_B, *GLA_DL;
  bf16_t *H, *TWL, *TWC, *WGU, *WD, *WIN, *WOUT, *WQB, *WKVB, *ACT, *Z, *QS, *KS, *VS, *CKV, *QLAT, *KR, *QM, *KV, *ABTL,
      *ABTC, *GLA_S, *MIX;
};

constexpr size_t al256(size_t x) { return (x + 255) & ~(size_t)255; }
constexpr size_t OFF_X = 0;
constexpr size_t OFF_H = OFF_X + al256((size_t)M_TOT * DM * 4);
constexpr size_t OFF_MOD = OFF_H + al256((size_t)M_TOT * DM * 2);
constexpr size_t OFF_ROPE_S = OFF_MOD + al256((size_t)4 * 5 * 9216 * 4);
constexpr size_t OFF_ROPE_M = OFF_ROPE_S + al256(64 * 16 * 2 * 4);
constexpr size_t OFF_TWL = OFF_ROPE_M + al256(64 * 8 * 2 * 4);
constexpr size_t OFF_TWC = OFF_TWL + al256((size_t)4096 * 8192 * 2);
constexpr size_t OFF_WGU = OFF_TWC + al256((size_t)256 * 512 * 2);
constexpr size_t OFF_WD = OFF_WGU + al256((size_t)2 * 5632 * 1024 * 2);
constexpr size_t OFF_WIN = OFF_WD + al256((size_t)2 * 1024 * DFF * 2);
constexpr size_t OFF_WOUT = OFF_WIN + al256((size_t)2304 * 1024 * 2);
constexpr size_t OFF_WQB = OFF_WOUT + al256((size_t)1024 * 1024 * 2);
constexpr size_t OFF_WKVB = OFF_WQB + al256((size_t)384 * 256 * 2);
constexpr size_t OFF_Z = OFF_WKVB + al256((size_t)512 * 128 * 2);
constexpr size_t OFF_QS = OFF_Z + al256((size_t)M_TOT * DIN * 2);
constexpr size_t OFF_KS = OFF_QS + al256((size_t)M_TOT * 256 * 2);
constexpr size_t OFF_VS = OFF_KS + al256((size_t)M_EXT * 128 * 2);
constexpr size_t OFF_CKV = OFF_VS + al256((size_t)M_EXT * 128 * 2);
constexpr size_t OFF_QLAT = OFF_CKV + al256((size_t)M_EXT * 128 * 2);
constexpr size_t OFF_KR = OFF_QLAT + al256((size_t)M_TOT * 256 * 2);
constexpr size_t OFF_QM = OFF_KR + al256((size_t)M_EXT * 32 * 2);
constexpr size_t OFF_KV = OFF_QM + al256((size_t)M_TOT * 384 * 2);
constexpr size_t OFF_ABTL = OFF_KV + al256((size_t)M_EXT * 512 * 2);
constexpr size_t OFF_ABTC = OFF_ABTL + al256((size_t)4 * 256 * 8192 * 2);
constexpr size_t OFF_GLA_B = OFF_ABTC + al256((size_t)16 * 256 * 512 * 2);
constexpr size_t OFF_GLA_DL = OFF_GLA_B + al256((size_t)2560 * 4096 * 4);
constexpr size_t OFF_GLA_S = OFF_GLA_DL + al256((size_t)2560 * 64 * 4);
constexpr size_t OFF_MIX = OFF_GLA_S + al256((size_t)2560 * 4096 * 2);
constexpr size_t OFF_BAR = OFF_MIX + al256((size_t)M_TOT * 1024 * 2);
constexpr size_t OFF_END0 = OFF_BAR + al256(16384);
constexpr size_t OFF_ACTEND = OFF_QS + al256((size_t)M_TOT * DFF * 2);
constexpr size_t WS_NEED = OFF_END0 > OFF_ACTEND ? OFF_END0 : OFF_ACTEND;
struct PArg { const float* in[25]; float* out; unsigned char* ws; };
DI Params make_params(const PArg& a) {
  Params p;
  p.x_prompt = a.in[0];
  p.x_sample = a.in[1];
  p.c = a.in[2];
  p.state_gla = a.in[3];
  p.cache_swa_k = a.in[4];
  p.cache_swa_v = a.in[5];
  p.cache_mla_ckv = a.in[6];
  p.cache_mla_krope = a.in[7];
  p.c_ctx = a.in[8];
  p.w_mod = a.in[9];
  p.b_mod = a.in[10];
  p.g_norm = a.in[11];
  p.w_gate = a.in[12];
  p.w_up = a.in[13];
  p.w_down = a.in[14];
  p.w_in = a.in[15];
  p.gla_w_gate = a.in[16];
  p.gla_b_gate = a.in[17];
  p.gla_g_out = a.in[18];
  p.swa_sink = a.in[19];
  p.mla_g_q = a.in[20];
  p.mla_g_kv = a.in[21];
  p.w_qb = a.in[22];
  p.w_kvb = a.in[23];
  p.w_out = a.in[24];
  p.out = a.out;
  p.X = (float*)(a.ws + OFF_X);
  p.H = (bf16_t*)(a.ws + OFF_H);
  p.MOD = (float*)(a.ws + OFF_MOD);
  p.ROPE_S = (float*)(a.ws + OFF_ROPE_S);
  p.ROPE_M = (float*)(a.ws + OFF_ROPE_M);
  p.TWL = (bf16_t*)(a.ws + OFF_TWL);
  p.TWC = (bf16_t*)(a.ws + OFF_TWC);
  p.WGU = (bf16_t*)(a.ws + OFF_WGU);
  p.WD = (bf16_t*)(a.ws + OFF_WD);
  p.WIN = (bf16_t*)(a.ws + OFF_WIN);
  p.WOUT = (bf16_t*)(a.ws + OFF_WOUT);
  p.WQB = (bf16_t*)(a.ws + OFF_WQB);
  p.WKVB = (bf16_t*)(a.ws + OFF_WKVB);
  p.Z = (bf16_t*)(a.ws + OFF_Z);
  p.QS = (bf16_t*)(a.ws + OFF_QS);
  p.KS = (bf16_t*)(a.ws + OFF_KS);
  p.VS = (bf16_t*)(a.ws + OFF_VS);
  p.CKV = (bf16_t*)(a.ws + OFF_CKV);
  p.QLAT = (bf16_t*)(a.ws + OFF_QLAT);
  p.KR = (bf16_t*)(a.ws + OFF_KR);
  p.QM = (bf16_t*)(a.ws + OFF_QM);
  p.KV = (bf16_t*)(a.ws + OFF_KV);
  p.ABTL = (bf16_t*)(a.ws + OFF_ABTL);
  p.ABTC = (bf16_t*)(a.ws + OFF_ABTC);
  p.GLA_B = (float*)(a.ws + OFF_GLA_B);
  p.GLA_DL = (float*)(a.ws + OFF_GLA_DL);
  p.GLA_S = (bf16_t*)(a.ws + OFF_GLA_S);
  p.MIX = (bf16_t*)(a.ws + OFF_MIX);
  p.F = (float*)(a.ws + OFF_Z);
  p.ACT = (bf16_t*)(a.ws + OFF_QS);
  return p;
}

DI int ltid() { int t = __builtin_amdgcn_workitem_id_x(); asm volatile("" : "+v"(t)); return t; }
DI int lbid() { int t = __builtin_amdgcn_workgroup_id_x(); asm volatile("" : "+s"(t)); return t; }
DI bf16_t f2bf(float x) { unsigned u = __float_as_uint(x); u += 0x7fffu + ((u >> 16) & 1u); return (bf16_t)(u >> 16); }
DI float bf2f(bf16_t b) { return __uint_as_float(((unsigned)b) << 16); }
DI unsigned pack2(float a, float b) { return (unsigned)f2bf(a) | ((unsigned)f2bf(b) << 16); }
DI float wave_sum(float v) {
#pragma unroll
  for (int o = 32; o > 0; o >>= 1) v += __shfl_xor(v, o);
  return v;
}
DI float silu_f(float x) { return x / (1.f + __expf(-x)); }
DI int crow(int r, int h) { return (r & 3) + 8 * (r >> 2) + 4 * h; }


#define XB_TMO      128
#define XB_XCNT(j)  (256  + 64 * (j))
#define XB_XSUB(j)  (1280 + 64 * (j))
#define XB_XGEN(j)  (2304 + 64 * (j))
#define XB_TOP      3328
#define XB_TOPGEN   3392
#define XCD_BAR_WORDS 3456
#define XB_SPIN_CAP (1u << 22)
#define LAS __attribute__((address_space(3)))
DI unsigned xb_ld(unsigned* p) { return __hip_atomic_load(p, __ATOMIC_RELAXED, __HIP_MEMORY_SCOPE_AGENT); }
DI unsigned xb_add(unsigned* p, unsigned v) { return __hip_atomic_fetch_add(p, v, __ATOMIC_RELAXED, __HIP_MEMORY_SCOPE_AGENT); }
DI unsigned xb_xcc_id() { return (unsigned)__builtin_amdgcn_s_getreg((3 << 11) | 20) & 0xFu; }
#define XB_SPIN(cond, bar) do { unsigned _sp = 0; while (cond) { __builtin_amdgcn_s_sleep(1); \
    if ((++_sp & 255u) == 0u) { if (xb_ld(&(bar)[XB_TMO])) break; if (_sp > XB_SPIN_CAP) { atomicAdd(&(bar)[XB_TMO], 1u); break; } } } } while (0)
struct XcdBarrier { unsigned* bar; unsigned x; volatile LAS unsigned* st; };
DI XcdBarrier xcd_barrier_post(unsigned* bar, volatile LAS unsigned* st) {
  XcdBarrier b; b.bar = bar; b.x = xb_xcc_id(); b.st = st;
  if (threadIdx.x == 0) (void)xb_add(&bar[XB_XCNT(b.x)], 1u);
  return b;
}
DI void xcd_barrier_complete(unsigned* bar, unsigned x, unsigned& nloc, unsigned& nx) {
  const unsigned G = gridDim.x * gridDim.y * gridDim.z;
  unsigned sum, cnt, mine, sp = 0u;
  for (;;) {
    sum = 0u; cnt = 0u; mine = 0u;
#pragma unroll
    for (unsigned j = 0; j < 16; ++j) { const unsigned c = xb_ld(&bar[XB_XCNT(j)]); sum += c; cnt += (c > 0u) ? 1u : 0u; mine = (j == x) ? c : mine; }
    if (sum == G) break;
    __builtin_amdgcn_s_sleep(1);
    if ((++sp & 255u) == 0u) { if (xb_ld(&bar[XB_TMO])) break; if (sp > XB_SPIN_CAP) { atomicAdd(&bar[XB_TMO], 1u); break; } }
  }
  nloc = mine > 0u ? mine : 1u; nx = cnt > 0u ? cnt : 1u;
}
DI void xcd_barrier(const XcdBarrier& b) {
  asm volatile("s_waitcnt vmcnt(0)" ::: "memory");
  __syncthreads();
  if (threadIdx.x == 0) {
    unsigned* bar = b.bar;
    __builtin_amdgcn_s_waitcnt(0);
    unsigned nloc = b.st[0], nx = b.st[1];
    if (nloc == 0u) { xcd_barrier_complete(bar, b.x, nloc, nx); b.st[0] = nloc; b.st[1] = nx; }
    const unsigned old = xb_add(&bar[XB_XSUB(b.x)], 1u);
    const unsigned gen = old / nloc;
    if (old + 1u == (gen + 1u) * nloc) {
      __builtin_amdgcn_fence(__ATOMIC_RELEASE, "agent");
      asm volatile("s_waitcnt vmcnt(0)" ::: "memory");
      const unsigned og = xb_add(&bar[XB_TOP], 1u);
      const unsigned tg = og / nx;
      if (og + 1u == (tg + 1u) * nx) xb_add(&bar[XB_TOPGEN], 1u);
      else XB_SPIN(xb_ld(&bar[XB_TOPGEN]) == tg, bar);
      __builtin_amdgcn_fence(__ATOMIC_ACQUIRE, "agent");
      xb_add(&bar[XB_XGEN(b.x)], 1u);
      asm volatile("s_waitcnt vmcnt(0)" ::: "memory");
    } else {
      XB_SPIN(xb_ld(&bar[XB_XGEN(b.x)]) == gen, bar);
      __builtin_amdgcn_fence(__ATOMIC_ACQUIRE, "agent");
      asm volatile("s_waitcnt vmcnt(0)" ::: "memory");
    }
  }
  __syncthreads();
}

template <class Epi>
DI void gemm_tile(const bf16_t* __restrict__ A, int lda, const bf16_t* __restrict__ Bt, int ldb, int K, int m0, int n0,
                  unsigned char* smem, const Epi& epi) {
  bf16_t* sA = (bf16_t*)smem;
  bf16_t* sB = sA + 128 * PITCH;
  const int tid = ltid(), lane = tid & 63, wid = tid >> 6, wm = wid >> 1, wn = wid & 1, l31 = lane & 31, h = lane >> 5;
  f32x16 acc[2][2];
#pragma unroll
  for (int a = 0; a < 2; ++a)
#pragma unroll
    for (int b = 0; b < 2; ++b)
#pragma unroll
      for (int i = 0; i < 16; ++i) acc[a][b][i] = 0.f;
  const int lrow = tid >> 3, lkc = tid & 7;
  u32x4 ra0, ra1, ra2, ra3, rb0, rb1, rb2, rb3, qa0, qa1, qa2, qa3, qb0, qb1, qb2, qb3;
  const bf16_t* Ap = A + (size_t)(m0 + lrow) * lda + lkc * 8;
  const bf16_t* Bp = Bt + (size_t)(n0 + lrow) * ldb + lkc * 8;
  const size_t sa32 = (size_t)32 * lda, sb32 = (size_t)32 * ldb;
#define GLOADP(kk) { const bf16_t* a2 = Ap + (kk); const bf16_t* b2 = Bp + (kk); \
    ra0 = *(const u32x4*)(a2); ra1 = *(const u32x4*)(a2 + sa32); ra2 = *(const u32x4*)(a2 + 2 * sa32); ra3 = *(const u32x4*)(a2 + 3 * sa32); \
    rb0 = *(const u32x4*)(b2); rb1 = *(const u32x4*)(b2 + sb32); rb2 = *(const u32x4*)(b2 + 2 * sb32); rb3 = *(const u32x4*)(b2 + 3 * sb32); }
#define GLOADQ(kk) { const bf16_t* a2 = Ap + (kk); const bf16_t* b2 = Bp + (kk); \
    qa0 = *(const u32x4*)(a2); qa1 = *(const u32x4*)(a2 + sa32); qa2 = *(const u32x4*)(a2 + 2 * sa32); qa3 = *(const u32x4*)(a2 + 3 * sa32); \
    qb0 = *(const u32x4*)(b2); qb1 = *(const u32x4*)(b2 + sb32); qb2 = *(const u32x4*)(b2 + 2 * sb32); qb3 = *(const u32x4*)(b2 + 3 * sb32); }
#define GCOMPUTE() _Pragma("unroll") for (int ks = 0; ks < 4; ++ks) { \
      bf16x8 af0 = *(const bf16x8*)(sA + (wm * 64 + l31) * PITCH + ks * 16 + h * 8); \
      bf16x8 af1 = *(const bf16x8*)(sA + (wm * 64 + 32 + l31) * PITCH + ks * 16 + h * 8); \
      bf16x8 bf0 = *(const bf16x8*)(sB + (wn * 64 + l31) * PITCH + ks * 16 + h * 8); \
      bf16x8 bf1 = *(const bf16x8*)(sB + (wn * 64 + 32 + l31) * PITCH + ks * 16 + h * 8); \
      acc[0][0] = MFMA32(bf0, af0, acc[0][0]); acc[0][1] = MFMA32(bf0, af1, acc[0][1]); \
      acc[1][0] = MFMA32(bf1, af0, acc[1][0]); acc[1][1] = MFMA32(bf1, af1, acc[1][1]); }
  bf16_t* wA = sA + lrow * PITCH + lkc * 8;
  bf16_t* wB = sB + lrow * PITCH + lkc * 8;
  GLOADP(0);
  GLOADQ(64);
  for (int k0 = 0; k0 < K; k0 += 128) {
    __syncthreads();
    *(u32x4*)(wA) = ra0; *(u32x4*)(wA + 32 * PITCH) = ra1; *(u32x4*)(wA + 64 * PITCH) = ra2; *(u32x4*)(wA + 96 * PITCH) = ra3;
    *(u32x4*)(wB) = rb0; *(u32x4*)(wB + 32 * PITCH) = rb1; *(u32x4*)(wB + 64 * PITCH) = rb2; *(u32x4*)(wB + 96 * PITCH) = rb3;
    __syncthreads();
    { const int kn = (k0 + 128 < K) ? k0 + 128 : k0; GLOADP(kn); }
    GCOMPUTE();
    __syncthreads();
    *(u32x4*)(wA) = qa0; *(u32x4*)(wA + 32 * PITCH) = qa1; *(u32x4*)(wA + 64 * PITCH) = qa2; *(u32x4*)(wA + 96 * PITCH) = qa3;
    *(u32x4*)(wB) = qb0; *(u32x4*)(wB + 32 * PITCH) = qb1; *(u32x4*)(wB + 64 * PITCH) = qb2; *(u32x4*)(wB + 96 * PITCH) = qb3;
    __syncthreads();
    { const int kn = (k0 + 192 < K) ? k0 + 192 : k0 + 64; GLOADQ(kn); }
    GCOMPUTE();
  }
#undef GLOADP
#undef GLOADQ
#undef GCOMPUTE
  epi(acc, m0 + wm * 64, n0 + wn * 64, l31, h);
}

struct EpiF32 {
  float* C; int ldc;
  DI void operator()(const f32x16 (&acc)[2][2], int mb0, int nb0, int l31, int h) const {
#pragma unroll
    for (int nb = 0; nb < 2; ++nb)
#pragma unroll
      for (int mb = 0; mb < 2; ++mb) {
        float* row = C + (size_t)(mb0 + mb * 32 + l31) * ldc + nb0 + nb * 32 + 4 * h;
#pragma unroll
        for (int g = 0; g < 4; ++g)
          *(float4*)(row + 8 * g) = make_float4(acc[nb][mb][4 * g], acc[nb][mb][4 * g + 1], acc[nb][mb][4 * g + 2], acc[nb][mb][4 * g + 3]);
      }
  }
};
struct EpiBf16 {
  bf16_t* C; int ldc; float scale; int ncols;
  DI void operator()(const f32x16 (&acc)[2][2], int mb0, int nb0, int l31, int h) const {
#pragma unroll
    for (int nb = 0; nb < 2; ++nb)
#pragma unroll
      for (int mb = 0; mb < 2; ++mb) {
        const int col0 = nb0 + nb * 32 + 4 * h;
        bf16_t* row = C + (size_t)(mb0 + mb * 32 + l31) * ldc + col0;
#pragma unroll
        for (int g = 0; g < 4; ++g) {
          if (col0 + 8 * g < ncols) {
            uint2 w;
            w.x = pack2(acc[nb][mb][4 * g] * scale, acc[nb][mb][4 * g + 1] * scale);
            w.y = pack2(acc[nb][mb][4 * g + 2] * scale, acc[nb][mb][4 * g + 3] * scale);
            *(uint2*)(row + 8 * g) = w;
          }
        }
      }
  }
};
struct EpiGateUp {
  bf16_t* C;
  DI void operator()(const f32x16 (&acc)[2][2], int mb0, int nb0, int l31, int h) const {
#pragma unroll
    for (int mb = 0; mb < 2; ++mb) {
      bf16_t* row = C + (size_t)(mb0 + mb * 32 + l31) * DFF + (nb0 >> 1) + 4 * h;
#pragma unroll
      for (int g = 0; g < 4; ++g) {
        float v[4];
#pragma unroll
        for (int i = 0; i < 4; ++i) v[i] = silu_f(acc[0][mb][4 * g + i]) * acc[1][mb][4 * g + i];
        uint2 w; w.x = pack2(v[0], v[1]); w.y = pack2(v[2], v[3]);
        *(uint2*)(row + 8 * g) = w;
      }
    }
  }
};
struct EpiWin {
  bf16_t* Z; float* out; int l;
  DI void operator()(const f32x16 (&acc)[2][2], int mb0, int nb0, int l31, int h) const {
#pragma unroll
    for (int nb = 0; nb < 2; ++nb)
#pragma unroll
      for (int mb = 0; mb < 2; ++mb) {
        const int m = mb0 + mb * 32 + l31;
        const int col0 = nb0 + nb * 32 + 4 * h;
        bf16_t* row = Z + (size_t)m * DIN + col0;
#pragma unroll
        for (int g = 0; g < 4; ++g) {
          const int col = col0 + 8 * g;
          if (col < DIN) {
            uint2 w;
            w.x = pack2(acc[nb][mb][4 * g], acc[nb][mb][4 * g + 1]);
            w.y = pack2(acc[nb][mb][4 * g + 2], acc[nb][mb][4 * g + 3]);
            *(uint2*)(row + 8 * g) = w;
            if (m < M_CTX) {
              const int b = m >> 8, s = m & 255;
              const size_t tok = (size_t)((b * 4 + l) * 256 + s);
              float* dst = nullptr;
              if (col >= ZKS && col < ZVS) dst = out + O_SK + tok * 128 + (col - ZKS);
              else if (col >= ZVS && col < ZF) dst = out + O_SV + tok * 128 + (col - ZVS);
              else if (col >= ZKR) dst = out + O_KR + tok * 32 + (col - ZKR);
              if (dst) *(float4*)dst = make_float4(acc[nb][mb][4 * g], acc[nb][mb][4 * g + 1], acc[nb][mb][4 * g + 2], acc[nb][mb][4 * g + 3]);
            }
          }
        }
      }
  }
};
struct EpiQm {
  bf16_t* C; const float* rope_m;
  DI void operator()(const f32x16 (&acc)[2][2], int mb0, int nb0, int l31, int h) const {
#pragma unroll
    for (int nb = 0; nb < 2; ++nb) {
      const int cb = nb0 + nb * 32;
      const bool isrope = ((cb >> 5) % 3) == 2;
#pragma unroll
      for (int mb = 0; mb < 2; ++mb) {
        const int m = mb0 + mb * 32 + l31;
        float v[16];
#pragma unroll
        for (int i = 0; i < 16; ++i) v[i] = acc[nb][mb][i];
        if (isrope && m >= M_CTX) {
          const int t = (m - M_CTX) & 4095;
          const int prow = t >> 6, pcol = t & 63;
#pragma unroll
          for (int half = 0; half < 2; ++half) {
            const int pos = half ? pcol : prow;
#pragma unroll
            for (int i = 0; i < 4; ++i) {
              const int j = 4 * h + i;
              const float cs = rope_m[(pos * 8 + j) * 2], sn = rope_m[(pos * 8 + j) * 2 + 1];
              const float x1 = v[8 * half + i], x2 = v[8 * half + 4 + i];
              v[8 * half + i] = x1 * cs - x2 * sn;
              v[8 * half + 4 + i] = x2 * cs + x1 * sn;
            }
          }
        }
        bf16_t* row = C + (size_t)m * 384 + cb + 4 * h;
#pragma unroll
        for (int g = 0; g < 4; ++g) {
          uint2 w; w.x = pack2(v[4 * g], v[4 * g + 1]); w.y = pack2(v[4 * g + 2], v[4 * g + 3]);
          *(uint2*)(row + 8 * g) = w;
        }
      }
    }
  }
};

DI void mod_item(const Params& p, int it, unsigned char* smem) {
  float* sc = (float*)smem;
  float* red = sc + 5 * 1024;
  const int tid = ltid(), lane = tid & 63, wid = tid >> 6;
  const int l = it / 144, n = (it % 144) * 64 + lane;
  __syncthreads();
  for (int e = tid; e < 5 * 1024; e += NT) {
    const int i = e >> 10, k = e & 1023;
    const float v = i == 0 ? p.c_ctx[k] : p.c[(i - 1) * 1024 + k];
    sc[e] = v / (1.f + expf(-v));
  }
  __syncthreads();
  float a0 = 0, a1 = 0, a2 = 0, a3 = 0, a4 = 0;
  const float* w = p.w_mod + ((size_t)l * 1024 + wid * 256) * 9216 + n;
#pragma unroll 8
  for (int k = 0; k < 256; ++k) {
    const float wv = w[(size_t)k * 9216];
    const int kk = wid * 256 + k;
    a0 += sc[kk] * wv; a1 += sc[1024 + kk] * wv; a2 += sc[2048 + kk] * wv; a3 += sc[3072 + kk] * wv; a4 += sc[4096 + kk] * wv;
  }
  red[(wid * 5 + 0) * 64 + lane] = a0; red[(wid * 5 + 1) * 64 + lane] = a1; red[(wid * 5 + 2) * 64 + lane] = a2;
  red[(wid * 5 + 3) * 64 + lane] = a3; red[(wid * 5 + 4) * 64 + lane] = a4;
  __syncthreads();
  for (int e = tid; e < 320; e += NT) {
    const int i = e >> 6, cl = e & 63;
    float s = 0.f;
    for (int w4 = 0; w4 < 4; ++w4) s += red[(w4 * 5 + i) * 64 + cl];
    const int col = (it % 144) * 64 + cl;
    p.MOD[(size_t)(l * 5 + i) * 9216 + col] = s + p.b_mod[(size_t)l * 9216 + col];
  }
}

DI void phase_init(const Params& p, unsigned char* smem) {
  const int nb = gridDim.x, bid = lbid(), tid = ltid();
  for (int it = bid; it < 1602; it += nb) {
    if (it < 576) mod_item(p, it, smem);
    else if (it < 1600) {
      const int r0 = (it - 576) * 4;
      for (int e = tid; e < 4 * 1024; e += NT) {
        const int r = r0 + (e >> 10), k8 = (e & 1023) * 8;
        unsigned w[4];
#pragma unroll
        for (int j = 0; j < 4; ++j) {
          float v[2];
#pragma unroll
          for (int q = 0; q < 2; ++q) {
            const int k = k8 + 2 * j + q;
            const int idx = (r * (k & 4095)) & 4095;
            const float ang = (float)idx * (1.0f / 2048.0f);
            v[q] = k < 4096 ? cospif(ang) : -sinpif(ang);
          }
          w[j] = pack2(v[0], v[1]);
        }
        *(uint4*)(p.TWL + (size_t)r * 8192 + k8) = make_uint4(w[0], w[1], w[2], w[3]);
      }
    } else if (it == 1600) {
      for (int e = tid; e < 256 * 512; e += NT) {
        const int r = e >> 9, k = e & 511;
        const int idx = (r * (k & 255)) & 255;
        const float ang = (float)idx * (1.0f / 128.0f);
        p.TWC[e] = f2bf(k < 256 ? cospif(ang) : -sinpif(ang));
      }
    } else {
      for (int e = tid; e < 64 * 16; e += NT) {
        const int pos = e >> 4, j = e & 15;
        const float inv = powf(10000.0f, -(float)(2 * j) / 32.0f);
        const float ang = (float)pos * inv;
        p.ROPE_S[e * 2] = cosf(ang); p.ROPE_S[e * 2 + 1] = sinf(ang);
      }
      for (int e = tid; e < 64 * 8; e += NT) {
        const int pos = e >> 3, j = e & 7;
        const float inv = powf(10000.0f, -(float)(2 * j) / 16.0f);
        const float ang = (float)pos * inv;
        p.ROPE_M[e * 2] = cosf(ang); p.ROPE_M[e * 2 + 1] = sinf(ang);
      }
    }
  }
}

DI void conv_tile(const float* __restrict__ src, int N, bf16_t* __restrict__ dst, int K, int kt, int nt, int mode, unsigned char* smem) {
  float* ts = (float*)smem;
  const int tid = ltid();
  __syncthreads();
#pragma unroll
  for (int i = 0; i < 4; ++i) {
    const int r = (tid >> 4) + 16 * i, c4 = (tid & 15) * 4;
    const float4 v = *(const float4*)(src + (size_t)(kt * 64 + r) * N + nt * 64 + c4);
    ts[r * 65 + c4] = v.x; ts[r * 65 + c4 + 1] = v.y; ts[r * 65 + c4 + 2] = v.z; ts[r * 65 + c4 + 3] = v.w;
  }
  __syncthreads();
  const int nl = tid >> 2, ks = (tid & 3) * 16;
  const int n = nt * 64 + nl;
  int drow = n;
  if (mode == 1) drow = (n >> 5) * 64 + (n & 31);
  else if (mode == 2) drow = (n >> 5) * 64 + 32 + (n & 31);
  unsigned w[8];
#pragma unroll
  for (int j = 0; j < 8; ++j) w[j] = pack2(ts[(ks + 2 * j) * 65 + nl], ts[(ks + 2 * j + 1) * 65 + nl]);
  bf16_t* d = dst + (size_t)drow * K + kt * 64 + ks;
  *(uint4*)d = make_uint4(w[0], w[1], w[2], w[3]);
  *(uint4*)(d + 8) = make_uint4(w[4], w[5], w[6], w[7]);
}
DI void convert_layer(const Params& p, int l, unsigned char* smem) {
  for (int t = lbid(); t < 5080; t += gridDim.x) {
    if (t < 2816) {
      const int q = t / 704, r = t % 704, i = q >> 1, which = q & 1;
      const float* src = (which ? p.w_up : p.w_gate) + (size_t)(l * 2 + i) * 1024 * DFF;
      conv_tile(src, DFF, p.WGU + (size_t)i * 5632 * 1024, 1024, r / 44, r % 44, 1 + which, smem);
    } else if (t < 4224) {
      const int q = (t - 2816) / 704, r = (t - 2816) % 704;
      conv_tile(p.w_down + (size_t)(l * 2 + q) * DFF * 1024, 1024, p.WD + (size_t)q * 1024 * DFF, DFF, r / 16, r % 16, 0, smem);
    } else if (t < 4784) {
      const int r = t - 4224;
      conv_tile(p.w_in + (size_t)l * 1024 * DIN, DIN, p.WIN, 1024, r / 35, r % 35, 0, smem);
    } else if (t < 5040) {
      const int r = t - 4784;
      conv_tile(p.w_out + (size_t)l * 1024 * 1024, 1024, p.WOUT, 1024, r / 16, r % 16, 0, smem);
    } else if (t < 5064) {
      const int r = t - 5040;
      conv_tile(p.w_qb + (size_t)l * 256 * 384, 384, p.WQB, 256, r / 6, r % 6, 0, smem);
    } else {
      const int r = t - 5064;
      conv_tile(p.w_kvb + (size_t)l * 128 * 512, 512, p.WKVB, 128, r / 8, r % 8, 0, smem);
    }
  }
}

struct EwArgs {
  const float *xin_ctx, *xin_lat; float *xout_ctx, *xout_lat;
  const float* F; int lu, gate_idx, gpost_idx; float res_w;
  int do_norm, ln, sc_idx, sh_idx, gpre_idx;
};
DI void phase_ew(const Params& p, const EwArgs& a) {
  const int lane = ltid() & 63, gw = lbid() * NW + (ltid() >> 6), gs = gridDim.x * NW;
  for (int r = gw; r < M_TOT; r += gs) {
    const int mi = r < M_CTX ? 0 : 1 + ((r - M_CTX) >> 12);
    const float* xs = r < M_CTX ? a.xin_ctx + (size_t)r * DM : a.xin_lat + (size_t)(r - M_CTX) * DM;
    float4 x[4];
#pragma unroll
    for (int j = 0; j < 4; ++j) x[j] = *(const float4*)(xs + lane * 4 + 256 * j);
    if (a.F) {
      const float* fr = a.F + (size_t)r * DM;
      const float* gate = p.MOD + (size_t)(a.lu * 5 + mi) * 9216 + a.gate_idx * 1024;
      const float* gp = p.g_norm + (size_t)(a.lu * 6 + a.gpost_idx) * 1024;
      float4 f[4]; float ss = 0.f;
#pragma unroll
      for (int j = 0; j < 4; ++j) { f[j] = *(const float4*)(fr + lane * 4 + 256 * j); ss += f[j].x * f[j].x + f[j].y * f[j].y + f[j].z * f[j].z + f[j].w * f[j].w; }
      ss = wave_sum(ss);
      const float rs = rsqrtf(ss * (1.f / 1024.f) + EPS) * a.res_w;
      float* xo = r < M_CTX ? a.xout_ctx + (size_t)r * DM : a.xout_lat + (size_t)(r - M_CTX) * DM;
#pragma unroll
      for (int j = 0; j < 4; ++j) {
        const float4 g = *(const float4*)(gate + lane * 4 + 256 * j), q = *(const float4*)(gp + lane * 4 + 256 * j);
        x[j].x += g.x * (f[j].x * rs * q.x); x[j].y += g.y * (f[j].y * rs * q.y); x[j].z += g.z * (f[j].z * rs * q.z); x[j].w += g.w * (f[j].w * rs * q.w);
        *(float4*)(xo + lane * 4 + 256 * j) = x[j];
      }
    }
    if (a.do_norm) {
      float ss = 0.f;
#pragma unroll
      for (int j = 0; j < 4; ++j) ss += x[j].x * x[j].x + x[j].y * x[j].y + x[j].z * x[j].z + x[j].w * x[j].w;
      ss = wave_sum(ss);
      const float rs = rsqrtf(ss * (1.f / 1024.f) + EPS);
      const float* sc = p.MOD + (size_t)(a.ln * 5 + mi) * 9216 + a.sc_idx * 1024;
      const float* sh = p.MOD + (size_t)(a.ln * 5 + mi) * 9216 + a.sh_idx * 1024;
      const float* gp = p.g_norm + (size_t)(a.ln * 6 + a.gpre_idx) * 1024;
      bf16_t* hr = p.H + (size_t)r * DM;
#pragma unroll
      for (int j = 0; j < 4; ++j) {
        const float4 s = *(const float4*)(sc + lane * 4 + 256 * j), t = *(const float4*)(sh + lane * 4 + 256 * j), q = *(const float4*)(gp + lane * 4 + 256 * j);
        uint2 w;
        w.x = pack2(x[j].x * rs * q.x * (1.f + s.x) + t.x, x[j].y * rs * q.y * (1.f + s.y) + t.y);
        w.y = pack2(x[j].z * rs * q.z * (1.f + s.z) + t.z, x[j].w * rs * q.w * (1.f + s.w) + t.w);
        *(uint2*)(hr + lane * 4 + 256 * j) = w;
      }
    }
  }
}

DI void prep_item(const Params& p, int l, int it, unsigned char* smem) {
  const int tid = ltid(), lane = tid & 63, wid = tid >> 6;
  const int r0 = it * 32;
  if (r0 >= M_TOT) {
    for (int e = tid; e < 32 * 128; e += NT) {
      const int rr = e >> 7, cc = e & 127, idx = r0 - M_TOT + rr, b = idx >> 8, j = idx & 255;
      const size_t src = ((size_t)(b * 4 + l) * 256 + j) * 128 + cc;
      const size_t dst = (size_t)(r0 + rr) * 128 + cc;
      p.KS[dst] = f2bf(p.cache_swa_k[src]);
      p.VS[dst] = f2bf(p.cache_swa_v[src]);
      p.CKV[dst] = f2bf(p.cache_mla_ckv[src]);
    }
    for (int e = tid; e < 32 * 32; e += NT) {
      const int rr = e >> 5, cc = e & 31, idx = r0 - M_TOT + rr, b = idx >> 8, j = idx & 255;
      p.KR[(size_t)(r0 + rr) * 32 + cc] = f2bf(p.cache_mla_krope[((size_t)(b * 4 + l) * 256 + j) * 32 + cc]);
    }
    return;
  }
  const bool lat = r0 >= M_CTX;
  for (int e = tid; e < 32 * 128; e += NT) {
    const int rr = e >> 7, rem = e & 127, head = rem >> 5, half = (rem >> 4) & 1, j = rem & 15;
    const int r = r0 + rr;
    const bf16_t* z = p.Z + (size_t)r * DIN;
    const int d1 = head * 64 + half * 32 + j, d2 = d1 + 16;
    float x1 = bf2f(z[ZQS + d1]), x2 = bf2f(z[ZQS + d2]);
    float cs = 1.f, sn = 0.f;
    if (lat) { const int t = (r - M_CTX) & 4095; const int pos = half ? (t & 63) : (t >> 6); cs = p.ROPE_S[(pos * 16 + j) * 2]; sn = p.ROPE_S[(pos * 16 + j) * 2 + 1]; }
    p.QS[(size_t)r * 256 + d1] = f2bf((x1 * cs - x2 * sn) * 0.125f);
    p.QS[(size_t)r * 256 + d2] = f2bf((x2 * cs + x1 * sn) * 0.125f);
    if (head < 2) {
      x1 = bf2f(z[ZKS + d1]); x2 = bf2f(z[ZKS + d2]);
      p.KS[(size_t)r * 128 + d1] = f2bf(x1 * cs - x2 * sn);
      p.KS[(size_t)r * 128 + d2] = f2bf(x2 * cs + x1 * sn);
      p.VS[(size_t)r * 128 + d1] = z[ZVS + d1];
      p.VS[(size_t)r * 128 + d2] = z[ZVS + d2];
    }
  }
  for (int e = tid; e < 32 * 16; e += NT) {
    const int rr = e >> 4, half = (e >> 3) & 1, j = e & 7, r = r0 + rr;
    const bf16_t* z = p.Z + (size_t)r * DIN + ZKR;
    const int d1 = half * 16 + j, d2 = d1 + 8;
    const float x1 = bf2f(z[d1]), x2 = bf2f(z[d2]);
    float cs = 1.f, sn = 0.f;
    if (lat) { const int t = (r - M_CTX) & 4095; const int pos = half ? (t & 63) : (t >> 6); cs = p.ROPE_M[(pos * 8 + j) * 2]; sn = p.ROPE_M[(pos * 8 + j) * 2 + 1]; }
    p.KR[(size_t)r * 32 + d1] = f2bf(x1 * cs - x2 * sn);
    p.KR[(size_t)r * 32 + d2] = f2bf(x2 * cs + x1 * sn);
  }
  for (int rr = wid; rr < 32; rr += NW) {
    const int r = r0 + rr;
    const bf16_t* z = p.Z + (size_t)r * DIN;
    {
      const float a = bf2f(z[ZKVA + lane]), b = bf2f(z[ZKVA + 64 + lane]);
      const float rs = rsqrtf(wave_sum(a * a + b * b) * (1.f / 128.f) + EPS);
      const float o0 = a * rs * p.mla_g_kv[l * 128 + lane], o1 = b * rs * p.mla_g_kv[l * 128 + 64 + lane];
      p.CKV[(size_t)r * 128 + lane] = f2bf(o0); p.CKV[(size_t)r * 128 + 64 + lane] = f2bf(o1);
      if (!lat) {
        const int b_ = r >> 8, s = r & 255;
        float* dst = p.out + O_CKV + ((size_t)(b_ * 4 + l) * 256 + s) * 128;
        dst[lane] = o0; dst[64 + lane] = o1;
      }
    }
    {
      float v[4]; float ss = 0.f;
#pragma unroll
      for (int j = 0; j < 4; ++j) { v[j] = bf2f(z[ZQA + lane + 64 * j]); ss += v[j] * v[j]; }
      const float rs = rsqrtf(wave_sum(ss) * (1.f / 256.f) + EPS);
#pragma unroll
      for (int j = 0; j < 4; ++j) p.QLAT[(size_t)r * 256 + lane + 64 * j] = f2bf(v[j] * rs * p.mla_g_q[l * 256 + lane + 64 * j]);
    }
  }
  {
    float* tw = (float*)smem;
    __syncthreads();
    if (tid < 64) tw[tid] = cospif((float)tid * (1.f / 32.f));
    __syncthreads();
    const int tk = tid & 31, og = tid >> 5, g = og >> 1, type = og & 1;
    const int r = r0 + tk;
    float zr[64];
    {
      const uint4* zp = (const uint4*)(p.Z + (size_t)r * DIN + ZF + g * 64);
#pragma unroll
      for (int q = 0; q < 8; ++q) {
        const uint4 u = zp[q];
        const unsigned uu[4] = {u.x, u.y, u.z, u.w};
#pragma unroll
        for (int j = 0; j < 4; ++j) { zr[q * 8 + 2 * j] = __uint_as_float(uu[j] << 16); zr[q * 8 + 2 * j + 1] = __uint_as_float(uu[j] & 0xffff0000u); }
      }
    }
    bf16_t* dst;
    int dstride;
    if (lat) { const int b = (r - M_CTX) >> 12, s = (r - M_CTX) & 4095; dst = p.ABTL + ((size_t)b * 256 + g * 64) * 8192 + type * 4096 + s; dstride = 8192; }
    else { const int b = r >> 8, s = r & 255; dst = p.ABTC + ((size_t)b * 256 + g * 64) * 512 + type * 256 + s; dstride = 512; }
    const int off = type ? 48 : 0;
    for (int cp = 0; cp < 64; ++cp) {
      float acc = 0.f; int idx = off;
#pragma unroll
      for (int c = 0; c < 64; ++c) { acc += zr[c] * tw[idx & 63]; idx += cp; }
      dst[(size_t)cp * dstride] = f2bf(acc);
    }
  }
}

DI void gla_cum(const Params& p, int l, int head, int dir, int row0, int rstep, float* sa, float* qt, f32x16& cum, float& last) {
  const int tid = ltid(), dk = tid & 63, quarter = tid >> 6;
  __syncthreads();
  for (int e = tid; e < 64 * 16; e += NT) {
    const int i = e >> 4, rr = e & 15;
    sa[e] = bf2f(p.Z[(size_t)(row0 + i * rstep) * DIN + ZAF + dir * 16 + rr]);
  }
  __syncthreads();
  float wg[16];
  const float* W = p.gla_w_gate + ((size_t)(l * 2 + dir) * 16) * 256 + head * 64 + dk;
#pragma unroll
  for (int rr = 0; rr < 16; ++rr) wg[rr] = W[rr * 256];
  const float bg = p.gla_b_gate[(l * 2 + dir) * 256 + head * 64 + dk];
  float run = 0.f;
#pragma unroll
  for (int ii = 0; ii < 16; ++ii) {
    const int i = quarter * 16 + ii;
    float lg = bg;
#pragma unroll
    for (int rr = 0; rr < 16; ++rr) lg += sa[i * 16 + rr] * wg[rr];
    const float ls = -(fmaxf(-lg, 0.f) + log1pf(expf(-fabsf(lg))));
    run += ls * (1.f / 16.f);
    cum[ii] = run;
  }
  qt[quarter * 64 + dk] = run;
  __syncthreads();
  float offs = 0.f, tot = 0.f;
#pragma unroll
  for (int q = 0; q < 4; ++q) { const float v = qt[q * 64 + dk]; tot += v; if (q < quarter) offs += v; }
#pragma unroll
  for (int ii = 0; ii < 16; ++ii) cum[ii] += offs;
  last = tot;
}

DI void gla_seq_info(int sq_global, int& grp, int& b, int& head, int& dir, int& S, int& base) {
  if (sq_global < 32) { grp = 1; b = sq_global >> 3; head = (sq_global >> 1) & 3; dir = sq_global & 1; S = 4096; base = M_CTX + b * 4096; }
  else { const int s = sq_global - 32; grp = 0; b = s >> 3; head = (s >> 1) & 3; dir = s & 1; S = 256; base = b * 256; }
}

DI void gla_pass_a(const Params& p, int l, int ci, unsigned char* smem) {
  float* sa = (float*)smem;
  float* qt = sa + 1024;
  bf16_t* kdT = (bf16_t*)(qt + 256);
  bf16_t* vT = kdT + 64 * PITCH;
  const int tid = ltid(), lane = tid & 63, wid = tid >> 6, dk = tid & 63, quarter = tid >> 6, l31 = lane & 31, h = lane >> 5;
  int sqg, c;
  if (ci < 2048) { sqg = ci >> 6; c = ci & 63; } else { sqg = 32 + ((ci - 2048) >> 2); c = (ci - 2048) & 3; }
  int grp, b, head, dir, S, base;
  gla_seq_info(sqg, grp, b, head, dir, S, base);
  const int row0 = dir ? base + S - 1 - 64 * c : base + 64 * c, rstep = dir ? -1 : 1;
  f32x16 cum; float last;
  gla_cum(p, l, head, dir, row0, rstep, sa, qt, cum, last);
  unsigned kw[8], vw[8];
#pragma unroll
  for (int j = 0; j < 8; ++j) {
    float kv[2], vv[2];
#pragma unroll
    for (int q = 0; q < 2; ++q) {
      const int ii = 2 * j + q, i = quarter * 16 + ii;
      const bf16_t* z = p.Z + (size_t)(row0 + i * rstep) * DIN;
      kv[q] = bf2f(z[ZKG + head * 64 + dk]) * expf(last - cum[ii]);
      vv[q] = bf2f(z[ZVG + head * 64 + dk]);
    }
    kw[j] = pack2(kv[0], kv[1]); vw[j] = pack2(vv[0], vv[1]);
  }
  *(uint4*)(kdT + dk * PITCH + quarter * 16) = make_uint4(kw[0], kw[1], kw[2], kw[3]);
  *(uint4*)(kdT + dk * PITCH + quarter * 16 + 8) = make_uint4(kw[4], kw[5], kw[6], kw[7]);
  *(uint4*)(vT + dk * PITCH + quarter * 16) = make_uint4(vw[0], vw[1], vw[2], vw[3]);
  *(uint4*)(vT + dk * PITCH + quarter * 16 + 8) = make_uint4(vw[4], vw[5], vw[6], vw[7]);
  if (quarter == 0) p.GLA_DL[(size_t)ci * 64 + dk] = expf(last);
  __syncthreads();
  const int wr = wid >> 1, wc = wid & 1;
  f32x16 acc;
#pragma unroll
  for (int i = 0; i < 16; ++i) acc[i] = 0.f;
#pragma unroll
  for (int ks = 0; ks < 4; ++ks) {
    const bf16x8 a = *(const bf16x8*)(kdT + (wr * 32 + l31) * PITCH + ks * 16 + h * 8);
    const bf16x8 bb = *(const bf16x8*)(vT + (wc * 32 + l31) * PITCH + ks * 16 + h * 8);
    acc = MFMA32(a, bb, acc);
  }
  float* Bc = p.GLA_B + (size_t)ci * 4096;
#pragma unroll
  for (int i = 0; i < 16; ++i) Bc[(wr * 32 + crow(i, h)) * 64 + wc * 32 + l31] = acc[i];
}

DI void gla_pass_b(const Params& p, int l, int sqg) {
  const int tid = ltid(), dv = tid >> 2, dk0 = (tid & 3) * 16;
  int grp, b, head, dir, S, base;
  gla_seq_info(sqg, grp, b, head, dir, S, base);
  const int nch = S >> 6;
  const int ci0 = grp ? sqg * 64 : 2048 + (sqg - 32) * 4;
  f32x16 s;
  if (grp) {
    const float* s0 = p.state_gla + ((((size_t)b * 4 + l) * 2 + dir) * 4 + head) * 4096;
#pragma unroll
    for (int j = 0; j < 16; ++j) s[j] = s0[(dk0 + j) * 64 + dv];
  } else {
#pragma unroll
    for (int j = 0; j < 16; ++j) s[j] = 0.f;
  }
  for (int c = 0; c < nch; ++c) {
    const size_t ci = ci0 + c;
    unsigned w[8];
#pragma unroll
    for (int j = 0; j < 8; ++j) w[j] = pack2(s[2 * j], s[2 * j + 1]);
    bf16_t* Sd = p.GLA_S + ci * 4096 + dv * 64 + dk0;
    *(uint4*)Sd = make_uint4(w[0], w[1], w[2], w[3]);
    *(uint4*)(Sd + 8) = make_uint4(w[4], w[5], w[6], w[7]);
    const float* Bc = p.GLA_B + ci * 4096;
    const float* dl = p.GLA_DL + ci * 64;
#pragma unroll
    for (int j = 0; j < 16; ++j) s[j] = dl[dk0 + j] * s[j] + Bc[(dk0 + j) * 64 + dv];
  }
  if (!grp) {
    float* so = p.out + O_ST + ((((size_t)b * 4 + l) * 2 + dir) * 4 + head) * 4096;
#pragma unroll
    for (int j = 0; j < 16; ++j) so[(dk0 + j) * 64 + dv] = s[j];
  }
}

DI void gla_pass_c(const Params& p, int l, int item, unsigned char* smem) {
  float* sa = (float*)smem;
  float* qt = sa + 1024;
  bf16_t* qd = (bf16_t*)(qt + 256);
  bf16_t* ki = qd + 64 * PITCH;
  bf16_t* vT = ki + 64 * PITCH;
  bf16_t* stT = vT + 64 * PITCH;
  float* osum = (float*)(stT + 64 * PITCH);
  const int tid = ltid(), lane = tid & 63, wid = tid >> 6, dk = tid & 63, quarter = tid >> 6, l31 = lane & 31, h = lane >> 5;
  int grp, b, head, c, S, base, nch;
  if (item < 1024) { grp = 1; b = item >> 8; head = (item >> 6) & 3; c = item & 63; S = 4096; base = M_CTX + b * 4096; nch = 64; }
  else { const int it = item - 1024; grp = 0; b = it >> 4; head = (it >> 2) & 3; c = it & 3; S = 256; base = b * 256; nch = 4; }
  const int wd = wid >> 1, wp = wid & 1;
  for (int dir = 0; dir < 2; ++dir) {
    const int cs = dir ? nch - 1 - c : c;
    const int sq = b * 8 + head * 2 + dir;
    const size_t ci = grp ? (size_t)sq * 64 + cs : 2048 + (size_t)sq * 4 + cs;
    const int row0 = dir ? base + S - 1 - 64 * cs : base + 64 * cs, rstep = dir ? -1 : 1;
    f32x16 cum; float last;
    gla_cum(p, l, head, dir, row0, rstep, sa, qt, cum, last);
    unsigned vw[8];
#pragma unroll
    for (int j = 0; j < 8; ++j) {
      float vv[2];
#pragma unroll
      for (int q = 0; q < 2; ++q) {
        const int ii = 2 * j + q, i = quarter * 16 + ii;
        const bf16_t* z = p.Z + (size_t)(row0 + i * rstep) * DIN;
        const float e = expf(cum[ii]);
        qd[i * PITCH + dk] = f2bf(bf2f(z[ZQG + head * 64 + dk]) * 0.125f * e);
        ki[i * PITCH + dk] = f2bf(bf2f(z[ZKG + head * 64 + dk]) / e);
        vv[q] = bf2f(z[ZVG + head * 64 + dk]);
      }
      vw[j] = pack2(vv[0], vv[1]);
    }
    *(uint4*)(vT + dk * PITCH + quarter * 16) = make_uint4(vw[0], vw[1], vw[2], vw[3]);
    *(uint4*)(vT + dk * PITCH + quarter * 16 + 8) = make_uint4(vw[4], vw[5], vw[6], vw[7]);
    {
      const bf16_t* Sg = p.GLA_S + ci * 4096;
      for (int e = tid; e < 512; e += NT) { const int r = e >> 3, cc = (e & 7) * 8; *(uint4*)(stT + r * PITCH + cc) = *(const uint4*)(Sg + r * 64 + cc); }
    }
    __syncthreads();
    f32x16 acco;
#pragma unroll
    for (int i = 0; i < 16; ++i) acco[i] = 0.f;
#pragma unroll
    for (int ks = 0; ks < 4; ++ks) {
      const bf16x8 a = *(const bf16x8*)(stT + (wd * 32 + l31) * PITCH + ks * 16 + h * 8);
      const bf16x8 bb = *(const bf16x8*)(qd + (wp * 32 + l31) * PITCH + ks * 16 + h * 8);
      acco = MFMA32(a, bb, acco);
    }
    for (int jb = 0; jb <= wp; ++jb) {
      f32x16 att;
#pragma unroll
      for (int i = 0; i < 16; ++i) att[i] = 0.f;
#pragma unroll
      for (int ks = 0; ks < 4; ++ks) {
        const bf16x8 a = *(const bf16x8*)(ki + (jb * 32 + l31) * PITCH + ks * 16 + h * 8);
        const bf16x8 bb = *(const bf16x8*)(qd + (wp * 32 + l31) * PITCH + ks * 16 + h * 8);
        att = MFMA32(a, bb, att);
      }
      const int ipos = wp * 32 + l31;
#pragma unroll
      for (int i = 0; i < 16; ++i) if (jb * 32 + crow(i, h) > ipos) att[i] = 0.f;
#pragma unroll
      for (int s = 0; s < 2; ++s) {
        union { bf16x8 v; unsigned u[4]; } pf;
#pragma unroll
        for (int j = 0; j < 4; ++j) pf.u[j] = pack2(att[8 * s + 2 * j], att[8 * s + 2 * j + 1]);
        union { bf16x8 v; bf16x4 hlf[2]; } vf;
        vf.hlf[0] = *(const bf16x4*)(vT + (wd * 32 + l31) * PITCH + jb * 32 + 16 * s + 4 * h);
        vf.hlf[1] = *(const bf16x4*)(vT + (wd * 32 + l31) * PITCH + jb * 32 + 16 * s + 8 + 4 * h);
        acco = MFMA32(vf.v, pf.v, acco);
      }
    }
    {
      const int i = wp * 32 + l31, tl = dir ? 63 - i : i;
#pragma unroll
      for (int r = 0; r < 16; ++r) {
        float* o = osum + tl * 65 + wd * 32 + crow(r, h);
        if (dir) *o += acco[r]; else *o = acco[r];
      }
    }
  }
  __syncthreads();
  const float g = p.gla_g_out[l * 64 + lane];
  for (int t = wid; t < 64; t += NW) {
    const float v = osum[t * 65 + lane];
    const float rs = rsqrtf(wave_sum(v * v) * (1.f / 64.f) + EPS);
    const int row = base + 64 * c + t;
    const float rg = bf2f(p.Z[(size_t)row * DIN + ZRG + head * 64 + lane]);
    p.MIX[(size_t)row * 1024 + head * 64 + lane] = f2bf(v * rs * g * silu_f(rg));
  }
}

struct AttnJob {
  const bf16_t* Q; int ldq;
  const bf16_t* K1; int ldk1;
  const bf16_t* K2; int ldk2;
  const bf16_t* V; int ldv;
  int ctx_row0, nctx;
  int loc_row0, loc_pos0, nloc;
  int qrow0, qpos0;
  int window;
  float scale; int has_sink; float sink;
  bf16_t* O; int ldo;
};
template <int DQ>
DI void attn_block(const AttnJob& jb, unsigned char* smem) {
  constexpr int NKS = DQ / 16, KP = DQ + 8, NCH = DQ / 8;
  bf16_t* sK = (bf16_t*)smem;
  bf16_t* sVt = sK + 64 * KP;
  const int tid = ltid(), lane = tid & 63, wid = tid >> 6, l31 = lane & 31, h = lane >> 5;
  const int qr = jb.qrow0 + wid * 32 + l31;
  bf16x8 qf[NKS];
#pragma unroll
  for (int ks = 0; ks < NKS; ++ks) qf[ks] = *(const bf16x8*)(jb.Q + (size_t)qr * jb.ldq + ks * 16 + h * 8);
  const int qpos = jb.qpos0 + wid * 32 + l31;
  f32x16 o[2];
#pragma unroll
  for (int d = 0; d < 2; ++d)
#pragma unroll
    for (int i = 0; i < 16; ++i) o[d][i] = 0.f;
  float m = -1e30f, lsum = 0.f;
  const int nt = jb.nctx + jb.nloc;
  for (int t = 0; t < nt; ++t) {
    int krow, kpos0; bool masked;
    if (t < jb.nctx) { krow = jb.ctx_row0 + 64 * t; kpos0 = 0; masked = false; }
    else { kpos0 = jb.loc_pos0 + 64 * (t - jb.nctx); krow = jb.loc_row0 + kpos0; masked = jb.window > 0; }
    __syncthreads();
    for (int ch = tid; ch < 64 * NCH; ch += NT) {
      const int key = ch / NCH, dc = ch % NCH;
      uint4 v;
      if (dc < 8) v = *(const uint4*)(jb.K1 + (size_t)(krow + key) * jb.ldk1 + dc * 8);
      else v = *(const uint4*)(jb.K2 + (size_t)(krow + key) * jb.ldk2 + (dc - 8) * 8);
      *(uint4*)(sK + key * KP + dc * 8) = v;
    }
    for (int ch = tid; ch < 512; ch += NT) {
      const int key = ch & 63, dc = ch >> 6;
      const uint4 v = *(const uint4*)(jb.V + (size_t)(krow + key) * jb.ldv + dc * 8);
      const unsigned uu[4] = {v.x, v.y, v.z, v.w};
#pragma unroll
      for (int j = 0; j < 4; ++j) {
        sVt[(dc * 8 + 2 * j) * PITCH + key] = (bf16_t)(uu[j] & 0xffffu);
        sVt[(dc * 8 + 2 * j + 1) * PITCH + key] = (bf16_t)(uu[j] >> 16);
      }
    }
    __syncthreads();
    f32x16 st[2];
#pragma unroll
    for (int kb = 0; kb < 2; ++kb) {
#pragma unroll
      for (int i = 0; i < 16; ++i) st[kb][i] = 0.f;
#pragma unroll
      for (int ks = 0; ks < NKS; ++ks) {
        const bf16x8 a = *(const bf16x8*)(sK + (kb * 32 + l31) * KP + ks * 16 + h * 8);
        st[kb] = MFMA32(a, qf[ks], st[kb]);
      }
    }
    float mx = -1e30f;
#pragma unroll
    for (int kb = 0; kb < 2; ++kb)
#pragma unroll
      for (int i = 0; i < 16; ++i) {
        float s = st[kb][i] * jb.scale;
        if (masked) {
          const int kp = kpos0 + kb * 32 + crow(i, h);
          const int d = qpos - kp;
          if (d > jb.window || d < -jb.window) s = -1e30f;
        }
        st[kb][i] = s;
        mx = fmaxf(mx, s);
      }
    mx = fmaxf(mx, __shfl_xor(mx, 32));
    const float mn = fmaxf(m, mx);
    const float alpha = __expf(m - mn);
    m = mn;
    float ps = 0.f;
#pragma unroll
    for (int kb = 0; kb < 2; ++kb)
#pragma unroll
      for (int i = 0; i < 16; ++i) { const float pv = __expf(st[kb][i] - mn); st[kb][i] = pv; ps += pv; }
    lsum = lsum * alpha + ps;
#pragma unroll
    for (int d = 0; d < 2; ++d)
#pragma unroll
      for (int i = 0; i < 16; ++i) o[d][i] *= alpha;
#pragma unroll
    for (int kb = 0; kb < 2; ++kb)
#pragma unroll
      for (int s = 0; s < 2; ++s) {
        union { bf16x8 v; unsigned u[4]; } pf;
#pragma unroll
        for (int j = 0; j < 4; ++j) pf.u[j] = pack2(st[kb][8 * s + 2 * j], st[kb][8 * s + 2 * j + 1]);
#pragma unroll
        for (int d = 0; d < 2; ++d) {
          union { bf16x8 v; bf16x4 hlf[2]; } vf;
          vf.hlf[0] = *(const bf16x4*)(sVt + (d * 32 + l31) * PITCH + kb * 32 + 16 * s + 4 * h);
          vf.hlf[1] = *(const bf16x4*)(sVt + (d * 32 + l31) * PITCH + kb * 32 + 16 * s + 8 + 4 * h);
          o[d] = MFMA32(vf.v, pf.v, o[d]);
        }
      }
  }
  lsum += __shfl_xor(lsum, 32);
  float inv;
  if (jb.has_sink) {
    const float mf = fmaxf(m, jb.sink);
    const float corr = __expf(m - mf);
    inv = corr / (lsum * corr + __expf(jb.sink - mf));
  } else inv = 1.f / lsum;
  bf16_t* orow = jb.O + (size_t)qr * jb.ldo;
#pragma unroll
  for (int d = 0; d < 2; ++d)
#pragma unroll
    for (int g = 0; g < 4; ++g) {
      uint2 w;
      w.x = pack2(o[d][4 * g] * inv, o[d][4 * g + 1] * inv);
      w.y = pack2(o[d][4 * g + 2] * inv, o[d][4 * g + 3] * inv);
      *(uint2*)(orow + d * 32 + 8 * g + 4 * h) = w;
    }
}

DI void mla_item(const Params& p, int l, int grp, int it, unsigned char* smem) {
  AttnJob j;
  int b, head, qb;
  if (grp) { b = it >> 7; head = (it >> 5) & 3; qb = it & 31; } else { b = it >> 3; head = (it >> 1) & 3; qb = it & 1; }
  const int base = grp ? M_CTX + b * 4096 : b * 256;
  j.Q = p.QM + head * 96; j.ldq = 384;
  j.K1 = p.KV + head * 128; j.ldk1 = 512; j.K2 = p.KR; j.ldk2 = 32; j.V = p.KV + head * 128 + 64; j.ldv = 512;
  j.ctx_row0 = M_TOT + b * 256; j.nctx = grp ? 4 : 0;
  j.loc_row0 = base; j.loc_pos0 = 0; j.nloc = grp ? 64 : 4;
  j.qrow0 = base + qb * 128; j.qpos0 = qb * 128; j.window = 0;
  j.scale = 0.10206207261596577f; j.has_sink = 0; j.sink = 0.f;
  j.O = p.MIX + 768 + head * 64; j.ldo = 1024;
  attn_block<96>(j, smem);
}
DI void swa_item(const Params& p, int l, int grp, int it, unsigned char* smem) {
  AttnJob j;
  int b, hq, qb;
  if (grp) { b = it >> 7; hq = (it >> 5) & 3; qb = it & 31; } else { b = it >> 3; hq = (it >> 1) & 3; qb = it & 1; }
  const int base = grp ? M_CTX + b * 4096 : b * 256;
  const int g = hq >> 1;
  j.Q = p.QS + hq * 64; j.ldq = 256;
  j.K1 = p.KS + g * 64; j.ldk1 = 128; j.K2 = p.KS; j.ldk2 = 128; j.V = p.VS + g * 64; j.ldv = 128;
  j.ctx_row0 = M_TOT + b * 256; j.nctx = grp ? 4 : 0;
  if (grp) {
    const int lo = qb > 0 ? (qb - 1) * 128 : 0, hi = qb < 31 ? (qb + 2) * 128 : 4096;
    j.loc_pos0 = lo; j.nloc = (hi - lo) >> 6; j.window = 128;
  } else { j.loc_pos0 = 0; j.nloc = 4; j.window = 0; }
  j.loc_row0 = base;
  j.qrow0 = base + qb * 128; j.qpos0 = qb * 128;
  j.scale = 1.0f;
  j.has_sink = 1; j.sink = p.swa_sink[l * 4 + hq];
  j.O = p.MIX + 256 + hq * 64; j.ldo = 1024;
  attn_block<64>(j, smem);
}

DI void phase_gemm_gu(const Params& p, int i, unsigned char* smem) {
  EpiGateUp epi{p.ACT};
  const bf16_t* W = p.WGU + (size_t)i * 5632 * 1024;
  for (int t = lbid(); t < 160 * 44; t += gridDim.x) { const int tm = t / 44, tn = t % 44; gemm_tile(p.H, 1024, W, 1024, 1024, tm * 128, tn * 128, smem, epi); }
}
DI void phase_gemm_down(const Params& p, int i, unsigned char* smem) {
  EpiF32 epi{p.F, 1024};
  const bf16_t* W = p.WD + (size_t)i * 1024 * DFF;
  for (int t = lbid(); t < 160 * 8; t += gridDim.x) { const int tm = t / 8, tn = t % 8; gemm_tile(p.ACT, DFF, W, DFF, DFF, tm * 128, tn * 128, smem, epi); }
}
DI void phase_gemm_win(const Params& p, int l, unsigned char* smem) {
  EpiWin epi{p.Z, p.out, l};
  for (int t = lbid(); t < 160 * 18; t += gridDim.x) { const int tm = t / 18, tn = t % 18; gemm_tile(p.H, 1024, p.WIN, 1024, 1024, tm * 128, tn * 128, smem, epi); }
}
DI void phase_gemm_wout(const Params& p, unsigned char* smem) {
  EpiF32 epi{p.F, 1024};
  for (int t = lbid(); t < 160 * 8; t += gridDim.x) { const int tm = t / 8, tn = t % 8; gemm_tile(p.MIX, 1024, p.WOUT, 1024, 1024, tm * 128, tn * 128, smem, epi); }
}
DI void phase_prep(const Params& p, int l, unsigned char* smem) {
  for (int t = lbid(); t < 672 + 2560; t += gridDim.x) {
    if (t < 672) prep_item(p, l, t, smem); else gla_pass_a(p, l, t - 672, smem);
  }
}
DI void phase_qkv(const Params& p, int l, unsigned char* smem) {
  EpiQm eq{p.QM, p.ROPE_M};
  EpiBf16 ekv{p.KV, 512, 1.f, 512};
  for (int t = lbid(); t < 160 + 480 + 672; t += gridDim.x) {
    if (t < 160) gla_pass_b(p, l, t);
    else if (t < 640) { const int u = t - 160, tm = u / 3, tn = u % 3; gemm_tile(p.QLAT, 256, p.WQB, 256, 256, tm * 128, tn * 128, smem, eq); }
    else { const int u = t - 640, tm = u >> 2, tn = u & 3; gemm_tile(p.CKV, 128, p.WKVB, 128, 128, tm * 128, tn * 128, smem, ekv); }
  }
}
DI void phase_mixers(const Params& p, int l, unsigned char* smem) {
  for (int t = lbid(); t < 2880; t += gridDim.x) {
    if (t < 512) mla_item(p, l, 1, t, smem);
    else if (t < 768) {
      const int u = t - 512, b = u >> 6, tm = (u >> 1) & 31, tn = u & 1;
      EpiBf16 e{p.MIX + (size_t)(M_CTX + b * 4096) * 1024 + 512, 1024, 1.f / 512.f, 256};
      gemm_tile(p.TWL, 8192, p.ABTL + (size_t)b * 256 * 8192, 8192, 8192, tm * 128, tn * 128, smem, e);
    } else if (t < 1280) swa_item(p, l, 1, t - 768, smem);
    else if (t < 2304) gla_pass_c(p, l, t - 1280, smem);
    else if (t < 2432) mla_item(p, l, 0, t - 2304, smem);
    else if (t < 2560) swa_item(p, l, 0, t - 2432, smem);
    else if (t < 2624) {
      const int u = t - 2560, b = u >> 2, tm = (u >> 1) & 1, tn = u & 1;
      EpiBf16 e{p.MIX + (size_t)(b * 256) * 1024 + 512, 1024, 1.f / 128.f, 256};
      gemm_tile(p.TWC, 512, p.ABTC + (size_t)b * 256 * 512, 512, 512, tm * 128, tn * 128, smem, e);
    } else gla_pass_c(p, l, 1024 + (t - 2624), smem);
  }
}

#ifndef PROBE_DBL
#define PROBE_DBL 0
#endif
#define DBL(bit) (((PROBE_DBL) >> (bit)) & 1)
#ifndef ONLY_J
#define ONLY_J -1
#endif
#define EN(x) (ONLY_J < 0 || ONLY_J == (x))
constexpr int N_PHASES = 50;
#define MKP const PArg* kq = kp; asm volatile("" : "+s"(kq)); const Params p = make_params(*kq)
DI void run_phase(const PArg* kp, int ph, unsigned char* smem) {
  if (ph == 0) { if (EN(100)) { MKP; phase_init(p, smem); } return; }
  if (ph == 49) {
    MKP;
    EwArgs a{p.X, p.X + (size_t)M_CTX * DM, p.out + O_YP, p.out + O_YS, p.F, 3, 8, 5, 0.5f, 0, 0, 0, 0, 0};
    if (EN(101)) phase_ew(p, a);
    return;
  }
  const int l = (ph - 1) / 12, j = (ph - 1) % 12;
  switch (j) {
    case 0: if (EN(0)) {
      MKP; float* Xl = p.X + (size_t)M_CTX * DM;
      convert_layer(p, l, smem);
      if (l == 0) { EwArgs a{p.x_prompt, p.x_sample, p.X, Xl, nullptr, 0, 0, 0, 0.f, 1, 0, 1, 0, 0}; phase_ew(p, a); }
      else { EwArgs a{p.X, Xl, p.X, Xl, p.F, l - 1, 8, 5, 0.5f, 1, l, 1, 0, 0}; phase_ew(p, a); }
    } break;
    case 1: if (EN(1)) { MKP; phase_gemm_gu(p, 0, smem); if (DBL(0)) { phase_gemm_gu(p, 0, smem); } } break;
    case 2: if (EN(2)) { MKP; phase_gemm_down(p, 0, smem); if (DBL(0)) { phase_gemm_down(p, 0, smem); } } break;
    case 3: if (EN(3)) {
      MKP; float* Xl = p.X + (size_t)M_CTX * DM;
      if (l == 0) { EwArgs a{p.x_prompt, p.x_sample, p.X, Xl, p.F, l, 2, 1, 0.5f, 1, l, 4, 3, 2}; phase_ew(p, a); }
      else { EwArgs a{p.X, Xl, p.X, Xl, p.F, l, 2, 1, 0.5f, 1, l, 4, 3, 2}; phase_ew(p, a); }
    } break;
    case 4: if (EN(4)) { MKP; phase_gemm_win(p, l, smem); if (DBL(0)) { phase_gemm_win(p, l, smem); } } break;
    case 5: if (EN(5)) { MKP; phase_prep(p, l, smem); if (DBL(2)) { phase_prep(p, l, smem); } } break;
    case 6: if (EN(6)) { MKP; phase_qkv(p, l, smem); if (DBL(2)) { phase_qkv(p, l, smem); } } break;
    case 7: if (EN(7)) { MKP; phase_mixers(p, l, smem); if (DBL(1)) { phase_mixers(p, l, smem); } } break;
    case 8: if (EN(8)) { MKP; phase_gemm_wout(p, smem); if (DBL(0)) { phase_gemm_wout(p, smem); } } break;
    case 9: if (EN(9)) { MKP; float* Xl = p.X + (size_t)M_CTX * DM; EwArgs a{p.X, Xl, p.X, Xl, p.F, l, 5, 3, 1.0f, 1, l, 7, 6, 4}; phase_ew(p, a); } break;
    case 10: if (EN(10)) { MKP; phase_gemm_gu(p, 1, smem); if (DBL(0)) { phase_gemm_gu(p, 1, smem); } } break;
    case 11: if (EN(11)) { MKP; phase_gemm_down(p, 1, smem); if (DBL(0)) { phase_gemm_down(p, 1, smem); } } break;
  }
}

__global__ void __launch_bounds__(NT, 2) fwd_kernel(PArg pa, int ph_lo, int ph_hi) {
  __shared__ __attribute__((aligned(16))) unsigned char smem[SMEM_BYTES];
  const PArg* kp = (const PArg*)__builtin_amdgcn_kernarg_segment_ptr();
#if MULTI_LAUNCH
  for (int ph = ph_lo; ph < ph_hi; ++ph) run_phase(kp, ph, smem);
#else
  cg::grid_group grid = cg::this_grid();
  __shared__ uint4 xb_words;
  if (threadIdx.x == 0) xb_words = make_uint4(0u, 0u, 0u, 0u);
  __syncthreads();
  const XcdBarrier xb = xcd_barrier_post((unsigned*)(pa.ws + OFF_BAR), (volatile LAS unsigned*)&xb_words);
  for (int ph = ph_lo; ph < ph_hi; ++ph) {
    run_phase(kp, ph, smem);
    if (ph + 1 < ph_hi) { if (ph == ph_lo) grid.sync(); else xcd_barrier(xb); }
  }
#endif
}

extern "C" void kernel_launch(void* const* d_in, const int* in_sizes, int n_in, void* d_out, int out_size, void* d_ws, size_t ws_size,
                              hipStream_t stream) {
  PArg p{};
  for (int i = 0; i < 25; ++i) p.in[i] = (const float*)d_in[i];
  p.out = (float*)d_out;
  p.ws = (unsigned char*)d_ws;
  if (WS_NEED > ws_size) { fprintf(stderr, "workspace too small: need %zu have %zu\n", (size_t)WS_NEED, ws_size); return; }
#if MULTI_LAUNCH
  for (int ph = 0; ph < N_PHASES; ++ph) hipLaunchKernelGGL(fwd_kernel, dim3(512), dim3(NT), 0, stream, p, ph, ph + 1);
#else
  static int grid_blocks = 0;
  if (!grid_blocks) {
    int dev = 0, cus = 0, per_cu = 0;
    hipGetDevice(&dev);
    hipDeviceGetAttribute(&cus, hipDeviceAttributeMultiprocessorCount, dev);
    hipOccupancyMaxActiveBlocksPerMultiprocessor(&per_cu, fwd_kernel, NT, 0);
    if (per_cu > 2) per_cu = 2;
    grid_blocks = cus * per_cu;
  }
  hipMemsetAsync((unsigned char*)d_ws + OFF_BAR, 0, 16384, stream);
  int lo = 0, hi = N_PHASES;
  void* args[] = {&p, &lo, &hi};
  hipError_t e = hipLaunchCooperativeKernel((void*)fwd_kernel, dim3(grid_blocks), dim3(NT), args, 0, stream);
  if (e != hipSuccess) fprintf(stderr, "cooperative launch failed: %s (grid %d)\n", hipGetErrorString(e), grid_blocks);
#endif
}
```

```cpp
#include <hip/hip_runtime.h>
#include <hip/hip_cooperative_groups.h>
#include <cstdio>
#include <cstdint>
namespace cg = cooperative_groups;

#ifndef MULTI_LAUNCH
#define MULTI_LAUNCH 0
#endif

#define DI __device__ __forceinline__
typedef unsigned short bf16_t;
typedef short bf16x8 __attribute__((ext_vector_type(8)));
typedef short bf16x4 __attribute__((ext_vector_type(4)));
typedef float f32x16 __attribute__((ext_vector_type(16)));
typedef unsigned u32x4 __attribute__((ext_vector_type(4)));
typedef unsigned u32x2 __attribute__((ext_vector_type(2)));
#define MFMA32(a, b, c) __builtin_amdgcn_mfma_f32_32x32x16_bf16((a), (b), (c), 0, 0, 0)

constexpr int NT = 256, NW = NT / 64;
constexpr int DM = 1024, M_CTX = 4096, M_LAT = 16384, M_TOT = 20480, M_EXT = 21504;
constexpr int DFF = 2816, DIN = 2240;
constexpr float EPS = 1e-6f;
constexpr int SMEM_BYTES = 60 * 1024;
constexpr int PITCH = 72;
constexpr int ZQG = 0, ZKG = 256, ZVG = 512, ZRG = 768, ZAF = 1024, ZQS = 1056, ZKS = 1312, ZVS = 1440, ZF = 1568, ZQA = 1824, ZKVA = 2080, ZKR = 2208;
constexpr size_t O_YP = 0, O_YS = 4194304, O_ST = 20971520, O_SK = 23068672, O_SV = 25165824, O_CKV = 27262976, O_KR = 29360128;

struct Params {
  const float *x_prompt, *x_sample, *c, *state_gla, *cache_swa_k, *cache_swa_v, *cache_mla_ckv, *cache_mla_krope, *c_ctx,
      *w_mod, *b_mod, *g_norm, *w_gate, *w_up, *w_down, *w_in, *gla_w_gate, *gla_b_gate, *gla_g_out, *swa_sink, *mla_g_q,
      *mla_g_kv, *w_qb, *w_kvb, *w_out;
  float* out;
  float *X, *F, *MOD, *ROPE_S, *ROPE_M, *GLA_B, *GLA_DL;
  bf16_t *H, *TWL, *TWC, *WGU, *WD, *WIN, *WOUT, *WQB, *WKVB, *ACT, *Z, *QS, *KS, *VS, *CKV, *QLAT, *KR, *QM, *KV, *ABTL,
      *ABTC, *GLA_S, *MIX;
};

constexpr size_t al256(size_t x) { return (x + 255) & ~(size_t)255; }
constexpr size_t OFF_X = 0;
constexpr size_t OFF_H = OFF_X + al256((size_t)M_TOT * DM * 4);
constexpr size_t OFF_MOD = OFF_H + al256((size_t)M_TOT * DM * 2);
constexpr size_t OFF_ROPE_S = OFF_MOD + al256((size_t)4 * 5 * 9216 * 4);
constexpr size_t OFF_ROPE_M = OFF_ROPE_S + al256(64 * 16 * 2 * 4);
constexpr size_t OFF_TWL = OFF_ROPE_M + al256(64 * 8 * 2 * 4);
constexpr size_t OFF_TWC = OFF_TWL + al256((size_t)4096 * 8192 * 2);
constexpr size_t OFF_WGU = OFF_TWC + al256((size_t)256 * 512 * 2);
constexpr size_t OFF_WD = OFF_WGU + al256((size_t)2 * 5632 * 1024 * 2);
constexpr size_t OFF_WIN = OFF_WD + al256((size_t)2 * 1024 * DFF * 2);
constexpr size_t OFF_WOUT = OFF_WIN + al256((size_t)2304 * 1024 * 2);
constexpr size_t OFF_WQB = OFF_WOUT + al256((size_t)1024 * 1024 * 2);
constexpr size_t OFF_WKVB = OFF_WQB + al256((size_t)384 * 256 * 2);
constexpr size_t OFF_Z = OFF_WKVB + al256((size_t)512 * 128 * 2);
constexpr size_t OFF_QS = OFF_Z + al256((size_t)M_TOT * DIN * 2);
constexpr size_t OFF_KS = OFF_QS + al256((size_t)M_TOT * 256 * 2);
constexpr size_t OFF_VS = OFF_KS + al256((size_t)M_EXT * 128 * 2);
constexpr size_t OFF_CKV = OFF_VS + al256((size_t)M_EXT * 128 * 2);
constexpr size_t OFF_QLAT = OFF_CKV + al256((size_t)M_EXT * 128 * 2);
constexpr size_t OFF_KR = OFF_QLAT + al256((size_t)M_TOT * 256 * 2);
constexpr size_t OFF_QM = OFF_KR + al256((size_t)M_EXT * 32 * 2);
constexpr size_t OFF_KV = OFF_QM + al256((size_t)M_TOT * 384 * 2);
constexpr size_t OFF_ABTL = OFF_KV + al256((size_t)M_EXT * 512 * 2);
constexpr size_t OFF_ABTC = OFF_ABTL + al256((size_t)4 * 256 * 8192 * 2);
constexpr size_t OFF_GLA_B = OFF_ABTC + al256((size_t)16 * 256 * 512 * 2);
constexpr size_t OFF_GLA_DL = OFF_GLA_B + al256((size_t)2560 * 4096 * 4);
constexpr size_t OFF_GLA_S = OFF_GLA_DL + al256((size_t)2560 * 64 * 4);
constexpr size_t OFF_MIX = OFF_GLA_S + al256((size_t)2560 * 4096 * 2);
constexpr size_t OFF_BAR = OFF_MIX + al256((size_t)M_TOT * 1024 * 2);
constexpr size_t OFF_END0 = OFF_BAR + al256(16384);
constexpr size_t OFF_ACTEND = OFF_QS + al256((size_t)M_TOT * DFF * 2);
constexpr size_t WS_NEED = OFF_END0 > OFF_ACTEND ? OFF_END0 : OFF_ACTEND;
struct PArg { const float* in[25]; float* out; unsigned char* ws; };
#define GAS __attribute__((address_space(1)))
struct PArgG { GAS const float* in[25]; GAS float* out; GAS unsigned char* ws; };
DI Params make_params(const PArg& a0) {
  const PArgG& a = *(const PArgG*)&a0;
  Params p;
  p.x_prompt = (const float*)a.in[0];
  p.x_sample = (const float*)a.in[1];
  p.c = (const float*)a.in[2];
  p.state_gla = (const float*)a.in[3];
  p.cache_swa_k = (const float*)a.in[4];
  p.cache_swa_v = (const float*)a.in[5];
  p.cache_mla_ckv = (const float*)a.in[6];
  p.cache_mla_krope = (const float*)a.in[7];
  p.c_ctx = (const float*)a.in[8];
  p.w_mod = (const float*)a.in[9];
  p.b_mod = (const float*)a.in[10];
  p.g_norm = (const float*)a.in[11];
  p.w_gate = (const float*)a.in[12];
  p.w_up = (const float*)a.in[13];
  p.w_down = (const float*)a.in[14];
  p.w_in = (const float*)a.in[15];
  p.gla_w_gate = (const float*)a.in[16];
  p.gla_b_gate = (const float*)a.in[17];
  p.gla_g_out = (const float*)a.in[18];
  p.swa_sink = (const float*)a.in[19];
  p.mla_g_q = (const float*)a.in[20];
  p.mla_g_kv = (const float*)a.in[21];
  p.w_qb = (const float*)a.in[22];
  p.w_kvb = (const float*)a.in[23];
  p.w_out = (const float*)a.in[24];
  p.out = (float*)a.out;
  p.X = (float*)(GAS float*)(a.ws + OFF_X);
  p.H = (bf16_t*)(GAS bf16_t*)(a.ws + OFF_H);
  p.MOD = (float*)(GAS float*)(a.ws + OFF_MOD);
  p.ROPE_S = (float*)(GAS float*)(a.ws + OFF_ROPE_S);
  p.ROPE_M = (float*)(GAS float*)(a.ws + OFF_ROPE_M);
  p.TWL = (bf16_t*)(GAS bf16_t*)(a.ws + OFF_TWL);
  p.TWC = (bf16_t*)(GAS bf16_t*)(a.ws + OFF_TWC);
  p.WGU = (bf16_t*)(GAS bf16_t*)(a.ws + OFF_WGU);
  p.WD = (bf16_t*)(GAS bf16_t*)(a.ws + OFF_WD);
  p.WIN = (bf16_t*)(GAS bf16_t*)(a.ws + OFF_WIN);
  p.WOUT = (bf16_t*)(GAS bf16_t*)(a.ws + OFF_WOUT);
  p.WQB = (bf16_t*)(GAS bf16_t*)(a.ws + OFF_WQB);
  p.WKVB = (bf16_t*)(GAS bf16_t*)(a.ws + OFF_WKVB);
  p.Z = (bf16_t*)(GAS bf16_t*)(a.ws + OFF_Z);
  p.QS = (bf16_t*)(GAS bf16_t*)(a.ws + OFF_QS);
  p.KS = (bf16_t*)(GAS bf16_t*)(a.ws + OFF_KS);
  p.VS = (bf16_t*)(GAS bf16_t*)(a.ws + OFF_VS);
  p.CKV = (bf16_t*)(GAS bf16_t*)(a.ws + OFF_CKV);
  p.QLAT = (bf16_t*)(GAS bf16_t*)(a.ws + OFF_QLAT);
  p.KR = (bf16_t*)(GAS bf16_t*)(a.ws + OFF_KR);
  p.QM = (bf16_t*)(GAS bf16_t*)(a.ws + OFF_QM);
  p.KV = (bf16_t*)(GAS bf16_t*)(a.ws + OFF_KV);
  p.ABTL = (bf16_t*)(GAS bf16_t*)(a.ws + OFF_ABTL);
  p.ABTC = (bf16_t*)(GAS bf16_t*)(a.ws + OFF_ABTC);
  p.GLA_B = (float*)(GAS float*)(a.ws + OFF_GLA_B);
  p.GLA_DL = (float*)(GAS float*)(a.ws + OFF_GLA_DL);
  p.GLA_S = (bf16_t*)(GAS bf16_t*)(a.ws + OFF_GLA_S);
  p.MIX = (bf16_t*)(GAS bf16_t*)(a.ws + OFF_MIX);
  p.F = (float*)(GAS float*)(a.ws + OFF_Z);
  p.ACT = (bf16_t*)(GAS bf16_t*)(a.ws + OFF_QS);
  return p;
}

DI int ltid() { int t = __builtin_amdgcn_workitem_id_x(); asm volatile("" : "+v"(t)); return t; }
DI int lbid() { int t = __builtin_amdgcn_workgroup_id_x(); asm volatile("" : "+s"(t)); return t; }
DI bf16_t f2bf(float x) { unsigned u = __float_as_uint(x); u += 0x7fffu + ((u >> 16) & 1u); return (bf16_t)(u >> 16); }
DI float bf2f(bf16_t b) { return __uint_as_float(((unsigned)b) << 16); }
DI unsigned pack2(float a, float b) { return (unsigned)f2bf(a) | ((unsigned)f2bf(b) << 16); }
DI float wave_sum(float v) {
#pragma unroll
  for (int o = 32; o > 0; o >>= 1) v += __shfl_xor(v, o);
  return v;
}
DI float silu_f(float x) { return x / (1.f + __expf(-x)); }
DI int crow(int r, int h) { return (r & 3) + 8 * (r >> 2) + 4 * h; }


#define XB_TMO      128
#define XB_XCNT(j)  (256  + 64 * (j))
#define XB_XSUB(j)  (1280 + 64 * (j))
#define XB_XGEN(j)  (2304 + 64 * (j))
#define XB_TOP      3328
#define XB_TOPGEN   3392
#define XCD_BAR_WORDS 3456
#define XB_SPIN_CAP (1u << 22)
#define LAS __attribute__((address_space(3)))
DI unsigned xb_ld(unsigned* p) { return __hip_atomic_load(p, __ATOMIC_RELAXED, __HIP_MEMORY_SCOPE_AGENT); }
DI unsigned xb_add(unsigned* p, unsigned v) { return __hip_atomic_fetch_add(p, v, __ATOMIC_RELAXED, __HIP_MEMORY_SCOPE_AGENT); }
DI unsigned xb_xcc_id() { return (unsigned)__builtin_amdgcn_s_getreg((3 << 11) | 20) & 0xFu; }
#define XB_SPIN(cond, bar) do { unsigned _sp = 0; while (cond) { __builtin_amdgcn_s_sleep(1); \
    if ((++_sp & 255u) == 0u) { if (xb_ld(&(bar)[XB_TMO])) break; if (_sp > XB_SPIN_CAP) { atomicAdd(&(bar)[XB_TMO], 1u); break; } } } } while (0)
struct XcdBarrier { unsigned* bar; unsigned x; volatile LAS unsigned* st; };
DI XcdBarrier xcd_barrier_post(unsigned* bar, volatile LAS unsigned* st) {
  XcdBarrier b; b.bar = bar; b.x = xb_xcc_id(); b.st = st;
  if (threadIdx.x == 0) (void)xb_add(&bar[XB_XCNT(b.x)], 1u);
  return b;
}
DI void xcd_barrier_complete(unsigned* bar, unsigned x, unsigned& nloc, unsigned& nx) {
  const unsigned G = gridDim.x * gridDim.y * gridDim.z;
  unsigned sum, cnt, mine, sp = 0u;
  for (;;) {
    sum = 0u; cnt = 0u; mine = 0u;
#pragma unroll
    for (unsigned j = 0; j < 16; ++j) { const unsigned c = xb_ld(&bar[XB_XCNT(j)]); sum += c; cnt += (c > 0u) ? 1u : 0u; mine = (j == x) ? c : mine; }
    if (sum == G) break;
    __builtin_amdgcn_s_sleep(1);
    if ((++sp & 255u) == 0u) { if (xb_ld(&bar[XB_TMO])) break; if (sp > XB_SPIN_CAP) { atomicAdd(&bar[XB_TMO], 1u); break; } }
  }
  nloc = mine > 0u ? mine : 1u; nx = cnt > 0u ? cnt : 1u;
}
DI void xcd_barrier(const XcdBarrier& b) {
  asm volatile("s_waitcnt vmcnt(0)" ::: "memory");
  __syncthreads();
  if (threadIdx.x == 0) {
    unsigned* bar = b.bar;
    __builtin_amdgcn_s_waitcnt(0);
    unsigned nloc = b.st[0], nx = b.st[1];
    if (nloc == 0u) { xcd_barrier_complete(bar, b.x, nloc, nx); b.st[0] = nloc; b.st[1] = nx; }
    const unsigned old = xb_add(&bar[XB_XSUB(b.x)], 1u);
    const unsigned gen = old / nloc;
    if (old + 1u == (gen + 1u) * nloc) {
      __builtin_amdgcn_fence(__ATOMIC_RELEASE, "agent");
      asm volatile("s_waitcnt vmcnt(0)" ::: "memory");
      const unsigned og = xb_add(&bar[XB_TOP], 1u);
      const unsigned tg = og / nx;
      if (og + 1u == (tg + 1u) * nx) xb_add(&bar[XB_TOPGEN], 1u);
      else XB_SPIN(xb_ld(&bar[XB_TOPGEN]) == tg, bar);
      __builtin_amdgcn_fence(__ATOMIC_ACQUIRE, "agent");
      xb_add(&bar[XB_XGEN(b.x)], 1u);
      asm volatile("s_waitcnt vmcnt(0)" ::: "memory");
    } else {
      XB_SPIN(xb_ld(&bar[XB_XGEN(b.x)]) == gen, bar);
      __builtin_amdgcn_fence(__ATOMIC_ACQUIRE, "agent");
      asm volatile("s_waitcnt vmcnt(0)" ::: "memory");
    }
  }
  __syncthreads();
}

template <class Epi>
DI void gemm_tile(const bf16_t* __restrict__ A, int lda, const bf16_t* __restrict__ Bt, int ldb, int K, int m0, int n0,
                  unsigned char* smem, const Epi& epi) {
  bf16_t* sA = (bf16_t*)smem;
  bf16_t* sB = sA + 128 * PITCH;
  const int tid = ltid(), lane = tid & 63, wid = tid >> 6, wm = wid >> 1, wn = wid & 1, l31 = lane & 31, h = lane >> 5;
  f32x16 acc[2][2];
#pragma unroll
  for (int a = 0; a < 2; ++a)
#pragma unroll
    for (int b = 0; b < 2; ++b)
#pragma unroll
      for (int i = 0; i < 16; ++i) acc[a][b][i] = 0.f;
  const int lrow = tid >> 3, lkc = tid & 7;
  u32x4 ra0, ra1, ra2, ra3, rb0, rb1, rb2, rb3, qa0, qa1, qa2, qa3, qb0, qb1, qb2, qb3;
  const bf16_t* Ap = A + (size_t)(m0 + lrow) * lda + lkc * 8;
  const bf16_t* Bp = Bt + (size_t)(n0 + lrow) * ldb + lkc * 8;
  const size_t sa32 = (size_t)32 * lda, sb32 = (size_t)32 * ldb;
#define GLOADP(kk) { const bf16_t* a2 = Ap + (kk); const bf16_t* b2 = Bp + (kk); \
    ra0 = *(const u32x4*)(a2); ra1 = *(const u32x4*)(a2 + sa32); ra2 = *(const u32x4*)(a2 + 2 * sa32); ra3 = *(const u32x4*)(a2 + 3 * sa32); \
    rb0 = *(const u32x4*)(b2); rb1 = *(const u32x4*)(b2 + sb32); rb2 = *(const u32x4*)(b2 + 2 * sb32); rb3 = *(const u32x4*)(b2 + 3 * sb32); }
#define GLOADQ(kk) { const bf16_t* a2 = Ap + (kk); const bf16_t* b2 = Bp + (kk); \
    qa0 = *(const u32x4*)(a2); qa1 = *(const u32x4*)(a2 + sa32); qa2 = *(const u32x4*)(a2 + 2 * sa32); qa3 = *(const u32x4*)(a2 + 3 * sa32); \
    qb0 = *(const u32x4*)(b2); qb1 = *(const u32x4*)(b2 + sb32); qb2 = *(const u32x4*)(b2 + 2 * sb32); qb3 = *(const u32x4*)(b2 + 3 * sb32); }
#define GCOMPUTE() _Pragma("unroll") for (int ks = 0; ks < 4; ++ks) { \
      bf16x8 af0 = *(const bf16x8*)(sA + (wm * 64 + l31) * PITCH + ks * 16 + h * 8); \
      bf16x8 af1 = *(const bf16x8*)(sA + (wm * 64 + 32 + l31) * PITCH + ks * 16 + h * 8); \
      bf16x8 bf0 = *(const bf16x8*)(sB + (wn * 64 + l31) * PITCH + ks * 16 + h * 8); \
      bf16x8 bf1 = *(const bf16x8*)(sB + (wn * 64 + 32 + l31) * PITCH + ks * 16 + h * 8); \
      acc[0][0] = MFMA32(bf0, af0, acc[0][0]); acc[0][1] = MFMA32(bf0, af1, acc[0][1]); \
      acc[1][0] = MFMA32(bf1, af0, acc[1][0]); acc[1][1] = MFMA32(bf1, af1, acc[1][1]); }
  bf16_t* wA = sA + lrow * PITCH + lkc * 8;
  bf16_t* wB = sB + lrow * PITCH + lkc * 8;
  GLOADP(0);
  GLOADQ(64);
  for (int k0 = 0; k0 < K; k0 += 128) {
    __syncthreads();
    *(u32x4*)(wA) = ra0; *(u32x4*)(wA + 32 * PITCH) = ra1; *(u32x4*)(wA + 64 * PITCH) = ra2; *(u32x4*)(wA + 96 * PITCH) = ra3;
    *(u32x4*)(wB) = rb0; *(u32x4*)(wB + 32 * PITCH) = rb1; *(u32x4*)(wB + 64 * PITCH) = rb2; *(u32x4*)(wB + 96 * PITCH) = rb3;
    __syncthreads();
    { const int kn = (k0 + 128 < K) ? k0 + 128 : k0; GLOADP(kn); }
    GCOMPUTE();
    __syncthreads();
    *(u32x4*)(wA) = qa0; *(u32x4*)(wA + 32 * PITCH) = qa1; *(u32x4*)(wA + 64 * PITCH) = qa2; *(u32x4*)(wA + 96 * PITCH) = qa3;
    *(u32x4*)(wB) = qb0; *(u32x4*)(wB + 32 * PITCH) = qb1; *(u32x4*)(wB + 64 * PITCH) = qb2; *(u32x4*)(wB + 96 * PITCH) = qb3;
    __syncthreads();
    { const int kn = (k0 + 192 < K) ? k0 + 192 : k0 + 64; GLOADQ(kn); }
    GCOMPUTE();
  }
#undef GLOADP
#undef GLOADQ
#undef GCOMPUTE
  epi(acc, m0 + wm * 64, n0 + wn * 64, l31, h);
}

struct EpiF32 {
  float* C; int ldc;
  DI void operator()(const f32x16 (&acc)[2][2], int mb0, int nb0, int l31, int h) const {
#pragma unroll
    for (int nb = 0; nb < 2; ++nb)
#pragma unroll
      for (int mb = 0; mb < 2; ++mb) {
        float* row = C + (size_t)(mb0 + mb * 32 + l31) * ldc + nb0 + nb * 32 + 4 * h;
#pragma unroll
        for (int g = 0; g < 4; ++g)
          *(float4*)(row + 8 * g) = make_float4(acc[nb][mb][4 * g], acc[nb][mb][4 * g + 1], acc[nb][mb][4 * g + 2], acc[nb][mb][4 * g + 3]);
      }
  }
};
struct EpiBf16 {
  bf16_t* C; int ldc; float scale; int ncols;
  DI void operator()(const f32x16 (&acc)[2][2], int mb0, int nb0, int l31, int h) const {
#pragma unroll
    for (int nb = 0; nb < 2; ++nb)
#pragma unroll
      for (int mb = 0; mb < 2; ++mb) {
        const int col0 = nb0 + nb * 32 + 4 * h;
        bf16_t* row = C + (size_t)(mb0 + mb * 32 + l31) * ldc + col0;
#pragma unroll
        for (int g = 0; g < 4; ++g) {
          if (col0 + 8 * g < ncols) {
            uint2 w;
            w.x = pack2(acc[nb][mb][4 * g] * scale, acc[nb][mb][4 * g + 1] * scale);
            w.y = pack2(acc[nb][mb][4 * g + 2] * scale, acc[nb][mb][4 * g + 3] * scale);
            *(uint2*)(row + 8 * g) = w;
          }
        }
      }
  }
};
struct EpiGateUp {
  bf16_t* C;
  DI void operator()(const f32x16 (&acc)[2][2], int mb0, int nb0, int l31, int h) const {
#pragma unroll
    for (int mb = 0; mb < 2; ++mb) {
      bf16_t* row = C + (size_t)(mb0 + mb * 32 + l31) * DFF + (nb0 >> 1) + 4 * h;
#pragma unroll
      for (int g = 0; g < 4; ++g) {
        float v[4];
#pragma unroll
        for (int i = 0; i < 4; ++i) v[i] = silu_f(acc[0][mb][4 * g + i]) * acc[1][mb][4 * g + i];
        uint2 w; w.x = pack2(v[0], v[1]); w.y = pack2(v[2], v[3]);
        *(uint2*)(row + 8 * g) = w;
      }
    }
  }
};
struct EpiWin {
  bf16_t* Z; float* out; int l;
  DI void operator()(const f32x16 (&acc)[2][2], int mb0, int nb0, int l31, int h) const {
#pragma unroll
    for (int nb = 0; nb < 2; ++nb)
#pragma unroll
      for (int mb = 0; mb < 2; ++mb) {
        const int m = mb0 + mb * 32 + l31;
        const int col0 = nb0 + nb * 32 + 4 * h;
        bf16_t* row = Z + (size_t)m * DIN + col0;
#pragma unroll
        for (int g = 0; g < 4; ++g) {
          const int col = col0 + 8 * g;
          if (col < DIN) {
            uint2 w;
            w.x = pack2(acc[nb][mb][4 * g], acc[nb][mb][4 * g + 1]);
            w.y = pack2(acc[nb][mb][4 * g + 2], acc[nb][mb][4 * g + 3]);
            *(uint2*)(row + 8 * g) = w;
            if (m < M_CTX) {
              const int b = m >> 8, s = m & 255;
              const size_t tok = (size_t)((b * 4 + l) * 256 + s);
              float* dst = nullptr;
              if (col >= ZKS && col < ZVS) dst = out + O_SK + tok * 128 + (col - ZKS);
              else if (col >= ZVS && col < ZF) dst = out + O_SV + tok * 128 + (col - ZVS);
              else if (col >= ZKR) dst = out + O_KR + tok * 32 + (col - ZKR);
              if (dst) *(float4*)dst = make_float4(acc[nb][mb][4 * g], acc[nb][mb][4 * g + 1], acc[nb][mb][4 * g + 2], acc[nb][mb][4 * g + 3]);
            }
          }
        }
      }
  }
};
struct EpiQm {
  bf16_t* C; const float* rope_m;
  DI void operator()(const f32x16 (&acc)[2][2], int mb0, int nb0, int l31, int h) const {
#pragma unroll
    for (int nb = 0; nb < 2; ++nb) {
      const int cb = nb0 + nb * 32;
      const bool isrope = ((cb >> 5) % 3) == 2;
#pragma unroll
      for (int mb = 0; mb < 2; ++mb) {
        const int m = mb0 + mb * 32 + l31;
        float v[16];
#pragma unroll
        for (int i = 0; i < 16; ++i) v[i] = acc[nb][mb][i];
        if (isrope && m >= M_CTX) {
          const int t = (m - M_CTX) & 4095;
          const int prow = t >> 6, pcol = t & 63;
#pragma unroll
          for (int half = 0; half < 2; ++half) {
            const int pos = half ? pcol : prow;
#pragma unroll
            for (int i = 0; i < 4; ++i) {
              const int j = 4 * h + i;
              const float cs = rope_m[(pos * 8 + j) * 2], sn = rope_m[(pos * 8 + j) * 2 + 1];
              const float x1 = v[8 * half + i], x2 = v[8 * half + 4 + i];
              v[8 * half + i] = x1 * cs - x2 * sn;
              v[8 * half + 4 + i] = x2 * cs + x1 * sn;
            }
          }
        }
        bf16_t* row = C + (size_t)m * 384 + cb + 4 * h;
#pragma unroll
        for (int g = 0; g < 4; ++g) {
          uint2 w; w.x = pack2(v[4 * g], v[4 * g + 1]); w.y = pack2(v[4 * g + 2], v[4 * g + 3]);
          *(uint2*)(row + 8 * g) = w;
        }
      }
    }
  }
};

DI void mod_item(const Params& p, int it, unsigned char* smem) {
  float* sc = (float*)smem;
  float* red = sc + 5 * 1024;
  const int tid = ltid(), lane = tid & 63, wid = tid >> 6;
  const int l = it / 144, n = (it % 144) * 64 + lane;
  __syncthreads();
  for (int e = tid; e < 5 * 1024; e += NT) {
    const int i = e >> 10, k = e & 1023;
    const float v = i == 0 ? p.c_ctx[k] : p.c[(i - 1) * 1024 + k];
    sc[e] = v / (1.f + expf(-v));
  }
  __syncthreads();
  float a0 = 0, a1 = 0, a2 = 0, a3 = 0, a4 = 0;
  const float* w = p.w_mod + ((size_t)l * 1024 + wid * 256) * 9216 + n;
#pragma unroll 8
  for (int k = 0; k < 256; ++k) {
    const float wv = w[(size_t)k * 9216];
    const int kk = wid * 256 + k;
    a0 += sc[kk] * wv; a1 += sc[1024 + kk] * wv; a2 += sc[2048 + kk] * wv; a3 += sc[3072 + kk] * wv; a4 += sc[4096 + kk] * wv;
  }
  red[(wid * 5 + 0) * 64 + lane] = a0; red[(wid * 5 + 1) * 64 + lane] = a1; red[(wid * 5 + 2) * 64 + lane] = a2;
  red[(wid * 5 + 3) * 64 + lane] = a3; red[(wid * 5 + 4) * 64 + lane] = a4;
  __syncthreads();
  for (int e = tid; e < 320; e += NT) {
    const int i = e >> 6, cl = e & 63;
    float s = 0.f;
    for (int w4 = 0; w4 < 4; ++w4) s += red[(w4 * 5 + i) * 64 + cl];
    const int col = (it % 144) * 64 + cl;
    p.MOD[(size_t)(l * 5 + i) * 9216 + col] = s + p.b_mod[(size_t)l * 9216 + col];
  }
}

DI void phase_init(const Params& p, unsigned char* smem) {
  const int nb = gridDim.x, bid = lbid(), tid = ltid();
  for (int it = bid; it < 1602; it += nb) {
    if (it < 576) mod_item(p, it, smem);
    else if (it < 1600) {
      const int r0 = (it - 576) * 4;
      for (int e = tid; e < 4 * 1024; e += NT) {
        const int r = r0 + (e >> 10), k8 = (e & 1023) * 8;
        unsigned w[4];
#pragma unroll
        for (int j = 0; j < 4; ++j) {
          float v[2];
#pragma unroll
          for (int q = 0; q < 2; ++q) {
            const int k = k8 + 2 * j + q;
            const int idx = (r * (k & 4095)) & 4095;
            const float ang = (float)idx * (1.0f / 2048.0f);
            v[q] = k < 4096 ? cospif(ang) : -sinpif(ang);
          }
          w[j] = pack2(v[0], v[1]);
        }
        *(uint4*)(p.TWL + (size_t)r * 8192 + k8) = make_uint4(w[0], w[1], w[2], w[3]);
      }
    } else if (it == 1600) {
      for (int e = tid; e < 256 * 512; e += NT) {
        const int r = e >> 9, k = e & 511;
        const int idx = (r * (k & 255)) & 255;
        const float ang = (float)idx * (1.0f / 128.0f);
        p.TWC[e] = f2bf(k < 256 ? cospif(ang) : -sinpif(ang));
      }
    } else {
      for (int e = tid; e < 64 * 16; e += NT) {
        const int pos = e >> 4, j = e & 15;
        const float inv = powf(10000.0f, -(float)(2 * j) / 32.0f);
        const float ang = (float)pos * inv;
        p.ROPE_S[e * 2] = cosf(ang); p.ROPE_S[e * 2 + 1] = sinf(ang);
      }
      for (int e = tid; e < 64 * 8; e += NT) {
        const int pos = e >> 3, j = e & 7;
        const float inv = powf(10000.0f, -(float)(2 * j) / 16.0f);
        const float ang = (float)pos * inv;
        p.ROPE_M[e * 2] = cosf(ang); p.ROPE_M[e * 2 + 1] = sinf(ang);
      }
    }
  }
}

DI void conv_tile(const float* __restrict__ src, int N, bf16_t* __restrict__ dst, int K, int kt, int nt, int mode, unsigned char* smem) {
  float* ts = (float*)smem;
  const int tid = ltid();
  __syncthreads();
#pragma unroll
  for (int i = 0; i < 4; ++i) {
    const int r = (tid >> 4) + 16 * i, c4 = (tid & 15) * 4;
    const float4 v = *(const float4*)(src + (size_t)(kt * 64 + r) * N + nt * 64 + c4);
    ts[r * 65 + c4] = v.x; ts[r * 65 + c4 + 1] = v.y; ts[r * 65 + c4 + 2] = v.z; ts[r * 65 + c4 + 3] = v.w;
  }
  __syncthreads();
  const int nl = tid >> 2, ks = (tid & 3) * 16;
  const int n = nt * 64 + nl;
  int drow = n;
  if (mode == 1) drow = (n >> 5) * 64 + (n & 31);
  else if (mode == 2) drow = (n >> 5) * 64 + 32 + (n & 31);
  unsigned w[8];
#pragma unroll
  for (int j = 0; j < 8; ++j) w[j] = pack2(ts[(ks + 2 * j) * 65 + nl], ts[(ks + 2 * j + 1) * 65 + nl]);
  bf16_t* d = dst + (size_t)drow * K + kt * 64 + ks;
  *(uint4*)d = make_uint4(w[0], w[1], w[2], w[3]);
  *(uint4*)(d + 8) = make_uint4(w[4], w[5], w[6], w[7]);
}
DI void convert_layer(const Params& p, int l, unsigned char* smem) {
  for (int t = lbid(); t < 5080; t += gridDim.x) {
    if (t < 2816) {
      const int q = t / 704, r = t % 704, i = q >> 1, which = q & 1;
      const float* src = (which ? p.w_up : p.w_gate) + (size_t)(l * 2 + i) * 1024 * DFF;
      conv_tile(src, DFF, p.WGU + (size_t)i * 5632 * 1024, 1024, r / 44, r % 44, 1 + which, smem);
    } else if (t < 4224) {
      const int q = (t - 2816) / 704, r = (t - 2816) % 704;
      conv_tile(p.w_down + (size_t)(l * 2 + q) * DFF * 1024, 1024, p.WD + (size_t)q * 1024 * DFF, DFF, r / 16, r % 16, 0, smem);
    } else if (t < 4784) {
      const int r = t - 4224;
      conv_tile(p.w_in + (size_t)l * 1024 * DIN, DIN, p.WIN, 1024, r / 35, r % 35, 0, smem);
    } else if (t < 5040) {
      const int r = t - 4784;
      conv_tile(p.w_out + (size_t)l * 1024 * 1024, 1024, p.WOUT, 1024, r / 16, r % 16, 0, smem);
    } else if (t < 5064) {
      const int r = t - 5040;
      conv_tile(p.w_qb + (size_t)l * 256 * 384, 384, p.WQB, 256, r / 6, r % 6, 0, smem);
    } else {
      const int r = t - 5064;
      conv_tile(p.w_kvb + (size_t)l * 128 * 512, 512, p.WKVB, 128, r / 8, r % 8, 0, smem);
    }
  }
}

struct EwArgs {
  const float *xin_ctx, *xin_lat; float *xout_ctx, *xout_lat;
  const float* F; int lu, gate_idx, gpost_idx; float res_w;
  int do_norm, ln, sc_idx, sh_idx, gpre_idx;
};
DI void phase_ew(const Params& p, const EwArgs& a) {
  const int lane = ltid() & 63, gw = lbid() * NW + (ltid() >> 6), gs = gridDim.x * NW;
  for (int r = gw; r < M_TOT; r += gs) {
    const int mi = r < M_CTX ? 0 : 1 + ((r - M_CTX) >> 12);
    const float* xs = r < M_CTX ? a.xin_ctx + (size_t)r * DM : a.xin_lat + (size_t)(r - M_CTX) * DM;
    float4 x[4];
#pragma unroll
    for (int j = 0; j < 4; ++j) x[j] = *(const float4*)(xs + lane * 4 + 256 * j);
    if (a.F) {
      const float* fr = a.F + (size_t)r * DM;
      const float* gate = p.MOD + (size_t)(a.lu * 5 + mi) * 9216 + a.gate_idx * 1024;
      const float* gp = p.g_norm + (size_t)(a.lu * 6 + a.gpost_idx) * 1024;
      float4 f[4]; float ss = 0.f;
#pragma unroll
      for (int j = 0; j < 4; ++j) { f[j] = *(const float4*)(fr + lane * 4 + 256 * j); ss += f[j].x * f[j].x + f[j].y * f[j].y + f[j].z * f[j].z + f[j].w * f[j].w; }
      ss = wave_sum(ss);
      const float rs = rsqrtf(ss * (1.f / 1024.f) + EPS) * a.res_w;
      float* xo = r < M_CTX ? a.xout_ctx + (size_t)r * DM : a.xout_lat + (size_t)(r - M_CTX) * DM;
#pragma unroll
      for (int j = 0; j < 4; ++j) {
        const float4 g = *(const float4*)(gate + lane * 4 + 256 * j), q = *(const float4*)(gp + lane * 4 + 256 * j);
        x[j].x += g.x * (f[j].x * rs * q.x); x[j].y += g.y * (f[j].y * rs * q.y); x[j].z += g.z * (f[j].z * rs * q.z); x[j].w += g.w * (f[j].w * rs * q.w);
        *(float4*)(xo + lane * 4 + 256 * j) = x[j];
      }
    }
    if (a.do_norm) {
      float ss = 0.f;
#pragma unroll
      for (int j = 0; j < 4; ++j) ss += x[j].x * x[j].x + x[j].y * x[j].y + x[j].z * x[j].z + x[j].w * x[j].w;
      ss = wave_sum(ss);
      const float rs = rsqrtf(ss * (1.f / 1024.f) + EPS);
      const float* sc = p.MOD + (size_t)(a.ln * 5 + mi) * 9216 + a.sc_idx * 1024;
      const float* sh = p.MOD + (size_t)(a.ln * 5 + mi) * 9216 + a.sh_idx * 1024;
      const float* gp = p.g_norm + (size_t)(a.ln * 6 + a.gpre_idx) * 1024;
      bf16_t* hr = p.H + (size_t)r * DM;
#pragma unroll
      for (int j = 0; j < 4; ++j) {
        const float4 s = *(const float4*)(sc + lane * 4 + 256 * j), t = *(const float4*)(sh + lane * 4 + 256 * j), q = *(const float4*)(gp + lane * 4 + 256 * j);
        uint2 w;
        w.x = pack2(x[j].x * rs * q.x * (1.f + s.x) + t.x, x[j].y * rs * q.y * (1.f + s.y) + t.y);
        w.y = pack2(x[j].z * rs * q.z * (1.f + s.z) + t.z, x[j].w * rs * q.w * (1.f + s.w) + t.w);
        *(uint2*)(hr + lane * 4 + 256 * j) = w;
      }
    }
  }
}

DI void prep_item(const Params& p, int l, int it, unsigned char* smem) {
  const int tid = ltid(), lane = tid & 63, wid = tid >> 6;
  const int r0 = it * 32;
  if (r0 >= M_TOT) {
    for (int e = tid; e < 32 * 128; e += NT) {
      const int rr = e >> 7, cc = e & 127, idx = r0 - M_TOT + rr, b = idx >> 8, j = idx & 255;
      const size_t src = ((size_t)(b * 4 + l) * 256 + j) * 128 + cc;
      const size_t dst = (size_t)(r0 + rr) * 128 + cc;
      p.KS[dst] = f2bf(p.cache_swa_k[src]);
      p.VS[dst] = f2bf(p.cache_swa_v[src]);
      p.CKV[dst] = f2bf(p.cache_mla_ckv[src]);
    }
    for (int e = tid; e < 32 * 32; e += NT) {
      const int rr = e >> 5, cc = e & 31, idx = r0 - M_TOT + rr, b = idx >> 8, j = idx & 255;
      p.KR[(size_t)(r0 + rr) * 32 + cc] = f2bf(p.cache_mla_krope[((size_t)(b * 4 + l) * 256 + j) * 32 + cc]);
    }
    return;
  }
  const bool lat = r0 >= M_CTX;
  for (int e = tid; e < 32 * 128; e += NT) {
    const int rr = e >> 7, rem = e & 127, head = rem >> 5, half = (rem >> 4) & 1, j = rem & 15;
    const int r = r0 + rr;
    const bf16_t* z = p.Z + (size_t)r * DIN;
    const int d1 = head * 64 + half * 32 + j, d2 = d1 + 16;
    float x1 = bf2f(z[ZQS + d1]), x2 = bf2f(z[ZQS + d2]);
    float cs = 1.f, sn = 0.f;
    if (lat) { const int t = (r - M_CTX) & 4095; const int pos = half ? (t & 63) : (t >> 6); cs = p.ROPE_S[(pos * 16 + j) * 2]; sn = p.ROPE_S[(pos * 16 + j) * 2 + 1]; }
    p.QS[(size_t)r * 256 + d1] = f2bf((x1 * cs - x2 * sn) * 0.125f);
    p.QS[(size_t)r * 256 + d2] = f2bf((x2 * cs + x1 * sn) * 0.125f);
    if (head < 2) {
      x1 = bf2f(z[ZKS + d1]); x2 = bf2f(z[ZKS + d2]);
      p.KS[(size_t)r * 128 + d1] = f2bf(x1 * cs - x2 * sn);
      p.KS[(size_t)r * 128 + d2] = f2bf(x2 * cs + x1 * sn);
      p.VS[(size_t)r * 128 + d1] = z[ZVS + d1];
      p.VS[(size_t)r * 128 + d2] = z[ZVS + d2];
    }
  }
  for (int e = tid; e < 32 * 16; e += NT) {
    const int rr = e >> 4, half = (e >> 3) & 1, j = e & 7, r = r0 + rr;
    const bf16_t* z = p.Z + (size_t)r * DIN + ZKR;
    const int d1 = half * 16 + j, d2 = d1 + 8;
    const float x1 = bf2f(z[d1]), x2 = bf2f(z[d2]);
    float cs = 1.f, sn = 0.f;
    if (lat) { const int t = (r - M_CTX) & 4095; const int pos = half ? (t & 63) : (t >> 6); cs = p.ROPE_M[(pos * 8 + j) * 2]; sn = p.ROPE_M[(pos * 8 + j) * 2 + 1]; }
    p.KR[(size_t)r * 32 + d1] = f2bf(x1 * cs - x2 * sn);
    p.KR[(size_t)r * 32 + d2] = f2bf(x2 * cs + x1 * sn);
  }
  for (int rr = wid; rr < 32; rr += NW) {
    const int r = r0 + rr;
    const bf16_t* z = p.Z + (size_t)r * DIN;
    {
      const float a = bf2f(z[ZKVA + lane]), b = bf2f(z[ZKVA + 64 + lane]);
      const float rs = rsqrtf(wave_sum(a * a + b * b) * (1.f / 128.f) + EPS);
      const float o0 = a * rs * p.mla_g_kv[l * 128 + lane], o1 = b * rs * p.mla_g_kv[l * 128 + 64 + lane];
      p.CKV[(size_t)r * 128 + lane] = f2bf(o0); p.CKV[(size_t)r * 128 + 64 + lane] = f2bf(o1);
      if (!lat) {
        const int b_ = r >> 8, s = r & 255;
        float* dst = p.out + O_CKV + ((size_t)(b_ * 4 + l) * 256 + s) * 128;
        dst[lane] = o0; dst[64 + lane] = o1;
      }
    }
    {
      float v[4]; float ss = 0.f;
#pragma unroll
      for (int j = 0; j < 4; ++j) { v[j] = bf2f(z[ZQA + lane + 64 * j]); ss += v[j] * v[j]; }
      const float rs = rsqrtf(wave_sum(ss) * (1.f / 256.f) + EPS);
#pragma unroll
      for (int j = 0; j < 4; ++j) p.QLAT[(size_t)r * 256 + lane + 64 * j] = f2bf(v[j] * rs * p.mla_g_q[l * 256 + lane + 64 * j]);
    }
  }
  {
    float* tw = (float*)smem;
    __syncthreads();
    if (tid < 64) tw[tid] = cospif((float)tid * (1.f / 32.f));
    __syncthreads();
    const int tk = tid & 31, og = tid >> 5, g = og >> 1, type = og & 1;
    const int r = r0 + tk;
    float zr[64];
    {
      const uint4* zp = (const uint4*)(p.Z + (size_t)r * DIN + ZF + g * 64);
#pragma unroll
      for (int q = 0; q < 8; ++q) {
        const uint4 u = zp[q];
        const unsigned uu[4] = {u.x, u.y, u.z, u.w};
#pragma unroll
        for (int j = 0; j < 4; ++j) { zr[q * 8 + 2 * j] = __uint_as_float(uu[j] << 16); zr[q * 8 + 2 * j + 1] = __uint_as_float(uu[j] & 0xffff0000u); }
      }
    }
    bf16_t* dst;
    int dstride;
    if (lat) { const int b = (r - M_CTX) >> 12, s = (r - M_CTX) & 4095; dst = p.ABTL + ((size_t)b * 256 + g * 64) * 8192 + type * 4096 + s; dstride = 8192; }
    else { const int b = r >> 8, s = r & 255; dst = p.ABTC + ((size_t)b * 256 + g * 64) * 512 + type * 256 + s; dstride = 512; }
    const int off = type ? 48 : 0;
    for (int cp = 0; cp < 64; ++cp) {
      float acc = 0.f; int idx = off;
#pragma unroll
      for (int c = 0; c < 64; ++c) { acc += zr[c] * tw[idx & 63]; idx += cp; }
      dst[(size_t)cp * dstride] = f2bf(acc);
    }
  }
}

DI void gla_cum(const Params& p, int l, int head, int dir, int row0, int rstep, float* sa, float* qt, f32x16& cum, float& last) {
  const int tid = ltid(), dk = tid & 63, quarter = tid >> 6;
  __syncthreads();
  for (int e = tid; e < 64 * 16; e += NT) {
    const int i = e >> 4, rr = e & 15;
    sa[e] = bf2f(p.Z[(size_t)(row0 + i * rstep) * DIN + ZAF + dir * 16 + rr]);
  }
  __syncthreads();
  float wg[16];
  const float* W = p.gla_w_gate + ((size_t)(l * 2 + dir) * 16) * 256 + head * 64 + dk;
#pragma unroll
  for (int rr = 0; rr < 16; ++rr) wg[rr] = W[rr * 256];
  const float bg = p.gla_b_gate[(l * 2 + dir) * 256 + head * 64 + dk];
  float run = 0.f;
#pragma unroll
  for (int ii = 0; ii < 16; ++ii) {
    const int i = quarter * 16 + ii;
    float lg = bg;
#pragma unroll
    for (int rr = 0; rr < 16; ++rr) lg += sa[i * 16 + rr] * wg[rr];
    const float ls = -(fmaxf(-lg, 0.f) + log1pf(expf(-fabsf(lg))));
    run += ls * (1.f / 16.f);
    cum[ii] = run;
  }
  qt[quarter * 64 + dk] = run;
  __syncthreads();
  float offs = 0.f, tot = 0.f;
#pragma unroll
  for (int q = 0; q < 4; ++q) { const float v = qt[q * 64 + dk]; tot += v; if (q < quarter) offs += v; }
#pragma unroll
  for (int ii = 0; ii < 16; ++ii) cum[ii] += offs;
  last = tot;
}

DI void gla_seq_info(int sq_global, int& grp, int& b, int& head, int& dir, int& S, int& base) {
  if (sq_global < 32) { grp = 1; b = sq_global >> 3; head = (sq_global >> 1) & 3; dir = sq_global & 1; S = 4096; base = M_CTX + b * 4096; }
  else { const int s = sq_global - 32; grp = 0; b = s >> 3; head = (s >> 1) & 3; dir = s & 1; S = 256; base = b * 256; }
}

DI void gla_pass_a(const Params& p, int l, int ci, unsigned char* smem) {
  float* sa = (float*)smem;
  float* qt = sa + 1024;
  bf16_t* kdT = (bf16_t*)(qt + 256);
  bf16_t* vT = kdT + 64 * PITCH;
  const int tid = ltid(), lane = tid & 63, wid = tid >> 6, dk = tid & 63, quarter = tid >> 6, l31 = lane & 31, h = lane >> 5;
  int sqg, c;
  if (ci < 2048) { sqg = ci >> 6; c = ci & 63; } else { sqg = 32 + ((ci - 2048) >> 2); c = (ci - 2048) & 3; }
  int grp, b, head, dir, S, base;
  gla_seq_info(sqg, grp, b, head, dir, S, base);
  const int row0 = dir ? base + S - 1 - 64 * c : base + 64 * c, rstep = dir ? -1 : 1;
  f32x16 cum; float last;
  gla_cum(p, l, head, dir, row0, rstep, sa, qt, cum, last);
  unsigned kw[8], vw[8];
#pragma unroll
  for (int j = 0; j < 8; ++j) {
    float kv[2], vv[2];
#pragma unroll
    for (int q = 0; q < 2; ++q) {
      const int ii = 2 * j + q, i = quarter * 16 + ii;
      const bf16_t* z = p.Z + (size_t)(row0 + i * rstep) * DIN;
      kv[q] = bf2f(z[ZKG + head * 64 + dk]) * expf(last - cum[ii]);
      vv[q] = bf2f(z[ZVG + head * 64 + dk]);
    }
    kw[j] = pack2(kv[0], kv[1]); vw[j] = pack2(vv[0], vv[1]);
  }
  *(uint4*)(kdT + dk * PITCH + quarter * 16) = make_uint4(kw[0], kw[1], kw[2], kw[3]);
  *(uint4*)(kdT + dk * PITCH + quarter * 16 + 8) = make_uint4(kw[4], kw[5], kw[6], kw[7]);
  *(uint4*)(vT + dk * PITCH + quarter * 16) = make_uint4(vw[0], vw[1], vw[2], vw[3]);
  *(uint4*)(vT + dk * PITCH + quarter * 16 + 8) = make_uint4(vw[4], vw[5], vw[6], vw[7]);
  if (quarter == 0) p.GLA_DL[(size_t)ci * 64 + dk] = expf(last);
  __syncthreads();
  const int wr = wid >> 1, wc = wid & 1;
  f32x16 acc;
#pragma unroll
  for (int i = 0; i < 16; ++i) acc[i] = 0.f;
#pragma unroll
  for (int ks = 0; ks < 4; ++ks) {
    const bf16x8 a = *(const bf16x8*)(kdT + (wr * 32 + l31) * PITCH + ks * 16 + h * 8);
    const bf16x8 bb = *(const bf16x8*)(vT + (wc * 32 + l31) * PITCH + ks * 16 + h * 8);
    acc = MFMA32(a, bb, acc);
  }
  float* Bc = p.GLA_B + (size_t)ci * 4096;
#pragma unroll
  for (int i = 0; i < 16; ++i) Bc[(wr * 32 + crow(i, h)) * 64 + wc * 32 + l31] = acc[i];
}

DI void gla_pass_b(const Params& p, int l, int sqg) {
  const int tid = ltid(), dv = tid >> 2, dk0 = (tid & 3) * 16;
  int grp, b, head, dir, S, base;
  gla_seq_info(sqg, grp, b, head, dir, S, base);
  const int nch = S >> 6;
  const int ci0 = grp ? sqg * 64 : 2048 + (sqg - 32) * 4;
  f32x16 s;
  if (grp) {
    const float* s0 = p.state_gla + ((((size_t)b * 4 + l) * 2 + dir) * 4 + head) * 4096;
#pragma unroll
    for (int j = 0; j < 16; ++j) s[j] = s0[(dk0 + j) * 64 + dv];
  } else {
#pragma unroll
    for (int j = 0; j < 16; ++j) s[j] = 0.f;
  }
  f32x16 bn, dn;
  {
    const float* Bc = p.GLA_B + (size_t)ci0 * 4096; const float* dl = p.GLA_DL + (size_t)ci0 * 64;
#pragma unroll
    for (int j = 0; j < 16; ++j) { bn[j] = Bc[(dk0 + j) * 64 + dv]; dn[j] = dl[dk0 + j]; }
  }
  for (int c = 0; c < nch; ++c) {
    const size_t ci = ci0 + c;
    const f32x16 bc = bn, dc = dn;
    {
      const size_t cn = ci0 + (c + 1 < nch ? c + 1 : c);
      const float* Bc = p.GLA_B + cn * 4096; const float* dl = p.GLA_DL + cn * 64;
#pragma unroll
      for (int j = 0; j < 16; ++j) { bn[j] = Bc[(dk0 + j) * 64 + dv]; dn[j] = dl[dk0 + j]; }
    }
    u32x4 w0, w1;
    w0[0] = pack2(s[0], s[1]); w0[1] = pack2(s[2], s[3]); w0[2] = pack2(s[4], s[5]); w0[3] = pack2(s[6], s[7]);
    w1[0] = pack2(s[8], s[9]); w1[1] = pack2(s[10], s[11]); w1[2] = pack2(s[12], s[13]); w1[3] = pack2(s[14], s[15]);
    bf16_t* Sd = p.GLA_S + ci * 4096 + dv * 64 + dk0;
    *(u32x4*)Sd = w0;
    *(u32x4*)(Sd + 8) = w1;
#pragma unroll
    for (int j = 0; j < 16; ++j) s[j] = dc[j] * s[j] + bc[j];
  }
  if (!grp) {
    float* so = p.out + O_ST + ((((size_t)b * 4 + l) * 2 + dir) * 4 + head) * 4096;
#pragma unroll
    for (int j = 0; j < 16; ++j) so[(dk0 + j) * 64 + dv] = s[j];
  }
}

DI void gla_pass_c(const Params& p, int l, int item, unsigned char* smem) {
  float* sa = (float*)smem;
  float* qt = sa + 1024;
  bf16_t* qd = (bf16_t*)(qt + 256);
  bf16_t* ki = qd + 64 * PITCH;
  bf16_t* vT = ki + 64 * PITCH;
  bf16_t* stT = vT + 64 * PITCH;
  float* osum = (float*)(stT + 64 * PITCH);
  const int tid = ltid(), lane = tid & 63, wid = tid >> 6, dk = tid & 63, quarter = tid >> 6, l31 = lane & 31, h = lane >> 5;
  int grp, b, head, c, S, base, nch;
  if (item < 1024) { grp = 1; b = item >> 8; head = (item >> 6) & 3; c = item & 63; S = 4096; base = M_CTX + b * 4096; nch = 64; }
  else { const int it = item - 1024; grp = 0; b = it >> 4; head = (it >> 2) & 3; c = it & 3; S = 256; base = b * 256; nch = 4; }
  const int wd = wid >> 1, wp = wid & 1;
  for (int dir = 0; dir < 2; ++dir) {
    const int cs = dir ? nch - 1 - c : c;
    const int sq = b * 8 + head * 2 + dir;
    const size_t ci = grp ? (size_t)sq * 64 + cs : 2048 + (size_t)sq * 4 + cs;
    const int row0 = dir ? base + S - 1 - 64 * cs : base + 64 * cs, rstep = dir ? -1 : 1;
    f32x16 cum; float last;
    gla_cum(p, l, head, dir, row0, rstep, sa, qt, cum, last);
    unsigned vw[8];
#pragma unroll
    for (int j = 0; j < 8; ++j) {
      float vv[2];
#pragma unroll
      for (int q = 0; q < 2; ++q) {
        const int ii = 2 * j + q, i = quarter * 16 + ii;
        const bf16_t* z = p.Z + (size_t)(row0 + i * rstep) * DIN;
        const float e = expf(cum[ii]);
        qd[i * PITCH + dk] = f2bf(bf2f(z[ZQG + head * 64 + dk]) * 0.125f * e);
        ki[i * PITCH + dk] = f2bf(bf2f(z[ZKG + head * 64 + dk]) / e);
        vv[q] = bf2f(z[ZVG + head * 64 + dk]);
      }
      vw[j] = pack2(vv[0], vv[1]);
    }
    *(uint4*)(vT + dk * PITCH + quarter * 16) = make_uint4(vw[0], vw[1], vw[2], vw[3]);
    *(uint4*)(vT + dk * PITCH + quarter * 16 + 8) = make_uint4(vw[4], vw[5], vw[6], vw[7]);
    {
      const bf16_t* Sg = p.GLA_S + ci * 4096;
      for (int e = tid; e < 512; e += NT) { const int r = e >> 3, cc = (e & 7) * 8; *(uint4*)(stT + r * PITCH + cc) = *(const uint4*)(Sg + r * 64 + cc); }
    }
    __syncthreads();
    f32x16 acco;
#pragma unroll
    for (int i = 0; i < 16; ++i) acco[i] = 0.f;
#pragma unroll
    for (int ks = 0; ks < 4; ++ks) {
      const bf16x8 a = *(const bf16x8*)(stT + (wd * 32 + l31) * PITCH + ks * 16 + h * 8);
      const bf16x8 bb = *(const bf16x8*)(qd + (wp * 32 + l31) * PITCH + ks * 16 + h * 8);
      acco = MFMA32(a, bb, acco);
    }
    for (int jb = 0; jb <= wp; ++jb) {
      f32x16 att;
#pragma unroll
      for (int i = 0; i < 16; ++i) att[i] = 0.f;
#pragma unroll
      for (int ks = 0; ks < 4; ++ks) {
        const bf16x8 a = *(const bf16x8*)(ki + (jb * 32 + l31) * PITCH + ks * 16 + h * 8);
        const bf16x8 bb = *(const bf16x8*)(qd + (wp * 32 + l31) * PITCH + ks * 16 + h * 8);
        att = MFMA32(a, bb, att);
      }
      const int ipos = wp * 32 + l31;
#pragma unroll
      for (int i = 0; i < 16; ++i) if (jb * 32 + crow(i, h) > ipos) att[i] = 0.f;
#pragma unroll
      for (int s = 0; s < 2; ++s) {
        union { bf16x8 v; unsigned u[4]; } pf;
#pragma unroll
        for (int j = 0; j < 4; ++j) pf.u[j] = pack2(att[8 * s + 2 * j], att[8 * s + 2 * j + 1]);
        union { bf16x8 v; bf16x4 hlf[2]; } vf;
        vf.hlf[0] = *(const bf16x4*)(vT + (wd * 32 + l31) * PITCH + jb * 32 + 16 * s + 4 * h);
        vf.hlf[1] = *(const bf16x4*)(vT + (wd * 32 + l31) * PITCH + jb * 32 + 16 * s + 8 + 4 * h);
        acco = MFMA32(vf.v, pf.v, acco);
      }
    }
    {
      const int i = wp * 32 + l31, tl = dir ? 63 - i : i;
#pragma unroll
      for (int r = 0; r < 16; ++r) {
        float* o = osum + tl * 65 + wd * 32 + crow(r, h);
        if (dir) *o += acco[r]; else *o = acco[r];
      }
    }
  }
  __syncthreads();
  const float g = p.gla_g_out[l * 64 + lane];
  for (int t = wid; t < 64; t += NW) {
    const float v = osum[t * 65 + lane];
    const float rs = rsqrtf(wave_sum(v * v) * (1.f / 64.f) + EPS);
    const int row = base + 64 * c + t;
    const float rg = bf2f(p.Z[(size_t)row * DIN + ZRG + head * 64 + lane]);
    p.MIX[(size_t)row * 1024 + head * 64 + lane] = f2bf(v * rs * g * silu_f(rg));
  }
}

struct AttnJob {
  const bf16_t* Q; int ldq;
  const bf16_t* K1; int ldk1;
  const bf16_t* K2; int ldk2;
  const bf16_t* V; int ldv;
  int ctx_row0, nctx;
  int loc_row0, loc_pos0, nloc;
  int qrow0, qpos0;
  int window;
  float scale; int has_sink; float sink;
  bf16_t* O; int ldo;
};
template <int DQ>
DI void attn_block(const AttnJob& jb, unsigned char* smem) {
  constexpr int NKS = DQ / 16, KP = DQ + 8, NCH = DQ / 8;
  bf16_t* sK = (bf16_t*)smem;
  bf16_t* sVt = sK + 64 * KP;
  const int tid = ltid(), lane = tid & 63, wid = tid >> 6, l31 = lane & 31, h = lane >> 5;
  const int qr = jb.qrow0 + wid * 32 + l31;
  bf16x8 qf[NKS];
#pragma unroll
  for (int ks = 0; ks < NKS; ++ks) qf[ks] = *(const bf16x8*)(jb.Q + (size_t)qr * jb.ldq + ks * 16 + h * 8);
  const int qpos = jb.qpos0 + wid * 32 + l31;
  f32x16 o[2];
#pragma unroll
  for (int d = 0; d < 2; ++d)
#pragma unroll
    for (int i = 0; i < 16; ++i) o[d][i] = 0.f;
  float m = -1e30f, lsum = 0.f;
  const int nt = jb.nctx + jb.nloc;
  const int kc0 = tid, kc1 = tid + NT, kc2 = tid + 2 * NT;
  const int kk0 = kc0 / NCH, kd0 = kc0 % NCH, kk1 = kc1 / NCH, kd1 = kc1 % NCH, kk2 = kc2 / NCH, kd2 = kc2 % NCH;
  const int vk0 = tid & 63, vd0 = tid >> 6, vd1 = (tid + NT) >> 6;
  u32x4 kr0, kr1, kr2 = {0u, 0u, 0u, 0u}, vr0, vr1;
#define ATT_KLD(key, dc, krow) ((dc) < 8 ? *(const u32x4*)(jb.K1 + (size_t)((krow) + (key)) * jb.ldk1 + (dc) * 8) \
                                       : *(const u32x4*)(jb.K2 + (size_t)((krow) + (key)) * jb.ldk2 + ((dc) - 8) * 8))
#define ATT_LOAD(tt) { const int kr_ = (tt) < jb.nctx ? jb.ctx_row0 + 64 * (tt) : jb.loc_row0 + jb.loc_pos0 + 64 * ((tt) - jb.nctx); \
    kr0 = ATT_KLD(kk0, kd0, kr_); kr1 = ATT_KLD(kk1, kd1, kr_); if (NCH > 8) kr2 = ATT_KLD(kk2, kd2, kr_); \
    vr0 = *(const u32x4*)(jb.V + (size_t)(kr_ + vk0) * jb.ldv + vd0 * 8); vr1 = *(const u32x4*)(jb.V + (size_t)(kr_ + vk0) * jb.ldv + vd1 * 8); }
#define ATT_VST(v, dc) { _Pragma("unroll") for (int j = 0; j < 4; ++j) { \
      sVt[((dc) * 8 + 2 * j) * PITCH + vk0] = (bf16_t)((v)[j] & 0xffffu); sVt[((dc) * 8 + 2 * j + 1) * PITCH + vk0] = (bf16_t)((v)[j] >> 16); } }
  ATT_LOAD(0);
  for (int t = 0; t < nt; ++t) {
    int kpos0; bool masked;
    if (t < jb.nctx) { kpos0 = 0; masked = false; }
    else { kpos0 = jb.loc_pos0 + 64 * (t - jb.nctx); masked = jb.window > 0; }
    __syncthreads();
    *(u32x4*)(sK + kk0 * KP + kd0 * 8) = kr0;
    *(u32x4*)(sK + kk1 * KP + kd1 * 8) = kr1;
    if (NCH > 8) *(u32x4*)(sK + kk2 * KP + kd2 * 8) = kr2;
    ATT_VST(vr0, vd0);
    ATT_VST(vr1, vd1);
    __syncthreads();
    { const int tn = t + 1 < nt ? t + 1 : t; ATT_LOAD(tn); }
    f32x16 st[2];
#pragma unroll
    for (int kb = 0; kb < 2; ++kb) {
#pragma unroll
      for (int i = 0; i < 16; ++i) st[kb][i] = 0.f;
#pragma unroll
      for (int ks = 0; ks < NKS; ++ks) {
        const bf16x8 a = *(const bf16x8*)(sK + (kb * 32 + l31) * KP + ks * 16 + h * 8);
        st[kb] = MFMA32(a, qf[ks], st[kb]);
      }
    }
    float mx = -1e30f;
#pragma unroll
    for (int kb = 0; kb < 2; ++kb)
#pragma unroll
      for (int i = 0; i < 16; ++i) {
        float s = st[kb][i] * jb.scale;
        if (masked) {
          const int kp = kpos0 + kb * 32 + crow(i, h);
          const int d = qpos - kp;
          if (d > jb.window || d < -jb.window) s = -1e30f;
        }
        st[kb][i] = s;
        mx = fmaxf(mx, s);
      }
    mx = fmaxf(mx, __shfl_xor(mx, 32));
    const float mn = fmaxf(m, mx);
    const float alpha = __expf(m - mn);
    m = mn;
    float ps = 0.f;
#pragma unroll
    for (int kb = 0; kb < 2; ++kb)
#pragma unroll
      for (int i = 0; i < 16; ++i) { const float pv = __expf(st[kb][i] - mn); st[kb][i] = pv; ps += pv; }
    lsum = lsum * alpha + ps;
#pragma unroll
    for (int d = 0; d < 2; ++d)
#pragma unroll
      for (int i = 0; i < 16; ++i) o[d][i] *= alpha;
#pragma unroll
    for (int kb = 0; kb < 2; ++kb)
#pragma unroll
      for (int s = 0; s < 2; ++s) {
        union { bf16x8 v; unsigned u[4]; } pf;
#pragma unroll
        for (int j = 0; j < 4; ++j) pf.u[j] = pack2(st[kb][8 * s + 2 * j], st[kb][8 * s + 2 * j + 1]);
#pragma unroll
        for (int d = 0; d < 2; ++d) {
          union { bf16x8 v; bf16x4 hlf[2]; } vf;
          vf.hlf[0] = *(const bf16x4*)(sVt + (d * 32 + l31) * PITCH + kb * 32 + 16 * s + 4 * h);
          vf.hlf[1] = *(const bf16x4*)(sVt + (d * 32 + l31) * PITCH + kb * 32 + 16 * s + 8 + 4 * h);
          o[d] = MFMA32(vf.v, pf.v, o[d]);
        }
      }
  }
  lsum += __shfl_xor(lsum, 32);
  float inv;
  if (jb.has_sink) {
    const float mf = fmaxf(m, jb.sink);
    const float corr = __expf(m - mf);
    inv = corr / (lsum * corr + __expf(jb.sink - mf));
  } else inv = 1.f / lsum;
  bf16_t* orow = jb.O + (size_t)qr * jb.ldo;
#pragma unroll
  for (int d = 0; d < 2; ++d)
#pragma unroll
    for (int g = 0; g < 4; ++g) {
      uint2 w;
      w.x = pack2(o[d][4 * g] * inv, o[d][4 * g + 1] * inv);
      w.y = pack2(o[d][4 * g + 2] * inv, o[d][4 * g + 3] * inv);
      *(uint2*)(orow + d * 32 + 8 * g + 4 * h) = w;
    }
}

DI void mla_item(const Params& p, int l, int grp, int it, unsigned char* smem) {
  AttnJob j;
  int b, head, qb;
  if (grp) { b = it >> 7; head = (it >> 5) & 3; qb = it & 31; } else { b = it >> 3; head = (it >> 1) & 3; qb = it & 1; }
  const int base = grp ? M_CTX + b * 4096 : b * 256;
  j.Q = p.QM + head * 96; j.ldq = 384;
  j.K1 = p.KV + head * 128; j.ldk1 = 512; j.K2 = p.KR; j.ldk2 = 32; j.V = p.KV + head * 128 + 64; j.ldv = 512;
  j.ctx_row0 = M_TOT + b * 256; j.nctx = grp ? 4 : 0;
  j.loc_row0 = base; j.loc_pos0 = 0; j.nloc = grp ? 64 : 4;
  j.qrow0 = base + qb * 128; j.qpos0 = qb * 128; j.window = 0;
  j.scale = 0.10206207261596577f; j.has_sink = 0; j.sink = 0.f;
  j.O = p.MIX + 768 + head * 64; j.ldo = 1024;
  attn_block<96>(j, smem);
}
DI void swa_item(const Params& p, int l, int grp, int it, unsigned char* smem) {
  AttnJob j;
  int b, hq, qb;
  if (grp) { b = it >> 7; hq = (it >> 5) & 3; qb = it & 31; } else { b = it >> 3; hq = (it >> 1) & 3; qb = it & 1; }
  const int base = grp ? M_CTX + b * 4096 : b * 256;
  const int g = hq >> 1;
  j.Q = p.QS + hq * 64; j.ldq = 256;
  j.K1 = p.KS + g * 64; j.ldk1 = 128; j.K2 = p.KS; j.ldk2 = 128; j.V = p.VS + g * 64; j.ldv = 128;
  j.ctx_row0 = M_TOT + b * 256; j.nctx = grp ? 4 : 0;
  if (grp) {
    const int lo = qb > 0 ? (qb - 1) * 128 : 0, hi = qb < 31 ? (qb + 2) * 128 : 4096;
    j.loc_pos0 = lo; j.nloc = (hi - lo) >> 6; j.window = 128;
  } else { j.loc_pos0 = 0; j.nloc = 4; j.window = 0; }
  j.loc_row0 = base;
  j.qrow0 = base + qb * 128; j.qpos0 = qb * 128;
  j.scale = 1.0f;
  j.has_sink = 1; j.sink = p.swa_sink[l * 4 + hq];
  j.O = p.MIX + 256 + hq * 64; j.ldo = 1024;
  attn_block<64>(j, smem);
}

DI bool tile_swz(int i, int nN, int T, int& tm, int& tn) {
  const int bid = lbid(), slots = gridDim.x >> 3;
  const int L = (i * 8 + (bid & 7)) * slots + (bid >> 3);
  if (L >= T) return false;
  const int pw = 8 * nN, pnl = L / pw, rem = L - pnl * pw;
  tn = rem >> 3; tm = pnl * 8 + (rem & 7);
  return true;
}
DI void phase_gemm_gu(const Params& p, int i, unsigned char* smem) {
  EpiGateUp epi{p.ACT};
  const bf16_t* W = p.WGU + (size_t)i * 5632 * 1024;
  { int tm, tn; const int nit = (160 * 44 + gridDim.x - 1) / gridDim.x + 8; for (int i = 0; i < nit; ++i) if (tile_swz(i, 44, 160 * 44, tm, tn)) gemm_tile(p.H, 1024, W, 1024, 1024, tm * 128, tn * 128, smem, epi); }
}
DI void phase_gemm_down(const Params& p, int i, unsigned char* smem) {
  EpiF32 epi{p.F, 1024};
  const bf16_t* W = p.WD + (size_t)i * 1024 * DFF;
  { int tm, tn; const int nit = (160 * 8 + gridDim.x - 1) / gridDim.x + 8; for (int i = 0; i < nit; ++i) if (tile_swz(i, 8, 160 * 8, tm, tn)) gemm_tile(p.ACT, DFF, W, DFF, DFF, tm * 128, tn * 128, smem, epi); }
}
DI void phase_gemm_win(const Params& p, int l, unsigned char* smem) {
  EpiWin epi{p.Z, p.out, l};
  { int tm, tn; const int nit = (160 * 18 + gridDim.x - 1) / gridDim.x + 8; for (int i = 0; i < nit; ++i) if (tile_swz(i, 18, 160 * 18, tm, tn)) gemm_tile(p.H, 1024, p.WIN, 1024, 1024, tm * 128, tn * 128, smem, epi); }
}
DI void phase_gemm_wout(const Params& p, unsigned char* smem) {
  EpiF32 epi{p.F, 1024};
  { int tm, tn; const int nit = (160 * 8 + gridDim.x - 1) / gridDim.x + 8; for (int i = 0; i < nit; ++i) if (tile_swz(i, 8, 160 * 8, tm, tn)) gemm_tile(p.MIX, 1024, p.WOUT, 1024, 1024, tm * 128, tn * 128, smem, epi); }
}
DI void phase_prep(const Params& p, int l, unsigned char* smem) {
  for (int t = lbid(); t < 672 + 2560; t += gridDim.x) {
    if (t < 672) prep_item(p, l, t, smem); else gla_pass_a(p, l, t - 672, smem);
  }
}
DI void phase_qkv(const Params& p, int l, unsigned char* smem) {
  EpiQm eq{p.QM, p.ROPE_M};
  EpiBf16 ekv{p.KV, 512, 1.f, 512};
  for (int t = lbid(); t < 160 + 480 + 672; t += gridDim.x) {
    if (t < 160) gla_pass_b(p, l, t);
    else if (t < 640) { const int u = t - 160, tm = u / 3, tn = u % 3; gemm_tile(p.QLAT, 256, p.WQB, 256, 256, tm * 128, tn * 128, smem, eq); }
    else { const int u = t - 640, tm = u >> 2, tn = u & 3; gemm_tile(p.CKV, 128, p.WKVB, 128, 128, tm * 128, tn * 128, smem, ekv); }
  }
}
DI void phase_mixers(const Params& p, int l, unsigned char* smem) {
  for (int t = lbid(); t < 2880; t += gridDim.x) {
    if (t < 512) mla_item(p, l, 1, t, smem);
    else if (t < 768) {
      const int u = t - 512, tm = (u & 7) + 8 * (u >> 6), rest = (u >> 3) & 7, b = rest >> 1, tn = rest & 1;
      EpiBf16 e{p.MIX + (size_t)(M_CTX + b * 4096) * 1024 + 512, 1024, 1.f / 512.f, 256};
      gemm_tile(p.TWL, 8192, p.ABTL + (size_t)b * 256 * 8192, 8192, 8192, tm * 128, tn * 128, smem, e);
    } else if (t < 1280) swa_item(p, l, 1, t - 768, smem);
    else if (t < 2304) gla_pass_c(p, l, t - 1280, smem);
    else if (t < 2432) mla_item(p, l, 0, t - 2304, smem);
    else if (t < 2560) swa_item(p, l, 0, t - 2432, smem);
    else if (t < 2624) {
      const int u = t - 2560, b = u >> 2, tm = (u >> 1) & 1, tn = u & 1;
      EpiBf16 e{p.MIX + (size_t)(b * 256) * 1024 + 512, 1024, 1.f / 128.f, 256};
      gemm_tile(p.TWC, 512, p.ABTC + (size_t)b * 256 * 512, 512, 512, tm * 128, tn * 128, smem, e);
    } else gla_pass_c(p, l, 1024 + (t - 2624), smem);
  }
}

#ifndef PROBE_DBL
#define PROBE_DBL 0
#endif
#define DBL(bit) (((PROBE_DBL) >> (bit)) & 1)
#ifndef ONLY_J
#define ONLY_J -1
#endif
#define EN(x) (ONLY_J < 0 || ONLY_J == (x))
constexpr int N_PHASES = 50;
#define MKP const PArg* kq = kp; asm volatile("" : "+s"(kq)); const Params p = make_params(*kq)
DI void run_phase(const PArg* kp, int ph, unsigned char* smem) {
  if (ph == 0) { if (EN(100)) { MKP; phase_init(p, smem); } return; }
  if (ph == 49) {
    MKP;
    EwArgs a{p.X, p.X + (size_t)M_CTX * DM, p.out + O_YP, p.out + O_YS, p.F, 3, 8, 5, 0.5f, 0, 0, 0, 0, 0};
    if (EN(101)) phase_ew(p, a);
    return;
  }
  const int l = (ph - 1) / 12, j = (ph - 1) % 12;
  switch (j) {
    case 0: if (EN(0)) {
      MKP; float* Xl = p.X + (size_t)M_CTX * DM;
      convert_layer(p, l, smem);
      if (l == 0) { EwArgs a{p.x_prompt, p.x_sample, p.X, Xl, nullptr, 0, 0, 0, 0.f, 1, 0, 1, 0, 0}; phase_ew(p, a); }
      else { EwArgs a{p.X, Xl, p.X, Xl, p.F, l - 1, 8, 5, 0.5f, 1, l, 1, 0, 0}; phase_ew(p, a); }
    } break;
    case 1: if (EN(1)) { MKP; phase_gemm_gu(p, 0, smem); if (DBL(0)) { phase_gemm_gu(p, 0, smem); } } break;
    case 2: if (EN(2)) { MKP; phase_gemm_down(p, 0, smem); if (DBL(0)) { phase_gemm_down(p, 0, smem); } } break;
    case 3: if (EN(3)) {
      MKP; float* Xl = p.X + (size_t)M_CTX * DM;
      if (l == 0) { EwArgs a{p.x_prompt, p.x_sample, p.X, Xl, p.F, l, 2, 1, 0.5f, 1, l, 4, 3, 2}; phase_ew(p, a); }
      else { EwArgs a{p.X, Xl, p.X, Xl, p.F, l, 2, 1, 0.5f, 1, l, 4, 3, 2}; phase_ew(p, a); }
    } break;
    case 4: if (EN(4)) { MKP; phase_gemm_win(p, l, smem); if (DBL(0)) { phase_gemm_win(p, l, smem); } } break;
    case 5: if (EN(5)) { MKP; phase_prep(p, l, smem); if (DBL(2)) { phase_prep(p, l, smem); } } break;
    case 6: if (EN(6)) { MKP; phase_qkv(p, l, smem); if (DBL(3)) { phase_qkv(p, l, smem); } } break;
    case 7: if (EN(7)) { MKP; phase_mixers(p, l, smem); if (DBL(1)) { phase_mixers(p, l, smem); } } break;
    case 8: if (EN(8)) { MKP; phase_gemm_wout(p, smem); if (DBL(0)) { phase_gemm_wout(p, smem); } } break;
    case 9: if (EN(9)) { MKP; float* Xl = p.X + (size_t)M_CTX * DM; EwArgs a{p.X, Xl, p.X, Xl, p.F, l, 5, 3, 1.0f, 1, l, 7, 6, 4}; phase_ew(p, a); } break;
    case 10: if (EN(10)) { MKP; phase_gemm_gu(p, 1, smem); if (DBL(0)) { phase_gemm_gu(p, 1, smem); } } break;
    case 11: if (EN(11)) { MKP; phase_gemm_down(p, 1, smem); if (DBL(0)) { phase_gemm_down(p, 1, smem); } } break;
  }
}

__global__ void __launch_bounds__(NT, 2) fwd_kernel(PArg pa, int ph_lo, int ph_hi) {
  __shared__ __attribute__((aligned(16))) unsigned char smem[SMEM_BYTES];
  const PArg* kp = (const PArg*)__builtin_amdgcn_kernarg_segment_ptr();
#if MULTI_LAUNCH
  for (int ph = ph_lo; ph < ph_hi; ++ph) run_phase(kp, ph, smem);
#else
  cg::grid_group grid = cg::this_grid();
  __shared__ uint4 xb_words;
  if (threadIdx.x == 0) xb_words = make_uint4(0u, 0u, 0u, 0u);
  __syncthreads();
  const XcdBarrier xb = xcd_barrier_post((unsigned*)(pa.ws + OFF_BAR), (volatile LAS unsigned*)&xb_words);
  for (int ph = ph_lo; ph < ph_hi; ++ph) {
    run_phase(kp, ph, smem);
    if (ph + 1 < ph_hi) { if (ph == ph_lo) grid.sync(); else xcd_barrier(xb); }
  }
#endif
}

extern "C" void kernel_launch(void* const* d_in, const int* in_sizes, int n_in, void* d_out, int out_size, void* d_ws, size_t ws_size,
                              hipStream_t stream) {
  PArg p{};
  for (int i = 0; i < 25; ++i) p.in[i] = (const float*)d_in[i];
  p.out = (float*)d_out;
  p.ws = (unsigned char*)d_ws;
  if (WS_NEED > ws_size) { fprintf(stderr, "workspace too small: need %zu have %zu\n", (size_t)WS_NEED, ws_size); return; }
#if MULTI_LAUNCH
  for (int ph = 0; ph < N_PHASES; ++ph) hipLaunchKernelGGL(fwd_kernel, dim3(512), dim3(NT), 0, stream, p, ph, ph + 1);
#else
  static int grid_blocks = 0;
  if (!grid_blocks) {
    int dev = 0, cus = 0, per_cu = 0;
    hipGetDevice(&dev);
    hipDeviceGetAttribute(&cus, hipDeviceAttributeMultiprocessorCount, dev);
    hipOccupancyMaxActiveBlocksPerMultiprocessor(&per_cu, fwd_kernel, NT, 0);
    if (per_cu > 2) per_cu = 2;
    grid_blocks = cus * per_cu;
  }
  hipMemsetAsync((unsigned char*)d_ws + OFF_BAR, 0, 16384, stream);
  int lo = 0, hi = N_PHASES;
  void* args[] = {&p, &lo, &hi};
  hipError_t e = hipLaunchCooperativeKernel((void*)fwd_kernel, dim3(grid_blocks), dim3(NT), args, 0, stream);
  if (e != hipSuccess) fprintf(stderr, "cooperative launch failed: %s (grid %d)\n", hipGetErrorString(e), grid_blocks);
#endif
}
```

```cpp
#include <hip/hip_runtime.h>
#include <hip/hip_cooperative_groups.h>
#include <cstdio>
#include <cstdint>
namespace cg = cooperative_groups;

#ifndef MULTI_LAUNCH
#define MULTI_LAUNCH 0
#endif

#define DI __device__ __forceinline__
typedef unsigned short bf16_t;
typedef short bf16x8 __attribute__((ext_vector_type(8)));
typedef short bf16x4 __attribute__((ext_vector_type(4)));
typedef float f32x16 __attribute__((ext_vector_type(16)));
typedef unsigned u32x4 __attribute__((ext_vector_type(4)));
typedef unsigned u32x2 __attribute__((ext_vector_type(2)));
#define MFMA32(a, b, c) __builtin_amdgcn_mfma_f32_32x32x16_bf16((a), (b), (c), 0, 0, 0)

constexpr int NT = 256, NW = NT / 64;
constexpr int DM = 1024, M_CTX = 4096, M_LAT = 16384, M_TOT = 20480, M_EXT = 21504;
constexpr int DFF = 2816, DIN = 2240;
constexpr float EPS = 1e-6f;
constexpr int SMEM_BYTES = 60 * 1024;
constexpr int PITCH = 72;
constexpr int ZQG = 0, ZKG = 256, ZVG = 512, ZRG = 768, ZAF = 1024, ZQS = 1056, ZKS = 1312, ZVS = 1440, ZF = 1568, ZQA = 1824, ZKVA = 2080, ZKR = 2208;
constexpr size_t O_YP = 0, O_YS = 4194304, O_ST = 20971520, O_SK = 23068672, O_SV = 25165824, O_CKV = 27262976, O_KR = 29360128;

struct Params {
  const float *x_prompt, *x_sample, *c, *state_gla, *cache_swa_k, *cache_swa_v, *cache_mla_ckv, *cache_mla_krope, *c_ctx,
      *w_mod, *b_mod, *g_norm, *w_gate, *w_up, *w_down, *w_in, *gla_w_gate, *gla_b_gate, *gla_g_out, *swa_sink, *mla_g_q,
      *mla_g_kv, *w_qb, *w_kvb, *w_out;
  float* out;
  float *X, *F, *MOD, *ROPE_S, *ROPE_M, *GLA_B, *GLA_DL;
  bf16_t *H, *TWL, *TWC, *WGU, *WD, *WIN, *WOUT, *WQB, *WKVB, *ACT, *Z, *QS, *KS, *VS, *CKV, *QLAT, *KR, *QM, *KV, *ABTL,
      *ABTC, *GLA_S, *MIX;
};

constexpr size_t al256(size_t x) { return (x + 255) & ~(size_t)255; }
constexpr size_t OFF_X = 0;
constexpr size_t OFF_H = OFF_X + al256((size_t)M_TOT * DM * 4);
constexpr size_t OFF_MOD = OFF_H + al256((size_t)M_TOT * DM * 2);
constexpr size_t OFF_ROPE_S = OFF_MOD + al256((size_t)4 * 5 * 9216 * 4);
constexpr size_t OFF_ROPE_M = OFF_ROPE_S + al256(64 * 16 * 2 * 4);
constexpr size_t OFF_TWL = OFF_ROPE_M + al256(64 * 8 * 2 * 4);
constexpr size_t OFF_TWC = OFF_TWL + al256((size_t)4096 * 8192 * 2);
constexpr size_t OFF_WGU = OFF_TWC + al256((size_t)256 * 512 * 2);
constexpr size_t OFF_WD = OFF_WGU + al256((size_t)2 * 5632 * 1024 * 2);
constexpr size_t OFF_WIN = OFF_WD + al256((size_t)2 * 1024 * DFF * 2);
constexpr size_t OFF_WOUT = OFF_WIN + al256((size_t)2304 * 1024 * 2);
constexpr size_t OFF_WQB = OFF_WOUT + al256((size_t)1024 * 1024 * 2);
constexpr size_t OFF_WKVB = OFF_WQB + al256((size_t)384 * 256 * 2);
constexpr size_t OFF_Z = OFF_WKVB + al256((size_t)512 * 128 * 2);
constexpr size_t OFF_QS = OFF_Z + al256((size_t)M_TOT * DIN * 2);
constexpr size_t OFF_KS = OFF_QS + al256((size_t)M_TOT * 256 * 2);
constexpr size_t OFF_VS = OFF_KS + al256((size_t)M_EXT * 128 * 2);
constexpr size_t OFF_CKV = OFF_VS + al256((size_t)M_EXT * 128 * 2);
constexpr size_t OFF_QLAT = OFF_CKV + al256((size_t)M_EXT * 128 * 2);
constexpr size_t OFF_KR = OFF_QLAT + al256((size_t)M_TOT * 256 * 2);
constexpr size_t OFF_QM = OFF_KR + al256((size_t)M_EXT * 32 * 2);
constexpr size_t OFF_KV = OFF_QM + al256((size_t)M_TOT * 384 * 2);
constexpr size_t OFF_ABTL = OFF_KV + al256((size_t)M_EXT * 512 * 2);
constexpr size_t OFF_ABTC = OFF_ABTL + al256((size_t)4 * 256 * 8192 * 2);
constexpr size_t OFF_GLA_B = OFF_ABTC + al256((size_t)16 * 256 * 512 * 2);
constexpr size_t OFF_GLA_DL = OFF_GLA_B + al256((size_t)2560 * 4096 * 4);
constexpr size_t OFF_GLA_S = OFF_GLA_DL + al256((size_t)2560 * 64 * 4);
constexpr size_t OFF_MIX = OFF_GLA_S + al256((size_t)2560 * 4096 * 2);
constexpr size_t OFF_BAR = OFF_MIX + al256((size_t)M_TOT * 1024 * 2);
constexpr size_t OFF_END0 = OFF_BAR + al256(16384);
constexpr size_t OFF_ACTEND = OFF_QS + al256((size_t)M_TOT * DFF * 2);
constexpr size_t WS_NEED = OFF_END0 > OFF_ACTEND ? OFF_END0 : OFF_ACTEND;
struct PArg { const float* in[25]; float* out; unsigned char* ws; };
#define GAS __attribute__((address_space(1)))
struct PArgG { GAS const float* in[25]; GAS float* out; GAS unsigned char* ws; };
DI Params make_params(const PArg& a0) {
  const PArgG& a = *(const PArgG*)&a0;
  Params p;
  p.x_prompt = (const float*)a.in[0];
  p.x_sample = (const float*)a.in[1];
  p.c = (const float*)a.in[2];
  p.state_gla = (const float*)a.in[3];
  p.cache_swa_k = (const float*)a.in[4];
  p.cache_swa_v = (const float*)a.in[5];
  p.cache_mla_ckv = (const float*)a.in[6];
  p.cache_mla_krope = (const float*)a.in[7];
  p.c_ctx = (const float*)a.in[8];
  p.w_mod = (const float*)a.in[9];
  p.b_mod = (const float*)a.in[10];
  p.g_norm = (const float*)a.in[11];
  p.w_gate = (const float*)a.in[12];
  p.w_up = (const float*)a.in[13];
  p.w_down = (const float*)a.in[14];
  p.w_in = (const float*)a.in[15];
  p.gla_w_gate = (const float*)a.in[16];
  p.gla_b_gate = (const float*)a.in[17];
  p.gla_g_out = (const float*)a.in[18];
  p.swa_sink = (const float*)a.in[19];
  p.mla_g_q = (const float*)a.in[20];
  p.mla_g_kv = (const float*)a.in[21];
  p.w_qb = (const float*)a.in[22];
  p.w_kvb = (const float*)a.in[23];
  p.w_out = (const float*)a.in[24];
  p.out = (float*)a.out;
  p.X = (float*)(GAS float*)(a.ws + OFF_X);
  p.H = (bf16_t*)(GAS bf16_t*)(a.ws + OFF_H);
  p.MOD = (float*)(GAS float*)(a.ws + OFF_MOD);
  p.ROPE_S = (float*)(GAS float*)(a.ws + OFF_ROPE_S);
  p.ROPE_M = (float*)(GAS float*)(a.ws + OFF_ROPE_M);
  p.TWL = (bf16_t*)(GAS bf16_t*)(a.ws + OFF_TWL);
  p.TWC = (bf16_t*)(GAS bf16_t*)(a.ws + OFF_TWC);
  p.WGU = (bf16_t*)(GAS bf16_t*)(a.ws + OFF_WGU);
  p.WD = (bf16_t*)(GAS bf16_t*)(a.ws + OFF_WD);
  p.WIN = (bf16_t*)(GAS bf16_t*)(a.ws + OFF_WIN);
  p.WOUT = (bf16_t*)(GAS bf16_t*)(a.ws + OFF_WOUT);
  p.WQB = (bf16_t*)(GAS bf16_t*)(a.ws + OFF_WQB);
  p.WKVB = (bf16_t*)(GAS bf16_t*)(a.ws + OFF_WKVB);
  p.Z = (bf16_t*)(GAS bf16_t*)(a.ws + OFF_Z);
  p.QS = (bf16_t*)(GAS bf16_t*)(a.ws + OFF_QS);
  p.KS = (bf16_t*)(GAS bf16_t*)(a.ws + OFF_KS);
  p.VS = (bf16_t*)(GAS bf16_t*)(a.ws + OFF_VS);
  p.CKV = (bf16_t*)(GAS bf16_t*)(a.ws + OFF_CKV);
  p.QLAT = (bf16_t*)(GAS bf16_t*)(a.ws + OFF_QLAT);
  p.KR = (bf16_t*)(GAS bf16_t*)(a.ws + OFF_KR);
  p.QM = (bf16_t*)(GAS bf16_t*)(a.ws + OFF_QM);
  p.KV = (bf16_t*)(GAS bf16_t*)(a.ws + OFF_KV);
  p.ABTL = (bf16_t*)(GAS bf16_t*)(a.ws + OFF_ABTL);
  p.ABTC = (bf16_t*)(GAS bf16_t*)(a.ws + OFF_ABTC);
  p.GLA_B = (float*)(GAS float*)(a.ws + OFF_GLA_B);
  p.GLA_DL = (float*)(GAS float*)(a.ws + OFF_GLA_DL);
  p.GLA_S = (bf16_t*)(GAS bf16_t*)(a.ws + OFF_GLA_S);
  p.MIX = (bf16_t*)(GAS bf16_t*)(a.ws + OFF_MIX);
  p.F = (float*)(GAS float*)(a.ws + OFF_Z);
  p.ACT = (bf16_t*)(GAS bf16_t*)(a.ws + OFF_QS);
  return p;
}

DI int ltid() { int t = __builtin_amdgcn_workitem_id_x(); asm volatile("" : "+v"(t)); return t; }
DI int lbid() { int t = __builtin_amdgcn_workgroup_id_x(); asm volatile("" : "+s"(t)); return t; }
DI bf16_t f2bf(float x) { unsigned u = __float_as_uint(x); u += 0x7fffu + ((u >> 16) & 1u); return (bf16_t)(u >> 16); }
DI float bf2f(bf16_t b) { return __uint_as_float(((unsigned)b) << 16); }
DI unsigned pack2(float a, float b) { return (unsigned)f2bf(a) | ((unsigned)f2bf(b) << 16); }
DI float wave_sum(float v) {
#pragma unroll
  for (int o = 32; o > 0; o >>= 1) v += __shfl_xor(v, o);
  return v;
}
DI float silu_f(float x) { return x / (1.f + __expf(-x)); }
DI int crow(int r, int h) { return (r & 3) + 8 * (r >> 2) + 4 * h; }


#define XB_TMO      128
#define XB_XCNT(j)  (256  + 64 * (j))
#define XB_XSUB(j)  (1280 + 64 * (j))
#define XB_XGEN(j)  (2304 + 64 * (j))
#define XB_TOP      3328
#define XB_TOPGEN   3392
#define XCD_BAR_WORDS 3456
#define XB_SPIN_CAP (1u << 22)
#define LAS __attribute__((address_space(3)))
DI unsigned xb_ld(unsigned* p) { return __hip_atomic_load(p, __ATOMIC_RELAXED, __HIP_MEMORY_SCOPE_AGENT); }
DI unsigned xb_add(unsigned* p, unsigned v) { return __hip_atomic_fetch_add(p, v, __ATOMIC_RELAXED, __HIP_MEMORY_SCOPE_AGENT); }
DI unsigned xb_xcc_id() { return (unsigned)__builtin_amdgcn_s_getreg((3 << 11) | 20) & 0xFu; }
#define XB_SPIN(cond, bar) do { unsigned _sp = 0; while (cond) { __builtin_amdgcn_s_sleep(1); \
    if ((++_sp & 255u) == 0u) { if (xb_ld(&(bar)[XB_TMO])) break; if (_sp > XB_SPIN_CAP) { atomicAdd(&(bar)[XB_TMO], 1u); break; } } } } while (0)
struct XcdBarrier { unsigned* bar; unsigned x; volatile LAS unsigned* st; };
DI XcdBarrier xcd_barrier_post(unsigned* bar, volatile LAS unsigned* st) {
  XcdBarrier b; b.bar = bar; b.x = xb_xcc_id(); b.st = st;
  if (threadIdx.x == 0) (void)xb_add(&bar[XB_XCNT(b.x)], 1u);
  return b;
}
DI void xcd_barrier_complete(unsigned* bar, unsigned x, unsigned& nloc, unsigned& nx) {
  const unsigned G = gridDim.x * gridDim.y * gridDim.z;
  unsigned sum, cnt, mine, sp = 0u;
  for (;;) {
    sum = 0u; cnt = 0u; mine = 0u;
#pragma unroll
    for (unsigned j = 0; j < 16; ++j) { const unsigned c = xb_ld(&bar[XB_XCNT(j)]); sum += c; cnt += (c > 0u) ? 1u : 0u; mine = (j == x) ? c : mine; }
    if (sum == G) break;
    __builtin_amdgcn_s_sleep(1);
    if ((++sp & 255u) == 0u) { if (xb_ld(&bar[XB_TMO])) break; if (sp > XB_SPIN_CAP) { atomicAdd(&bar[XB_TMO], 1u); break; } }
  }
  nloc = mine > 0u ? mine : 1u; nx = cnt > 0u ? cnt : 1u;
}
DI void xcd_barrier(const XcdBarrier& b) {
  asm volatile("s_waitcnt vmcnt(0)" ::: "memory");
  __syncthreads();
  if (threadIdx.x == 0) {
    unsigned* bar = b.bar;
    __builtin_amdgcn_s_waitcnt(0);
    unsigned nloc = b.st[0], nx = b.st[1];
    if (nloc == 0u) { xcd_barrier_complete(bar, b.x, nloc, nx); b.st[0] = nloc; b.st[1] = nx; }
    const unsigned old = xb_add(&bar[XB_XSUB(b.x)], 1u);
    const unsigned gen = old / nloc;
    if (old + 1u == (gen + 1u) * nloc) {
      __builtin_amdgcn_fence(__ATOMIC_RELEASE, "agent");
      asm volatile("s_waitcnt vmcnt(0)" ::: "memory");
      const unsigned og = xb_add(&bar[XB_TOP], 1u);
      const unsigned tg = og / nx;
      if (og + 1u == (tg + 1u) * nx) xb_add(&bar[XB_TOPGEN], 1u);
      else XB_SPIN(xb_ld(&bar[XB_TOPGEN]) == tg, bar);
      __builtin_amdgcn_fence(__ATOMIC_ACQUIRE, "agent");
      xb_add(&bar[XB_XGEN(b.x)], 1u);
      asm volatile("s_waitcnt vmcnt(0)" ::: "memory");
    } else {
      XB_SPIN(xb_ld(&bar[XB_XGEN(b.x)]) == gen, bar);
      __builtin_amdgcn_fence(__ATOMIC_ACQUIRE, "agent");
      asm volatile("s_waitcnt vmcnt(0)" ::: "memory");
    }
  }
  __syncthreads();
}

template <int MB, class Epi>
DI void gemm_tile(const bf16_t* __restrict__ A, int lda, const bf16_t* __restrict__ Bt, int ldb, int K, int m0, int n0,
                  unsigned char* smem, const Epi& epi) {
  constexpr int BMR = 64 * MB, NA = 2 * MB;
  bf16_t* sA = (bf16_t*)smem;
  bf16_t* sB = sA + BMR * PITCH;
  const int tid = ltid(), lane = tid & 63, wid = tid >> 6, wm = wid >> 1, wn = wid & 1, l31 = lane & 31, h = lane >> 5;
  f32x16 acc[2][MB];
#pragma unroll
  for (int a = 0; a < 2; ++a)
#pragma unroll
    for (int b = 0; b < MB; ++b)
#pragma unroll
      for (int i = 0; i < 16; ++i) acc[a][b][i] = 0.f;
  const int lrow = tid >> 3, lkc = tid & 7;
  const bf16_t* Ap = A + (size_t)(m0 + lrow) * lda + lkc * 8;
  const bf16_t* Bp = Bt + (size_t)(n0 + lrow) * ldb + lkc * 8;
  const size_t sa32 = (size_t)32 * lda, sb32 = (size_t)32 * ldb;
  bf16_t* wA = sA + lrow * PITCH + lkc * 8;
  bf16_t* wB = sB + lrow * PITCH + lkc * 8;
  u32x4 ra[NA], rb[4];
#pragma unroll
  for (int i = 0; i < NA; ++i) ra[i] = *(const u32x4*)(Ap + i * sa32);
#pragma unroll
  for (int i = 0; i < 4; ++i) rb[i] = *(const u32x4*)(Bp + i * sb32);
  for (int k0 = 0; k0 < K; k0 += 64) {
    __syncthreads();
#pragma unroll
    for (int i = 0; i < NA; ++i) *(u32x4*)(wA + i * 32 * PITCH) = ra[i];
#pragma unroll
    for (int i = 0; i < 4; ++i) *(u32x4*)(wB + i * 32 * PITCH) = rb[i];
    __syncthreads();
    {
      const int kn = (k0 + 64 < K) ? k0 + 64 : k0;
#pragma unroll
      for (int i = 0; i < NA; ++i) ra[i] = *(const u32x4*)(Ap + kn + i * sa32);
#pragma unroll
      for (int i = 0; i < 4; ++i) rb[i] = *(const u32x4*)(Bp + kn + i * sb32);
    }
#pragma unroll
    for (int ks = 0; ks < 4; ++ks) {
      bf16x8 af[MB], bfr[2];
#pragma unroll
      for (int b = 0; b < MB; ++b) af[b] = *(const bf16x8*)(sA + (wm * 32 * MB + b * 32 + l31) * PITCH + ks * 16 + h * 8);
#pragma unroll
      for (int b = 0; b < 2; ++b) bfr[b] = *(const bf16x8*)(sB + (wn * 64 + b * 32 + l31) * PITCH + ks * 16 + h * 8);
      __builtin_amdgcn_s_setprio(1);
#pragma unroll
      for (int nb = 0; nb < 2; ++nb)
#pragma unroll
        for (int mb = 0; mb < MB; ++mb) acc[nb][mb] = MFMA32(bfr[nb], af[mb], acc[nb][mb]);
      __builtin_amdgcn_s_setprio(0);
    }
  }
  epi(acc, m0 + wm * 32 * MB, n0 + wn * 64, l31, h);
}

struct EpiF32 {
  float* C; int ldc;
  template <int MB> DI void operator()(const f32x16 (&acc)[2][MB], int mb0, int nb0, int l31, int h) const {
#pragma unroll
    for (int nb = 0; nb < 2; ++nb)
#pragma unroll
      for (int mb = 0; mb < MB; ++mb) {
        float* row = C + (size_t)(mb0 + mb * 32 + l31) * ldc + nb0 + nb * 32 + 4 * h;
#pragma unroll
        for (int g = 0; g < 4; ++g)
          *(float4*)(row + 8 * g) = make_float4(acc[nb][mb][4 * g], acc[nb][mb][4 * g + 1], acc[nb][mb][4 * g + 2], acc[nb][mb][4 * g + 3]);
      }
  }
};
struct EpiBf16 {
  bf16_t* C; int ldc; float scale; int ncols;
  template <int MB> DI void operator()(const f32x16 (&acc)[2][MB], int mb0, int nb0, int l31, int h) const {
#pragma unroll
    for (int nb = 0; nb < 2; ++nb)
#pragma unroll
      for (int mb = 0; mb < MB; ++mb) {
        const int col0 = nb0 + nb * 32 + 4 * h;
        bf16_t* row = C + (size_t)(mb0 + mb * 32 + l31) * ldc + col0;
#pragma unroll
        for (int g = 0; g < 4; ++g) {
          if (col0 + 8 * g < ncols) {
            uint2 w;
            w.x = pack2(acc[nb][mb][4 * g] * scale, acc[nb][mb][4 * g + 1] * scale);
            w.y = pack2(acc[nb][mb][4 * g + 2] * scale, acc[nb][mb][4 * g + 3] * scale);
            *(uint2*)(row + 8 * g) = w;
          }
        }
      }
  }
};
struct EpiGateUp {
  bf16_t* C;
  template <int MB> DI void operator()(const f32x16 (&acc)[2][MB], int mb0, int nb0, int l31, int h) const {
#pragma unroll
    for (int mb = 0; mb < MB; ++mb) {
      bf16_t* row = C + (size_t)(mb0 + mb * 32 + l31) * DFF + (nb0 >> 1) + 4 * h;
#pragma unroll
      for (int g = 0; g < 4; ++g) {
        float v[4];
#pragma unroll
        for (int i = 0; i < 4; ++i) v[i] = silu_f(acc[0][mb][4 * g + i]) * acc[1][mb][4 * g + i];
        uint2 w; w.x = pack2(v[0], v[1]); w.y = pack2(v[2], v[3]);
        *(uint2*)(row + 8 * g) = w;
      }
    }
  }
};
struct EpiWin {
  bf16_t* Z; float* out; int l;
  template <int MB> DI void operator()(const f32x16 (&acc)[2][MB], int mb0, int nb0, int l31, int h) const {
#pragma unroll
    for (int nb = 0; nb < 2; ++nb)
#pragma unroll
      for (int mb = 0; mb < MB; ++mb) {
        const int m = mb0 + mb * 32 + l31;
        const int col0 = nb0 + nb * 32 + 4 * h;
        bf16_t* row = Z + (size_t)m * DIN + col0;
#pragma unroll
        for (int g = 0; g < 4; ++g) {
          const int col = col0 + 8 * g;
          if (col < DIN) {
            uint2 w;
            w.x = pack2(acc[nb][mb][4 * g], acc[nb][mb][4 * g + 1]);
            w.y = pack2(acc[nb][mb][4 * g + 2], acc[nb][mb][4 * g + 3]);
            *(uint2*)(row + 8 * g) = w;
            if (m < M_CTX) {
              const int b = m >> 8, s = m & 255;
              const size_t tok = (size_t)((b * 4 + l) * 256 + s);
              float* dst = nullptr;
              if (col >= ZKS && col < ZVS) dst = out + O_SK + tok * 128 + (col - ZKS);
              else if (col >= ZVS && col < ZF) dst = out + O_SV + tok * 128 + (col - ZVS);
              else if (col >= ZKR) dst = out + O_KR + tok * 32 + (col - ZKR);
              if (dst) *(float4*)dst = make_float4(acc[nb][mb][4 * g], acc[nb][mb][4 * g + 1], acc[nb][mb][4 * g + 2], acc[nb][mb][4 * g + 3]);
            }
          }
        }
      }
  }
};
struct EpiQm {
  bf16_t* C; const float* rope_m;
  template <int MB> DI void operator()(const f32x16 (&acc)[2][MB], int mb0, int nb0, int l31, int h) const {
#pragma unroll
    for (int nb = 0; nb < 2; ++nb) {
      const int cb = nb0 + nb * 32;
      const bool isrope = ((cb >> 5) % 3) == 2;
#pragma unroll
      for (int mb = 0; mb < MB; ++mb) {
        const int m = mb0 + mb * 32 + l31;
        float v[16];
#pragma unroll
        for (int i = 0; i < 16; ++i) v[i] = acc[nb][mb][i];
        if (isrope && m >= M_CTX) {
          const int t = (m - M_CTX) & 4095;
          const int prow = t >> 6, pcol = t & 63;
#pragma unroll
          for (int half = 0; half < 2; ++half) {
            const int pos = half ? pcol : prow;
#pragma unroll
            for (int i = 0; i < 4; ++i) {
              const int j = 4 * h + i;
              const float cs = rope_m[(pos * 8 + j) * 2], sn = rope_m[(pos * 8 + j) * 2 + 1];
              const float x1 = v[8 * half + i], x2 = v[8 * half + 4 + i];
              v[8 * half + i] = x1 * cs - x2 * sn;
              v[8 * half + 4 + i] = x2 * cs + x1 * sn;
            }
          }
        }
        bf16_t* row = C + (size_t)m * 384 + cb + 4 * h;
#pragma unroll
        for (int g = 0; g < 4; ++g) {
          uint2 w; w.x = pack2(v[4 * g], v[4 * g + 1]); w.y = pack2(v[4 * g + 2], v[4 * g + 3]);
          *(uint2*)(row + 8 * g) = w;
        }
      }
    }
  }
};

DI void mod_item(const Params& p, int it, unsigned char* smem) {
  float* sc = (float*)smem;
  float* red = sc + 5 * 1024;
  const int tid = ltid(), lane = tid & 63, wid = tid >> 6;
  const int l = it / 144, n = (it % 144) * 64 + lane;
  __syncthreads();
  for (int e = tid; e < 5 * 1024; e += NT) {
    const int i = e >> 10, k = e & 1023;
    const float v = i == 0 ? p.c_ctx[k] : p.c[(i - 1) * 1024 + k];
    sc[e] = v / (1.f + expf(-v));
  }
  __syncthreads();
  float a0 = 0, a1 = 0, a2 = 0, a3 = 0, a4 = 0;
  const float* w = p.w_mod + ((size_t)l * 1024 + wid * 256) * 9216 + n;
#pragma unroll 8
  for (int k = 0; k < 256; ++k) {
    const float wv = w[(size_t)k * 9216];
    const int kk = wid * 256 + k;
    a0 += sc[kk] * wv; a1 += sc[1024 + kk] * wv; a2 += sc[2048 + kk] * wv; a3 += sc[3072 + kk] * wv; a4 += sc[4096 + kk] * wv;
  }
  red[(wid * 5 + 0) * 64 + lane] = a0; red[(wid * 5 + 1) * 64 + lane] = a1; red[(wid * 5 + 2) * 64 + lane] = a2;
  red[(wid * 5 + 3) * 64 + lane] = a3; red[(wid * 5 + 4) * 64 + lane] = a4;
  __syncthreads();
  for (int e = tid; e < 320; e += NT) {
    const int i = e >> 6, cl = e & 63;
    float s = 0.f;
    for (int w4 = 0; w4 < 4; ++w4) s += red[(w4 * 5 + i) * 64 + cl];
    const int col = (it % 144) * 64 + cl;
    p.MOD[(size_t)(l * 5 + i) * 9216 + col] = s + p.b_mod[(size_t)l * 9216 + col];
  }
}

DI void phase_init(const Params& p, unsigned char* smem) {
  const int nb = gridDim.x, bid = lbid(), tid = ltid();
  for (int it = bid; it < 1602; it += nb) {
    if (it < 576) mod_item(p, it, smem);
    else if (it < 1600) {
      const int r0 = (it - 576) * 4;
      for (int e = tid; e < 4 * 1024; e += NT) {
        const int r = r0 + (e >> 10), k8 = (e & 1023) * 8;
        unsigned w[4];
#pragma unroll
        for (int j = 0; j < 4; ++j) {
          float v[2];
#pragma unroll
          for (int q = 0; q < 2; ++q) {
            const int k = k8 + 2 * j + q;
            const int idx = (r * (k & 4095)) & 4095;
            const float ang = (float)idx * (1.0f / 2048.0f);
            v[q] = k < 4096 ? cospif(ang) : -sinpif(ang);
          }
          w[j] = pack2(v[0], v[1]);
        }
        *(uint4*)(p.TWL + (size_t)r * 8192 + k8) = make_uint4(w[0], w[1], w[2], w[3]);
      }
    } else if (it == 1600) {
      for (int e = tid; e < 256 * 512; e += NT) {
        const int r = e >> 9, k = e & 511;
        const int idx = (r * (k & 255)) & 255;
        const float ang = (float)idx * (1.0f / 128.0f);
        p.TWC[e] = f2bf(k < 256 ? cospif(ang) : -sinpif(ang));
      }
    } else {
      for (int e = tid; e < 64 * 16; e += NT) {
        const int pos = e >> 4, j = e & 15;
        const float inv = powf(10000.0f, -(float)(2 * j) / 32.0f);
        const float ang = (float)pos * inv;
        p.ROPE_S[e * 2] = cosf(ang); p.ROPE_S[e * 2 + 1] = sinf(ang);
      }
      for (int e = tid; e < 64 * 8; e += NT) {
        const int pos = e >> 3, j = e & 7;
        const float inv = powf(10000.0f, -(float)(2 * j) / 16.0f);
        const float ang = (float)pos * inv;
        p.ROPE_M[e * 2] = cosf(ang); p.ROPE_M[e * 2 + 1] = sinf(ang);
      }
    }
  }
}

DI void conv_tile(const float* __restrict__ src, int N, bf16_t* __restrict__ dst, int K, int kt, int nt, int mode, unsigned char* smem) {
  float* ts = (float*)smem;
  const int tid = ltid();
  __syncthreads();
#pragma unroll
  for (int i = 0; i < 4; ++i) {
    const int r = (tid >> 4) + 16 * i, c4 = (tid & 15) * 4;
    const float4 v = *(const float4*)(src + (size_t)(kt * 64 + r) * N + nt * 64 + c4);
    ts[r * 65 + c4] = v.x; ts[r * 65 + c4 + 1] = v.y; ts[r * 65 + c4 + 2] = v.z; ts[r * 65 + c4 + 3] = v.w;
  }
  __syncthreads();
  const int nl = tid >> 2, ks = (tid & 3) * 16;
  const int n = nt * 64 + nl;
  int drow = n;
  if (mode == 1) drow = (n >> 5) * 64 + (n & 31);
  else if (mode == 2) drow = (n >> 5) * 64 + 32 + (n & 31);
  unsigned w[8];
#pragma unroll
  for (int j = 0; j < 8; ++j) w[j] = pack2(ts[(ks + 2 * j) * 65 + nl], ts[(ks + 2 * j + 1) * 65 + nl]);
  bf16_t* d = dst + (size_t)drow * K + kt * 64 + ks;
  *(uint4*)d = make_uint4(w[0], w[1], w[2], w[3]);
  *(uint4*)(d + 8) = make_uint4(w[4], w[5], w[6], w[7]);
}
DI void convert_layer(const Params& p, int l, unsigned char* smem) {
  for (int t = lbid(); t < 5080; t += gridDim.x) {
    if (t < 2816) {
      const int q = t / 704, r = t % 704, i = q >> 1, which = q & 1;
      const float* src = (which ? p.w_up : p.w_gate) + (size_t)(l * 2 + i) * 1024 * DFF;
      conv_tile(src, DFF, p.WGU + (size_t)i * 5632 * 1024, 1024, r / 44, r % 44, 1 + which, smem);
    } else if (t < 4224) {
      const int q = (t - 2816) / 704, r = (t - 2816) % 704;
      conv_tile(p.w_down + (size_t)(l * 2 + q) * DFF * 1024, 1024, p.WD + (size_t)q * 1024 * DFF, DFF, r / 16, r % 16, 0, smem);
    } else if (t < 4784) {
      const int r = t - 4224;
      conv_tile(p.w_in + (size_t)l * 1024 * DIN, DIN, p.WIN, 1024, r / 35, r % 35, 0, smem);
    } else if (t < 5040) {
      const int r = t - 4784;
      conv_tile(p.w_out + (size_t)l * 1024 * 1024, 1024, p.WOUT, 1024, r / 16, r % 16, 0, smem);
    } else if (t < 5064) {
      const int r = t - 5040;
      conv_tile(p.w_qb + (size_t)l * 256 * 384, 384, p.WQB, 256, r / 6, r % 6, 0, smem);
    } else {
      const int r = t - 5064;
      conv_tile(p.w_kvb + (size_t)l * 128 * 512, 512, p.WKVB, 128, r / 8, r % 8, 0, smem);
    }
  }
}

struct EwArgs {
  const float *xin_ctx, *xin_lat; float *xout_ctx, *xout_lat;
  const float* F; int lu, gate_idx, gpost_idx; float res_w;
  int do_norm, ln, sc_idx, sh_idx, gpre_idx;
};
DI void phase_ew(const Params& p, const EwArgs& a) {
  const int lane = ltid() & 63, gw = lbid() * NW + (ltid() >> 6), gs = gridDim.x * NW;
  const bool upd = a.F != nullptr;
  for (int r = gw; r < M_TOT; r += gs) {
    const int mi = r < M_CTX ? 0 : 1 + ((r - M_CTX) >> 12);
    const float* __restrict__ xs = r < M_CTX ? a.xin_ctx + (size_t)r * DM : a.xin_lat + (size_t)(r - M_CTX) * DM;
    const float* __restrict__ fr = (upd ? a.F : xs - (size_t)0) + (upd ? (size_t)r * DM : 0);
    const float* __restrict__ gate = p.MOD + (size_t)(a.lu * 5 + mi) * 9216 + a.gate_idx * 1024;
    const float* __restrict__ gpo = p.g_norm + (size_t)(a.lu * 6 + a.gpost_idx) * 1024;
    const float* __restrict__ sc = p.MOD + (size_t)(a.ln * 5 + mi) * 9216 + a.sc_idx * 1024;
    const float* __restrict__ sh = p.MOD + (size_t)(a.ln * 5 + mi) * 9216 + a.sh_idx * 1024;
    const float* __restrict__ gpr = p.g_norm + (size_t)(a.ln * 6 + a.gpre_idx) * 1024;
    float4 x[4], f[4], g[4], q[4], s4[4], t4[4], u4[4];
#pragma unroll
    for (int j = 0; j < 4; ++j) {
      const int c = lane * 4 + 256 * j;
      x[j] = *(const float4*)(xs + c);
      if (upd) { f[j] = *(const float4*)(fr + c); g[j] = *(const float4*)(gate + c); q[j] = *(const float4*)(gpo + c); }
      if (a.do_norm) { s4[j] = *(const float4*)(sc + c); t4[j] = *(const float4*)(sh + c); u4[j] = *(const float4*)(gpr + c); }
    }
    if (upd) {
      float ss = 0.f;
#pragma unroll
      for (int j = 0; j < 4; ++j) ss += f[j].x * f[j].x + f[j].y * f[j].y + f[j].z * f[j].z + f[j].w * f[j].w;
      ss = wave_sum(ss);
      const float rs = rsqrtf(ss * (1.f / 1024.f) + EPS) * a.res_w;
      float* xo = r < M_CTX ? a.xout_ctx + (size_t)r * DM : a.xout_lat + (size_t)(r - M_CTX) * DM;
#pragma unroll
      for (int j = 0; j < 4; ++j) {
        x[j].x += g[j].x * (f[j].x * rs * q[j].x); x[j].y += g[j].y * (f[j].y * rs * q[j].y);
        x[j].z += g[j].z * (f[j].z * rs * q[j].z); x[j].w += g[j].w * (f[j].w * rs * q[j].w);
        *(float4*)(xo + lane * 4 + 256 * j) = x[j];
      }
    }
    if (a.do_norm) {
      float ss = 0.f;
#pragma unroll
      for (int j = 0; j < 4; ++j) ss += x[j].x * x[j].x + x[j].y * x[j].y + x[j].z * x[j].z + x[j].w * x[j].w;
      ss = wave_sum(ss);
      const float rs = rsqrtf(ss * (1.f / 1024.f) + EPS);
      bf16_t* hr = p.H + (size_t)r * DM;
#pragma unroll
      for (int j = 0; j < 4; ++j) {
        u32x2 w;
        w[0] = pack2(x[j].x * rs * u4[j].x * (1.f + s4[j].x) + t4[j].x, x[j].y * rs * u4[j].y * (1.f + s4[j].y) + t4[j].y);
        w[1] = pack2(x[j].z * rs * u4[j].z * (1.f + s4[j].z) + t4[j].z, x[j].w * rs * u4[j].w * (1.f + s4[j].w) + t4[j].w);
        *(u32x2*)(hr + lane * 4 + 256 * j) = w;
      }
    }
  }
}

DI void prep_item(const Params& p, int l, int it, unsigned char* smem) {
  const int tid = ltid(), lane = tid & 63, wid = tid >> 6;
  const int r0 = it * 32;
  if (r0 >= M_TOT) {
    for (int e = tid; e < 32 * 128; e += NT) {
      const int rr = e >> 7, cc = e & 127, idx = r0 - M_TOT + rr, b = idx >> 8, j = idx & 255;
      const size_t src = ((size_t)(b * 4 + l) * 256 + j) * 128 + cc;
      const size_t dst = (size_t)(r0 + rr) * 128 + cc;
      p.KS[dst] = f2bf(p.cache_swa_k[src]);
      p.VS[dst] = f2bf(p.cache_swa_v[src]);
      p.CKV[dst] = f2bf(p.cache_mla_ckv[src]);
    }
    for (int e = tid; e < 32 * 32; e += NT) {
      const int rr = e >> 5, cc = e & 31, idx = r0 - M_TOT + rr, b = idx >> 8, j = idx & 255;
      p.KR[(size_t)(r0 + rr) * 32 + cc] = f2bf(p.cache_mla_krope[((size_t)(b * 4 + l) * 256 + j) * 32 + cc]);
    }
    return;
  }
  const bool lat = r0 >= M_CTX;
  const bf16_t* __restrict__ Zr = p.Z; bf16_t* __restrict__ QSr = p.QS; bf16_t* __restrict__ KSr = p.KS; bf16_t* __restrict__ VSr = p.VS; const float* __restrict__ RSr = p.ROPE_S;
#pragma unroll 4
  for (int e = tid; e < 32 * 128; e += NT) {
    const int rr = e >> 7, rem = e & 127, head = rem >> 5, half = (rem >> 4) & 1, j = rem & 15;
    const int r = r0 + rr;
    const bf16_t* __restrict__ z = Zr + (size_t)r * DIN;
    const int d1 = head * 64 + half * 32 + j, d2 = d1 + 16;
    float x1 = bf2f(z[ZQS + d1]), x2 = bf2f(z[ZQS + d2]);
    float cs = 1.f, sn = 0.f;
    if (lat) { const int t = (r - M_CTX) & 4095; const int pos = half ? (t & 63) : (t >> 6); cs = RSr[(pos * 16 + j) * 2]; sn = RSr[(pos * 16 + j) * 2 + 1]; }
    QSr[(size_t)r * 256 + d1] = f2bf((x1 * cs - x2 * sn) * 0.125f);
    QSr[(size_t)r * 256 + d2] = f2bf((x2 * cs + x1 * sn) * 0.125f);
    if (head < 2) {
      x1 = bf2f(z[ZKS + d1]); x2 = bf2f(z[ZKS + d2]);
      KSr[(size_t)r * 128 + d1] = f2bf(x1 * cs - x2 * sn);
      KSr[(size_t)r * 128 + d2] = f2bf(x2 * cs + x1 * sn);
      VSr[(size_t)r * 128 + d1] = z[ZVS + d1];
      VSr[(size_t)r * 128 + d2] = z[ZVS + d2];
    }
  }
  for (int e = tid; e < 32 * 16; e += NT) {
    const int rr = e >> 4, half = (e >> 3) & 1, j = e & 7, r = r0 + rr;
    const bf16_t* z = p.Z + (size_t)r * DIN + ZKR;
    const int d1 = half * 16 + j, d2 = d1 + 8;
    const float x1 = bf2f(z[d1]), x2 = bf2f(z[d2]);
    float cs = 1.f, sn = 0.f;
    if (lat) { const int t = (r - M_CTX) & 4095; const int pos = half ? (t & 63) : (t >> 6); cs = p.ROPE_M[(pos * 8 + j) * 2]; sn = p.ROPE_M[(pos * 8 + j) * 2 + 1]; }
    p.KR[(size_t)r * 32 + d1] = f2bf(x1 * cs - x2 * sn);
    p.KR[(size_t)r * 32 + d2] = f2bf(x2 * cs + x1 * sn);
  }
  for (int rr = wid; rr < 32; rr += NW) {
    const int r = r0 + rr;
    const bf16_t* z = p.Z + (size_t)r * DIN;
    {
      const float a = bf2f(z[ZKVA + lane]), b = bf2f(z[ZKVA + 64 + lane]);
      const float rs = rsqrtf(wave_sum(a * a + b * b) * (1.f / 128.f) + EPS);
      const float o0 = a * rs * p.mla_g_kv[l * 128 + lane], o1 = b * rs * p.mla_g_kv[l * 128 + 64 + lane];
      p.CKV[(size_t)r * 128 + lane] = f2bf(o0); p.CKV[(size_t)r * 128 + 64 + lane] = f2bf(o1);
      if (!lat) {
        const int b_ = r >> 8, s = r & 255;
        float* dst = p.out + O_CKV + ((size_t)(b_ * 4 + l) * 256 + s) * 128;
        dst[lane] = o0; dst[64 + lane] = o1;
      }
    }
    {
      float v[4]; float ss = 0.f;
#pragma unroll
      for (int j = 0; j < 4; ++j) { v[j] = bf2f(z[ZQA + lane + 64 * j]); ss += v[j] * v[j]; }
      const float rs = rsqrtf(wave_sum(ss) * (1.f / 256.f) + EPS);
#pragma unroll
      for (int j = 0; j < 4; ++j) p.QLAT[(size_t)r * 256 + lane + 64 * j] = f2bf(v[j] * rs * p.mla_g_q[l * 256 + lane + 64 * j]);
    }
  }
  {
    float* tw = (float*)smem;
    __syncthreads();
    if (tid < 64) tw[tid] = cospif((float)tid * (1.f / 32.f));
    __syncthreads();
    const int tk = tid & 31, og = tid >> 5, g = og >> 1, type = og & 1;
    const int r = r0 + tk;
    float zr[64];
    {
      const uint4* zp = (const uint4*)(p.Z + (size_t)r * DIN + ZF + g * 64);
#pragma unroll
      for (int q = 0; q < 8; ++q) {
        const uint4 u = zp[q];
        const unsigned uu[4] = {u.x, u.y, u.z, u.w};
#pragma unroll
        for (int j = 0; j < 4; ++j) { zr[q * 8 + 2 * j] = __uint_as_float(uu[j] << 16); zr[q * 8 + 2 * j + 1] = __uint_as_float(uu[j] & 0xffff0000u); }
      }
    }
    bf16_t* dst;
    int dstride;
    if (lat) { const int b = (r - M_CTX) >> 12, s = (r - M_CTX) & 4095; dst = p.ABTL + ((size_t)b * 256 + g * 64) * 8192 + type * 4096 + s; dstride = 8192; }
    else { const int b = r >> 8, s = r & 255; dst = p.ABTC + ((size_t)b * 256 + g * 64) * 512 + type * 256 + s; dstride = 512; }
    const int off = type ? 48 : 0;
    for (int cp = 0; cp < 64; ++cp) {
      float acc = 0.f; int idx = off;
#pragma unroll
      for (int c = 0; c < 64; ++c) { acc += zr[c] * tw[idx & 63]; idx += cp; }
      dst[(size_t)cp * dstride] = f2bf(acc);
    }
  }
}

DI void gla_cum(const Params& p, int l, int head, int dir, int row0, int rstep, float* sa, float* qt, f32x16& cum, float& last) {
  const int tid = ltid(), dk = tid & 63, quarter = tid >> 6;
  __syncthreads();
  for (int e = tid; e < 64 * 16; e += NT) {
    const int i = e >> 4, rr = e & 15;
    sa[e] = bf2f(p.Z[(size_t)(row0 + i * rstep) * DIN + ZAF + dir * 16 + rr]);
  }
  __syncthreads();
  float wg[16];
  const float* W = p.gla_w_gate + ((size_t)(l * 2 + dir) * 16) * 256 + head * 64 + dk;
#pragma unroll
  for (int rr = 0; rr < 16; ++rr) wg[rr] = W[rr * 256];
  const float bg = p.gla_b_gate[(l * 2 + dir) * 256 + head * 64 + dk];
  float run = 0.f;
#pragma unroll
  for (int ii = 0; ii < 16; ++ii) {
    const int i = quarter * 16 + ii;
    float lg = bg;
#pragma unroll
    for (int rr = 0; rr < 16; ++rr) lg += sa[i * 16 + rr] * wg[rr];
    const float ls = fminf(lg, 0.f) - __logf(1.f + __expf(-fabsf(lg)));
    run += ls * (1.f / 16.f);
    cum[ii] = run;
  }
  qt[quarter * 64 + dk] = run;
  __syncthreads();
  float offs = 0.f, tot = 0.f;
#pragma unroll
  for (int q = 0; q < 4; ++q) { const float v = qt[q * 64 + dk]; tot += v; if (q < quarter) offs += v; }
#pragma unroll
  for (int ii = 0; ii < 16; ++ii) cum[ii] += offs;
  last = tot;
}

DI void gla_seq_info(int sq_global, int& grp, int& b, int& head, int& dir, int& S, int& base) {
  if (sq_global < 32) { grp = 1; b = sq_global >> 3; head = (sq_global >> 1) & 3; dir = sq_global & 1; S = 4096; base = M_CTX + b * 4096; }
  else { const int s = sq_global - 32; grp = 0; b = s >> 3; head = (s >> 1) & 3; dir = s & 1; S = 256; base = b * 256; }
}

DI void gla_pass_a(const Params& p, int l, int ci, unsigned char* smem) {
  float* sa = (float*)smem;
  float* qt = sa + 1024;
  bf16_t* kdT = (bf16_t*)(qt + 256);
  bf16_t* vT = kdT + 64 * PITCH;
  const int tid = ltid(), lane = tid & 63, wid = tid >> 6, dk = tid & 63, quarter = tid >> 6, l31 = lane & 31, h = lane >> 5;
  int sqg, c;
  if (ci < 2048) { sqg = ci >> 6; c = ci & 63; } else { sqg = 32 + ((ci - 2048) >> 2); c = (ci - 2048) & 3; }
  int grp, b, head, dir, S, base;
  gla_seq_info(sqg, grp, b, head, dir, S, base);
  const int row0 = dir ? base + S - 1 - 64 * c : base + 64 * c, rstep = dir ? -1 : 1;
  f32x16 cum; float last;
  gla_cum(p, l, head, dir, row0, rstep, sa, qt, cum, last);
  unsigned kw[8], vw[8];
#pragma unroll
  for (int j = 0; j < 8; ++j) {
    float kv[2], vv[2];
#pragma unroll
    for (int q = 0; q < 2; ++q) {
      const int ii = 2 * j + q, i = quarter * 16 + ii;
      const bf16_t* z = p.Z + (size_t)(row0 + i * rstep) * DIN;
      kv[q] = bf2f(z[ZKG + head * 64 + dk]) * __expf(last - cum[ii]);
      vv[q] = bf2f(z[ZVG + head * 64 + dk]);
    }
    kw[j] = pack2(kv[0], kv[1]); vw[j] = pack2(vv[0], vv[1]);
  }
  *(uint4*)(kdT + dk * PITCH + quarter * 16) = make_uint4(kw[0], kw[1], kw[2], kw[3]);
  *(uint4*)(kdT + dk * PITCH + quarter * 16 + 8) = make_uint4(kw[4], kw[5], kw[6], kw[7]);
  *(uint4*)(vT + dk * PITCH + quarter * 16) = make_uint4(vw[0], vw[1], vw[2], vw[3]);
  *(uint4*)(vT + dk * PITCH + quarter * 16 + 8) = make_uint4(vw[4], vw[5], vw[6], vw[7]);
  if (quarter == 0) p.GLA_DL[(size_t)ci * 64 + dk] = expf(last);
  __syncthreads();
  const int wr = wid >> 1, wc = wid & 1;
  f32x16 acc;
#pragma unroll
  for (int i = 0; i < 16; ++i) acc[i] = 0.f;
#pragma unroll
  for (int ks = 0; ks < 4; ++ks) {
    const bf16x8 a = *(const bf16x8*)(kdT + (wr * 32 + l31) * PITCH + ks * 16 + h * 8);
    const bf16x8 bb = *(const bf16x8*)(vT + (wc * 32 + l31) * PITCH + ks * 16 + h * 8);
    acc = MFMA32(a, bb, acc);
  }
  float* Bc = p.GLA_B + (size_t)ci * 4096;
#pragma unroll
  for (int i = 0; i < 16; ++i) Bc[(wr * 32 + crow(i, h)) * 64 + wc * 32 + l31] = acc[i];
}

DI void gla_pass_b(const Params& p, int l, int sqg) {
  const int tid = ltid(), dv = tid >> 2, dk0 = (tid & 3) * 16;
  int grp, b, head, dir, S, base;
  gla_seq_info(sqg, grp, b, head, dir, S, base);
  const int nch = S >> 6;
  const int ci0 = grp ? sqg * 64 : 2048 + (sqg - 32) * 4;
  f32x16 s;
  if (grp) {
    const float* s0 = p.state_gla + ((((size_t)b * 4 + l) * 2 + dir) * 4 + head) * 4096;
#pragma unroll
    for (int j = 0; j < 16; ++j) s[j] = s0[(dk0 + j) * 64 + dv];
  } else {
#pragma unroll
    for (int j = 0; j < 16; ++j) s[j] = 0.f;
  }
  f32x16 bn, dn;
  {
    const float* Bc = p.GLA_B + (size_t)ci0 * 4096; const float* dl = p.GLA_DL + (size_t)ci0 * 64;
#pragma unroll
    for (int j = 0; j < 16; ++j) { bn[j] = Bc[(dk0 + j) * 64 + dv]; dn[j] = dl[dk0 + j]; }
  }
  for (int c = 0; c < nch; ++c) {
    const size_t ci = ci0 + c;
    const f32x16 bc = bn, dc = dn;
    {
      const size_t cn = ci0 + (c + 1 < nch ? c + 1 : c);
      const float* Bc = p.GLA_B + cn * 4096; const float* dl = p.GLA_DL + cn * 64;
#pragma unroll
      for (int j = 0; j < 16; ++j) { bn[j] = Bc[(dk0 + j) * 64 + dv]; dn[j] = dl[dk0 + j]; }
    }
    u32x4 w0, w1;
    w0[0] = pack2(s[0], s[1]); w0[1] = pack2(s[2], s[3]); w0[2] = pack2(s[4], s[5]); w0[3] = pack2(s[6], s[7]);
    w1[0] = pack2(s[8], s[9]); w1[1] = pack2(s[10], s[11]); w1[2] = pack2(s[12], s[13]); w1[3] = pack2(s[14], s[15]);
    bf16_t* Sd = p.GLA_S + ci * 4096 + dv * 64 + dk0;
    *(u32x4*)Sd = w0;
    *(u32x4*)(Sd + 8) = w1;
#pragma unroll
    for (int j = 0; j < 16; ++j) s[j] = dc[j] * s[j] + bc[j];
  }
  if (!grp) {
    float* so = p.out + O_ST + ((((size_t)b * 4 + l) * 2 + dir) * 4 + head) * 4096;
#pragma unroll
    for (int j = 0; j < 16; ++j) so[(dk0 + j) * 64 + dv] = s[j];
  }
}

DI void gla_pass_c(const Params& p, int l, int item, unsigned char* smem) {
  float* sa = (float*)smem;
  float* qt = sa + 1024;
  bf16_t* qd = (bf16_t*)(qt + 256);
  bf16_t* ki = qd + 64 * PITCH;
  bf16_t* vT = ki + 64 * PITCH;
  bf16_t* stT = vT + 64 * PITCH;
  float* osum = (float*)(stT + 64 * PITCH);
  const int tid = ltid(), lane = tid & 63, wid = tid >> 6, dk = tid & 63, quarter = tid >> 6, l31 = lane & 31, h = lane >> 5;
  int grp, b, head, c, S, base, nch;
  if (item < 1024) { grp = 1; b = item >> 8; head = (item >> 6) & 3; c = item & 63; S = 4096; base = M_CTX + b * 4096; nch = 64; }
  else { const int it = item - 1024; grp = 0; b = it >> 4; head = (it >> 2) & 3; c = it & 3; S = 256; base = b * 256; nch = 4; }
  const int wd = wid >> 1, wp = wid & 1;
  for (int dir = 0; dir < 2; ++dir) {
    const int cs = dir ? nch - 1 - c : c;
    const int sq = b * 8 + head * 2 + dir;
    const size_t ci = grp ? (size_t)sq * 64 + cs : 2048 + (size_t)sq * 4 + cs;
    const int row0 = dir ? base + S - 1 - 64 * cs : base + 64 * cs, rstep = dir ? -1 : 1;
    f32x16 cum; float last;
    gla_cum(p, l, head, dir, row0, rstep, sa, qt, cum, last);
    unsigned vw[8];
#pragma unroll
    for (int j = 0; j < 8; ++j) {
      float vv[2];
#pragma unroll
      for (int q = 0; q < 2; ++q) {
        const int ii = 2 * j + q, i = quarter * 16 + ii;
        const bf16_t* z = p.Z + (size_t)(row0 + i * rstep) * DIN;
        const float e = __expf(cum[ii]);
        qd[i * PITCH + dk] = f2bf(bf2f(z[ZQG + head * 64 + dk]) * 0.125f * e);
        ki[i * PITCH + dk] = f2bf(bf2f(z[ZKG + head * 64 + dk]) / e);
        vv[q] = bf2f(z[ZVG + head * 64 + dk]);
      }
      vw[j] = pack2(vv[0], vv[1]);
    }
    *(uint4*)(vT + dk * PITCH + quarter * 16) = make_uint4(vw[0], vw[1], vw[2], vw[3]);
    *(uint4*)(vT + dk * PITCH + quarter * 16 + 8) = make_uint4(vw[4], vw[5], vw[6], vw[7]);
    {
      const bf16_t* Sg = p.GLA_S + ci * 4096;
      for (int e = tid; e < 512; e += NT) { const int r = e >> 3, cc = (e & 7) * 8; *(uint4*)(stT + r * PITCH + cc) = *(const uint4*)(Sg + r * 64 + cc); }
    }
    __syncthreads();
    f32x16 acco;
#pragma unroll
    for (int i = 0; i < 16; ++i) acco[i] = 0.f;
#pragma unroll
    for (int ks = 0; ks < 4; ++ks) {
      const bf16x8 a = *(const bf16x8*)(stT + (wd * 32 + l31) * PITCH + ks * 16 + h * 8);
      const bf16x8 bb = *(const bf16x8*)(qd + (wp * 32 + l31) * PITCH + ks * 16 + h * 8);
      acco = MFMA32(a, bb, acco);
    }
    for (int jb = 0; jb <= wp; ++jb) {
      f32x16 att;
#pragma unroll
      for (int i = 0; i < 16; ++i) att[i] = 0.f;
#pragma unroll
      for (int ks = 0; ks < 4; ++ks) {
        const bf16x8 a = *(const bf16x8*)(ki + (jb * 32 + l31) * PITCH + ks * 16 + h * 8);
        const bf16x8 bb = *(const bf16x8*)(qd + (wp * 32 + l31) * PITCH + ks * 16 + h * 8);
        att = MFMA32(a, bb, att);
      }
      const int ipos = wp * 32 + l31;
#pragma unroll
      for (int i = 0; i < 16; ++i) if (jb * 32 + crow(i, h) > ipos) att[i] = 0.f;
#pragma unroll
      for (int s = 0; s < 2; ++s) {
        union { bf16x8 v; unsigned u[4]; } pf;
#pragma unroll
        for (int j = 0; j < 4; ++j) pf.u[j] = pack2(att[8 * s + 2 * j], att[8 * s + 2 * j + 1]);
        union { bf16x8 v; bf16x4 hlf[2]; } vf;
        vf.hlf[0] = *(const bf16x4*)(vT + (wd * 32 + l31) * PITCH + jb * 32 + 16 * s + 4 * h);
        vf.hlf[1] = *(const bf16x4*)(vT + (wd * 32 + l31) * PITCH + jb * 32 + 16 * s + 8 + 4 * h);
        acco = MFMA32(vf.v, pf.v, acco);
      }
    }
    {
      const int i = wp * 32 + l31, tl = dir ? 63 - i : i;
#pragma unroll
      for (int r = 0; r < 16; ++r) {
        float* o = osum + tl * 65 + wd * 32 + crow(r, h);
        if (dir) *o += acco[r]; else *o = acco[r];
      }
    }
  }
  __syncthreads();
  const float g = p.gla_g_out[l * 64 + lane];
  for (int t = wid; t < 64; t += NW) {
    const float v = osum[t * 65 + lane];
    const float rs = rsqrtf(wave_sum(v * v) * (1.f / 64.f) + EPS);
    const int row = base + 64 * c + t;
    const float rg = bf2f(p.Z[(size_t)row * DIN + ZRG + head * 64 + lane]);
    p.MIX[(size_t)row * 1024 + head * 64 + lane] = f2bf(v * rs * g * silu_f(rg));
  }
}

struct AttnJob {
  const bf16_t* Q; int ldq;
  const bf16_t* K1; int ldk1;
  const bf16_t* K2; int ldk2;
  const bf16_t* V; int ldv;
  int ctx_row0, nctx;
  int loc_row0, loc_pos0, nloc;
  int qrow0, qpos0;
  int window;
  float scale; int has_sink; float sink;
  bf16_t* O; int ldo;
};
template <int DQ>
DI void attn_block(const AttnJob& jb, unsigned char* smem) {
  constexpr int NKS = DQ / 16, KP = DQ + 8, NCH = DQ / 8;
  bf16_t* sK = (bf16_t*)smem;
  bf16_t* sVt = sK + 64 * KP;
  const int tid = ltid(), lane = tid & 63, wid = tid >> 6, l31 = lane & 31, h = lane >> 5;
  const int qr = jb.qrow0 + wid * 32 + l31;
  bf16x8 qf[NKS];
#pragma unroll
  for (int ks = 0; ks < NKS; ++ks) qf[ks] = *(const bf16x8*)(jb.Q + (size_t)qr * jb.ldq + ks * 16 + h * 8);
  const int qpos = jb.qpos0 + wid * 32 + l31;
  f32x16 o[2];
#pragma unroll
  for (int d = 0; d < 2; ++d)
#pragma unroll
    for (int i = 0; i < 16; ++i) o[d][i] = 0.f;
  float m = -1e30f, lsum = 0.f;
  const int nt = jb.nctx + jb.nloc;
  const int kc0 = tid, kc1 = tid + NT, kc2 = tid + 2 * NT;
  const int kk0 = kc0 / NCH, kd0 = kc0 % NCH, kk1 = kc1 / NCH, kd1 = kc1 % NCH, kk2 = kc2 / NCH, kd2 = kc2 % NCH;
  const int vk0 = tid & 63, vd0 = tid >> 6, vd1 = (tid + NT) >> 6;
  u32x4 kr0, kr1, kr2 = {0u, 0u, 0u, 0u}, vr0, vr1;
#define ATT_KLD(key, dc, krow) ((dc) < 8 ? *(const u32x4*)(jb.K1 + (size_t)((krow) + (key)) * jb.ldk1 + (dc) * 8) \
                                       : *(const u32x4*)(jb.K2 + (size_t)((krow) + (key)) * jb.ldk2 + ((dc) - 8) * 8))
#define ATT_LOAD(tt) { const int kr_ = (tt) < jb.nctx ? jb.ctx_row0 + 64 * (tt) : jb.loc_row0 + jb.loc_pos0 + 64 * ((tt) - jb.nctx); \
    kr0 = ATT_KLD(kk0, kd0, kr_); kr1 = ATT_KLD(kk1, kd1, kr_); if (NCH > 8) kr2 = ATT_KLD(kk2, kd2, kr_); \
    vr0 = *(const u32x4*)(jb.V + (size_t)(kr_ + vk0) * jb.ldv + vd0 * 8); vr1 = *(const u32x4*)(jb.V + (size_t)(kr_ + vk0) * jb.ldv + vd1 * 8); }
#define ATT_VST(v, dc) { _Pragma("unroll") for (int j = 0; j < 4; ++j) { \
      sVt[((dc) * 8 + 2 * j) * PITCH + vk0] = (bf16_t)((v)[j] & 0xffffu); sVt[((dc) * 8 + 2 * j + 1) * PITCH + vk0] = (bf16_t)((v)[j] >> 16); } }
  ATT_LOAD(0);
  for (int t = 0; t < nt; ++t) {
    int kpos0; bool masked;
    if (t < jb.nctx) { kpos0 = 0; masked = false; }
    else { kpos0 = jb.loc_pos0 + 64 * (t - jb.nctx); masked = jb.window > 0; }
    __syncthreads();
    *(u32x4*)(sK + kk0 * KP + kd0 * 8) = kr0;
    *(u32x4*)(sK + kk1 * KP + kd1 * 8) = kr1;
    if (NCH > 8) *(u32x4*)(sK + kk2 * KP + kd2 * 8) = kr2;
    ATT_VST(vr0, vd0);
    ATT_VST(vr1, vd1);
    __syncthreads();
    { const int tn = t + 1 < nt ? t + 1 : t; ATT_LOAD(tn); }
    f32x16 st[2];
#pragma unroll
    for (int kb = 0; kb < 2; ++kb) {
#pragma unroll
      for (int i = 0; i < 16; ++i) st[kb][i] = 0.f;
#pragma unroll
      for (int ks = 0; ks < NKS; ++ks) {
        const bf16x8 a = *(const bf16x8*)(sK + (kb * 32 + l31) * KP + ks * 16 + h * 8);
        st[kb] = MFMA32(a, qf[ks], st[kb]);
      }
    }
    float mx = -1e30f;
#pragma unroll
    for (int kb = 0; kb < 2; ++kb)
#pragma unroll
      for (int i = 0; i < 16; ++i) {
        float s = st[kb][i] * jb.scale;
        if (masked) {
          const int kp = kpos0 + kb * 32 + crow(i, h);
          const int d = qpos - kp;
          if (d > jb.window || d < -jb.window) s = -1e30f;
        }
        st[kb][i] = s;
        mx = fmaxf(mx, s);
      }
    mx = fmaxf(mx, __shfl_xor(mx, 32));
    const float mn = fmaxf(m, mx);
    const float alpha = __expf(m - mn);
    m = mn;
    float ps = 0.f;
#pragma unroll
    for (int kb = 0; kb < 2; ++kb)
#pragma unroll
      for (int i = 0; i < 16; ++i) { const float pv = __expf(st[kb][i] - mn); st[kb][i] = pv; ps += pv; }
    lsum = lsum * alpha + ps;
#pragma unroll
    for (int d = 0; d < 2; ++d)
#pragma unroll
      for (int i = 0; i < 16; ++i) o[d][i] *= alpha;
#pragma unroll
    for (int kb = 0; kb < 2; ++kb)
#pragma unroll
      for (int s = 0; s < 2; ++s) {
        union { bf16x8 v; unsigned u[4]; } pf;
#pragma unroll
        for (int j = 0; j < 4; ++j) pf.u[j] = pack2(st[kb][8 * s + 2 * j], st[kb][8 * s + 2 * j + 1]);
#pragma unroll
        for (int d = 0; d < 2; ++d) {
          union { bf16x8 v; bf16x4 hlf[2]; } vf;
          vf.hlf[0] = *(const bf16x4*)(sVt + (d * 32 + l31) * PITCH + kb * 32 + 16 * s + 4 * h);
          vf.hlf[1] = *(const bf16x4*)(sVt + (d * 32 + l31) * PITCH + kb * 32 + 16 * s + 8 + 4 * h);
          o[d] = MFMA32(vf.v, pf.v, o[d]);
        }
      }
  }
  lsum += __shfl_xor(lsum, 32);
  float inv;
  if (jb.has_sink) {
    const float mf = fmaxf(m, jb.sink);
    const float corr = __expf(m - mf);
    inv = corr / (lsum * corr + __expf(jb.sink - mf));
  } else inv = 1.f / lsum;
  bf16_t* orow = jb.O + (size_t)qr * jb.ldo;
#pragma unroll
  for (int d = 0; d < 2; ++d)
#pragma unroll
    for (int g = 0; g < 4; ++g) {
      uint2 w;
      w.x = pack2(o[d][4 * g] * inv, o[d][4 * g + 1] * inv);
      w.y = pack2(o[d][4 * g + 2] * inv, o[d][4 * g + 3] * inv);
      *(uint2*)(orow + d * 32 + 8 * g + 4 * h) = w;
    }
}

DI void mla_item(const Params& p, int l, int grp, int it, unsigned char* smem) {
  AttnJob j;
  int b, head, qb;
  if (grp) { b = it >> 7; head = (it >> 5) & 3; qb = it & 31; } else { b = it >> 3; head = (it >> 1) & 3; qb = it & 1; }
  const int base = grp ? M_CTX + b * 4096 : b * 256;
  j.Q = p.QM + head * 96; j.ldq = 384;
  j.K1 = p.KV + head * 128; j.ldk1 = 512; j.K2 = p.KR; j.ldk2 = 32; j.V = p.KV + head * 128 + 64; j.ldv = 512;
  j.ctx_row0 = M_TOT + b * 256; j.nctx = grp ? 4 : 0;
  j.loc_row0 = base; j.loc_pos0 = 0; j.nloc = grp ? 64 : 4;
  j.qrow0 = base + qb * 128; j.qpos0 = qb * 128; j.window = 0;
  j.scale = 0.10206207261596577f; j.has_sink = 0; j.sink = 0.f;
  j.O = p.MIX + 768 + head * 64; j.ldo = 1024;
  attn_block<96>(j, smem);
}
DI void swa_item(const Params& p, int l, int grp, int it, unsigned char* smem) {
  AttnJob j;
  int b, hq, qb;
  if (grp) { b = it >> 7; hq = (it >> 5) & 3; qb = it & 31; } else { b = it >> 3; hq = (it >> 1) & 3; qb = it & 1; }
  const int base = grp ? M_CTX + b * 4096 : b * 256;
  const int g = hq >> 1;
  j.Q = p.QS + hq * 64; j.ldq = 256;
  j.K1 = p.KS + g * 64; j.ldk1 = 128; j.K2 = p.KS; j.ldk2 = 128; j.V = p.VS + g * 64; j.ldv = 128;
  j.ctx_row0 = M_TOT + b * 256; j.nctx = grp ? 4 : 0;
  if (grp) {
    const int lo = qb > 0 ? (qb - 1) * 128 : 0, hi = qb < 31 ? (qb + 2) * 128 : 4096;
    j.loc_pos0 = lo; j.nloc = (hi - lo) >> 6; j.window = 128;
  } else { j.loc_pos0 = 0; j.nloc = 4; j.window = 0; }
  j.loc_row0 = base;
  j.qrow0 = base + qb * 128; j.qpos0 = qb * 128;
  j.scale = 1.0f;
  j.has_sink = 1; j.sink = p.swa_sink[l * 4 + hq];
  j.O = p.MIX + 256 + hq * 64; j.ldo = 1024;
  attn_block<64>(j, smem);
}

DI bool tile_swz(int i, int nN, int T, int& tm, int& tn) {
  const int bid = lbid(), slots = gridDim.x >> 3;
  const int L = (i * 8 + (bid & 7)) * slots + (bid >> 3);
  if (L >= T) return false;
  const int pw = 8 * nN, pnl = L / pw, rem = L - pnl * pw;
  tn = rem >> 3; tm = pnl * 8 + (rem & 7);
  return true;
}
DI void phase_gemm_gu(const Params& p, int i, unsigned char* smem) {
  EpiGateUp epi{p.ACT};
  const bf16_t* W = p.WGU + (size_t)i * 5632 * 1024;
  { int tm, tn; const int nit = (80 * 44 + gridDim.x - 1) / gridDim.x + 8; for (int i = 0; i < nit; ++i) if (tile_swz(i, 44, 80 * 44, tm, tn)) gemm_tile<4>(p.H, 1024, W, 1024, 1024, tm * 256, tn * 128, smem, epi); }
}
DI void phase_gemm_down(const Params& p, int i, unsigned char* smem) {
  EpiF32 epi{p.F, 1024};
  const bf16_t* W = p.WD + (size_t)i * 1024 * DFF;
  { int tm, tn; const int nit = (160 * 8 + gridDim.x - 1) / gridDim.x + 8; for (int i = 0; i < nit; ++i) if (tile_swz(i, 8, 160 * 8, tm, tn)) gemm_tile<2>(p.ACT, DFF, W, DFF, DFF, tm * 128, tn * 128, smem, epi); }
}
DI void phase_gemm_win(const Params& p, int l, unsigned char* smem) {
  EpiWin epi{p.Z, p.out, l};
  { int tm, tn; const int nit = (80 * 18 + gridDim.x - 1) / gridDim.x + 8; for (int i = 0; i < nit; ++i) if (tile_swz(i, 18, 80 * 18, tm, tn)) gemm_tile<4>(p.H, 1024, p.WIN, 1024, 1024, tm * 256, tn * 128, smem, epi); }
}
DI void phase_gemm_wout(const Params& p, unsigned char* smem) {
  EpiF32 epi{p.F, 1024};
  { int tm, tn; const int nit = (160 * 8 + gridDim.x - 1) / gridDim.x + 8; for (int i = 0; i < nit; ++i) if (tile_swz(i, 8, 160 * 8, tm, tn)) gemm_tile<2>(p.MIX, 1024, p.WOUT, 1024, 1024, tm * 128, tn * 128, smem, epi); }
}
DI void phase_prep(const Params& p, int l, unsigned char* smem) {
  for (int t = lbid(); t < 672 + 2560; t += gridDim.x) {
    if (t < 672) prep_item(p, l, t, smem); else gla_pass_a(p, l, t - 672, smem);
  }
}
DI void phase_qkv(const Params& p, int l, unsigned char* smem) {
  EpiQm eq{p.QM, p.ROPE_M};
  EpiBf16 ekv{p.KV, 512, 1.f, 512};
  for (int t = lbid(); t < 160 + 480 + 672; t += gridDim.x) {
    if (t < 160) gla_pass_b(p, l, t);
    else if (t < 640) { const int u = t - 160, tm = u / 3, tn = u % 3; gemm_tile<2>(p.QLAT, 256, p.WQB, 256, 256, tm * 128, tn * 128, smem, eq); }
    else { const int u = t - 640, tm = u >> 2, tn = u & 3; gemm_tile<2>(p.CKV, 128, p.WKVB, 128, 128, tm * 128, tn * 128, smem, ekv); }
  }
}
DI void phase_mixers(const Params& p, int l, unsigned char* smem, unsigned* ctr) {
  volatile int* s_item = (volatile int*)(smem + SMEM_BYTES - 16);
  for (;;) {
    __syncthreads();
    if (ltid() == 0) *s_item = (int)atomicAdd(ctr, 1u);
    __syncthreads();
    const int t = *s_item;
    if (t >= 2880) break;
    if (t < 256) {
      const int u = t, tm = (u & 7) + 8 * (u >> 6), rest = (u >> 3) & 7, b = rest >> 1, tn = rest & 1;
      EpiBf16 e{p.MIX + (size_t)(M_CTX + b * 4096) * 1024 + 512, 1024, 1.f / 512.f, 256};
      gemm_tile<2>(p.TWL, 8192, p.ABTL + (size_t)b * 256 * 8192, 8192, 8192, tm * 128, tn * 128, smem, e);
    } else if (t < 768) mla_item(p, l, 1, t - 256, smem);
    else if (t < 1280) swa_item(p, l, 1, t - 768, smem);
    else if (t < 2304) gla_pass_c(p, l, t - 1280, smem);
    else if (t < 2432) mla_item(p, l, 0, t - 2304, smem);
    else if (t < 2560) swa_item(p, l, 0, t - 2432, smem);
    else if (t < 2624) {
      const int u = t - 2560, b = u >> 2, tm = (u >> 1) & 1, tn = u & 1;
      EpiBf16 e{p.MIX + (size_t)(b * 256) * 1024 + 512, 1024, 1.f / 128.f, 256};
      gemm_tile<2>(p.TWC, 512, p.ABTC + (size_t)b * 256 * 512, 512, 512, tm * 128, tn * 128, smem, e);
    } else gla_pass_c(p, l, 1024 + (t - 2624), smem);
  }
}

#ifndef PROBE_DBL
#define PROBE_DBL 0
#endif
#define DBL(bit) (((PROBE_DBL) >> (bit)) & 1)
#ifndef ONLY_J
#define ONLY_J -1
#endif
#define EN(x) (ONLY_J < 0 || ONLY_J == (x))
constexpr int N_PHASES = 50;
#define MKP const PArg* kq = kp; asm volatile("" : "+s"(kq)); const Params p = make_params(*kq)
DI void run_phase(const PArg* kp, int ph, unsigned char* smem) {
  if (ph == 0) { if (EN(100)) { MKP; phase_init(p, smem); } return; }
  if (ph == 49) {
    MKP;
    EwArgs a{p.X, p.X + (size_t)M_CTX * DM, p.out + O_YP, p.out + O_YS, p.F, 3, 8, 5, 0.5f, 0, 0, 0, 0, 0};
    if (EN(101)) phase_ew(p, a);
    return;
  }
  const int l = (ph - 1) / 12, j = (ph - 1) % 12;
  switch (j) {
    case 0: if (EN(0)) {
      MKP; float* Xl = p.X + (size_t)M_CTX * DM;
      convert_layer(p, l, smem);
      if (l == 0) { EwArgs a{p.x_prompt, p.x_sample, p.X, Xl, nullptr, 0, 0, 0, 0.f, 1, 0, 1, 0, 0}; phase_ew(p, a); }
      else { EwArgs a{p.X, Xl, p.X, Xl, p.F, l - 1, 8, 5, 0.5f, 1, l, 1, 0, 0}; phase_ew(p, a); }
    } break;
    case 1: if (EN(1)) { MKP; phase_gemm_gu(p, 0, smem); if (DBL(0)) { phase_gemm_gu(p, 0, smem); } } break;
    case 2: if (EN(2)) { MKP; phase_gemm_down(p, 0, smem); if (DBL(0)) { phase_gemm_down(p, 0, smem); } } break;
    case 3: if (EN(3)) {
      MKP; float* Xl = p.X + (size_t)M_CTX * DM;
      if (l == 0) { EwArgs a{p.x_prompt, p.x_sample, p.X, Xl, p.F, l, 2, 1, 0.5f, 1, l, 4, 3, 2}; phase_ew(p, a); }
      else { EwArgs a{p.X, Xl, p.X, Xl, p.F, l, 2, 1, 0.5f, 1, l, 4, 3, 2}; phase_ew(p, a); }
    } break;
    case 4: if (EN(4)) { MKP; phase_gemm_win(p, l, smem); if (DBL(0)) { phase_gemm_win(p, l, smem); } } break;
    case 5: if (EN(5)) { MKP; phase_prep(p, l, smem); if (DBL(2)) { phase_prep(p, l, smem); } } break;
    case 6: if (EN(6)) { MKP; phase_qkv(p, l, smem); if (DBL(3)) { phase_qkv(p, l, smem); } } break;
    case 7: if (EN(7)) { MKP; phase_mixers(p, l, smem, (unsigned*)(GAS unsigned*)(((const PArgG*)kq)->ws + OFF_BAR) + 3600 + l); } break;
    case 8: if (EN(8)) { MKP; phase_gemm_wout(p, smem); if (DBL(0)) { phase_gemm_wout(p, smem); } } break;
    case 9: if (EN(9)) { MKP; float* Xl = p.X + (size_t)M_CTX * DM; EwArgs a{p.X, Xl, p.X, Xl, p.F, l, 5, 3, 1.0f, 1, l, 7, 6, 4}; phase_ew(p, a); } break;
    case 10: if (EN(10)) { MKP; phase_gemm_gu(p, 1, smem); if (DBL(0)) { phase_gemm_gu(p, 1, smem); } } break;
    case 11: if (EN(11)) { MKP; phase_gemm_down(p, 1, smem); if (DBL(0)) { phase_gemm_down(p, 1, smem); } } break;
  }
}

__global__ void __launch_bounds__(NT, 2) fwd_kernel(PArg pa, int ph_lo, int ph_hi) {
  __shared__ __attribute__((aligned(16))) unsigned char smem[SMEM_BYTES];
  const PArg* kp = (const PArg*)__builtin_amdgcn_kernarg_segment_ptr();
#if MULTI_LAUNCH
  for (int ph = ph_lo; ph < ph_hi; ++ph) run_phase(kp, ph, smem);
#else
  cg::grid_group grid = cg::this_grid();
  __shared__ uint4 xb_words;
  if (threadIdx.x == 0) xb_words = make_uint4(0u, 0u, 0u, 0u);
  __syncthreads();
  const XcdBarrier xb = xcd_barrier_post((unsigned*)(pa.ws + OFF_BAR), (volatile LAS unsigned*)&xb_words);
  for (int ph = ph_lo; ph < ph_hi; ++ph) {
    run_phase(kp, ph, smem);
    if (ph + 1 < ph_hi) { if (ph == ph_lo) grid.sync(); else xcd_barrier(xb); }
  }
#endif
}

extern "C" void kernel_launch(void* const* d_in, const int* in_sizes, int n_in, void* d_out, int out_size, void* d_ws, size_t ws_size,
                              hipStream_t stream) {
  PArg p{};
  for (int i = 0; i < 25; ++i) p.in[i] = (const float*)d_in[i];
  p.out = (float*)d_out;
  p.ws = (unsigned char*)d_ws;
  if (WS_NEED > ws_size) { fprintf(stderr, "workspace too small: need %zu have %zu\n", (size_t)WS_NEED, ws_size); return; }
#if MULTI_LAUNCH
  for (int ph = 0; ph < N_PHASES; ++ph) hipLaunchKernelGGL(fwd_kernel, dim3(512), dim3(NT), 0, stream, p, ph, ph + 1);
#else
  static int grid_blocks = 0;
  if (!grid_blocks) {
    int dev = 0, cus = 0, per_cu = 0;
    hipGetDevice(&dev);
    hipDeviceGetAttribute(&cus, hipDeviceAttributeMultiprocessorCount, dev);
    hipOccupancyMaxActiveBlocksPerMultiprocessor(&per_cu, fwd_kernel, NT, 0);
    if (per_cu > 2) per_cu = 2;
    grid_blocks = cus * per_cu;
  }
  hipMemsetAsync((unsigned char*)d_ws + OFF_BAR, 0, 16384, stream);
  int lo = 0, hi = N_PHASES;
  void* args[] = {&p, &lo, &hi};
  hipError_t e = hipLaunchCooperativeKernel((void*)fwd_kernel, dim3(grid_blocks), dim3(NT), args, 0, stream);
  if (e != hipSuccess) fprintf(stderr, "cooperative launch failed: %s (grid %d)\n", hipGetErrorString(e), grid_blocks);
#endif
}
```

```cpp
#include <hip/hip_runtime.h>
#include <hip/hip_cooperative_groups.h>
#include <cstdio>
#include <cstdint>
namespace cg = cooperative_groups;

#ifndef PROBE_SPIN
#define PROBE_SPIN 0
#endif
#ifndef MULTI_LAUNCH
#define MULTI_LAUNCH 0
#endif

#define DI __device__ __forceinline__
typedef unsigned short bf16_t;
typedef short bf16x8 __attribute__((ext_vector_type(8)));
typedef short bf16x4 __attribute__((ext_vector_type(4)));
typedef float f32x16 __attribute__((ext_vector_type(16)));
typedef unsigned u32x4 __attribute__((ext_vector_type(4)));
typedef unsigned u32x2 __attribute__((ext_vector_type(2)));
#define MFMA32(a, b, c) __builtin_amdgcn_mfma_f32_32x32x16_bf16((a), (b), (c), 0, 0, 0)

constexpr int NT = 512, NW = NT / 64, VT = 256, VW = 4;
constexpr int HALF_BYTES = 61440, S_ITEM_OFF = 131072, LDS_TOTAL = 131072 + 64;
constexpr int DM = 1024, M_CTX = 4096, M_LAT = 16384, M_TOT = 20480, M_EXT = 21504;
constexpr int DFF = 2816, DIN = 2240;
constexpr float EPS = 1e-6f;
constexpr int SMEM_BYTES = 60 * 1024;
constexpr int PITCH = 72;
constexpr int ZQG = 0, ZKG = 256, ZVG = 512, ZRG = 768, ZAF = 1024, ZQS = 1056, ZKS = 1312, ZVS = 1440, ZF = 1568, ZQA = 1824, ZKVA = 2080, ZKR = 2208;
constexpr size_t O_YP = 0, O_YS = 4194304, O_ST = 20971520, O_SK = 23068672, O_SV = 25165824, O_CKV = 27262976, O_KR = 29360128;

struct Params {
  const float *x_prompt, *x_sample, *c, *state_gla, *cache_swa_k, *cache_swa_v, *cache_mla_ckv, *cache_mla_krope, *c_ctx,
      *w_mod, *b_mod, *g_norm, *w_gate, *w_up, *w_down, *w_in, *gla_w_gate, *gla_b_gate, *gla_g_out, *swa_sink, *mla_g_q,
      *mla_g_kv, *w_qb, *w_kvb, *w_out;
  float* out;
  float *X, *F, *MOD, *ROPE_S, *ROPE_M, *GLA_B, *GLA_DL;
  bf16_t *H, *TWL, *TWC, *WGU, *WD, *WIN, *WOUT, *WQB, *WKVB, *ACT, *Z, *QS, *KS, *VS, *CKV, *QLAT, *KR, *QM, *KV, *ABTL,
      *ABTC, *GLA_S, *MIX, *DFTW, *ABTF;
};

constexpr size_t al256(size_t x) { return (x + 255) & ~(size_t)255; }
constexpr size_t OFF_X = 0;
constexpr size_t OFF_H = OFF_X + al256((size_t)M_TOT * DM * 4);
constexpr size_t OFF_MOD = OFF_H + al256((size_t)M_TOT * DM * 2);
constexpr size_t OFF_ROPE_S = OFF_MOD + al256((size_t)4 * 5 * 9216 * 4);
constexpr size_t OFF_ROPE_M = OFF_ROPE_S + al256(64 * 16 * 2 * 4);
constexpr size_t OFF_TWL = OFF_ROPE_M + al256(64 * 8 * 2 * 4);
constexpr size_t OFF_TWC = OFF_TWL + al256((size_t)4096 * 8192 * 2);
constexpr size_t OFF_WGU = OFF_TWC + al256((size_t)256 * 512 * 2);
constexpr size_t OFF_WD = OFF_WGU + al256((size_t)2 * 5632 * 1024 * 2);
constexpr size_t OFF_WIN = OFF_WD + al256((size_t)2 * 1024 * DFF * 2);
constexpr size_t OFF_WOUT = OFF_WIN + al256((size_t)2304 * 1024 * 2);
constexpr size_t OFF_WQB = OFF_WOUT + al256((size_t)1024 * 1024 * 2);
constexpr size_t OFF_WKVB = OFF_WQB + al256((size_t)384 * 256 * 2);
constexpr size_t OFF_Z = OFF_WKVB + al256((size_t)512 * 128 * 2);
constexpr size_t OFF_QS = OFF_Z + al256((size_t)M_TOT * DIN * 2);
constexpr size_t OFF_KS = OFF_QS + al256((size_t)M_TOT * 256 * 2);
constexpr size_t OFF_VS = OFF_KS + al256((size_t)M_EXT * 128 * 2);
constexpr size_t OFF_CKV = OFF_VS + al256((size_t)M_EXT * 128 * 2);
constexpr size_t OFF_QLAT = OFF_CKV + al256((size_t)M_EXT * 128 * 2);
constexpr size_t OFF_KR = OFF_QLAT + al256((size_t)M_TOT * 256 * 2);
constexpr size_t OFF_QM = OFF_KR + al256((size_t)M_EXT * 32 * 2);
constexpr size_t OFF_KV = OFF_QM + al256((size_t)M_TOT * 384 * 2);
constexpr size_t OFF_ABTL = OFF_KV + al256((size_t)M_EXT * 512 * 2);
constexpr size_t OFF_ABTC = OFF_ABTL + al256((size_t)4 * 256 * 8192 * 2);
constexpr size_t OFF_GLA_B = OFF_ABTC + al256((size_t)16 * 256 * 512 * 2);
constexpr size_t OFF_GLA_DL = OFF_GLA_B + al256((size_t)2560 * 4096 * 4);
constexpr size_t OFF_GLA_S = OFF_GLA_DL + al256((size_t)2560 * 64 * 4);
constexpr size_t OFF_MIX = OFF_GLA_S + al256((size_t)2560 * 4096 * 2);
constexpr size_t OFF_BAR = OFF_MIX + al256((size_t)M_TOT * 1024 * 2);
constexpr size_t OFF_DFTW = OFF_BAR + al256(16384);
constexpr size_t OFF_ABTF = OFF_DFTW + al256(128 * 64 * 2);
constexpr size_t OFF_END0 = OFF_ABTF + al256((size_t)4 * 256 * 4096 * 2);
constexpr size_t OFF_ACTEND = OFF_QS + al256((size_t)M_TOT * DFF * 2);
constexpr size_t WS_NEED = OFF_END0 > OFF_ACTEND ? OFF_END0 : OFF_ACTEND;
struct PArg { const float* in[25]; float* out; unsigned char* ws; };
#define GAS __attribute__((address_space(1)))
struct PArgG { GAS const float* in[25]; GAS float* out; GAS unsigned char* ws; };
typedef const __attribute__((address_space(4))) PArgG* KP4;
DI Params make_params(KP4 ap) {
  Params p;
  p.x_prompt = (const float*)ap->in[0];
  p.x_sample = (const float*)ap->in[1];
  p.c = (const float*)ap->in[2];
  p.state_gla = (const float*)ap->in[3];
  p.cache_swa_k = (const float*)ap->in[4];
  p.cache_swa_v = (const float*)ap->in[5];
  p.cache_mla_ckv = (const float*)ap->in[6];
  p.cache_mla_krope = (const float*)ap->in[7];
  p.c_ctx = (const float*)ap->in[8];
  p.w_mod = (const float*)ap->in[9];
  p.b_mod = (const float*)ap->in[10];
  p.g_norm = (const float*)ap->in[11];
  p.w_gate = (const float*)ap->in[12];
  p.w_up = (const float*)ap->in[13];
  p.w_down = (const float*)ap->in[14];
  p.w_in = (const float*)ap->in[15];
  p.gla_w_gate = (const float*)ap->in[16];
  p.gla_b_gate = (const float*)ap->in[17];
  p.gla_g_out = (const float*)ap->in[18];
  p.swa_sink = (const float*)ap->in[19];
  p.mla_g_q = (const float*)ap->in[20];
  p.mla_g_kv = (const float*)ap->in[21];
  p.w_qb = (const float*)ap->in[22];
  p.w_kvb = (const float*)ap->in[23];
  p.w_out = (const float*)ap->in[24];
  p.out = (float*)ap->out;
  p.X = (float*)(GAS float*)(ap->ws + OFF_X);
  p.H = (bf16_t*)(GAS bf16_t*)(ap->ws + OFF_H);
  p.MOD = (float*)(GAS float*)(ap->ws + OFF_MOD);
  p.ROPE_S = (float*)(GAS float*)(ap->ws + OFF_ROPE_S);
  p.ROPE_M = (float*)(GAS float*)(ap->ws + OFF_ROPE_M);
  p.TWL = (bf16_t*)(GAS bf16_t*)(ap->ws + OFF_TWL);
  p.TWC = (bf16_t*)(GAS bf16_t*)(ap->ws + OFF_TWC);
  p.WGU = (bf16_t*)(GAS bf16_t*)(ap->ws + OFF_WGU);
  p.WD = (bf16_t*)(GAS bf16_t*)(ap->ws + OFF_WD);
  p.WIN = (bf16_t*)(GAS bf16_t*)(ap->ws + OFF_WIN);
  p.WOUT = (bf16_t*)(GAS bf16_t*)(ap->ws + OFF_WOUT);
  p.WQB = (bf16_t*)(GAS bf16_t*)(ap->ws + OFF_WQB);
  p.WKVB = (bf16_t*)(GAS bf16_t*)(ap->ws + OFF_WKVB);
  p.Z = (bf16_t*)(GAS bf16_t*)(ap->ws + OFF_Z);
  p.QS = (bf16_t*)(GAS bf16_t*)(ap->ws + OFF_QS);
  p.KS = (bf16_t*)(GAS bf16_t*)(ap->ws + OFF_KS);
  p.VS = (bf16_t*)(GAS bf16_t*)(ap->ws + OFF_VS);
  p.CKV = (bf16_t*)(GAS bf16_t*)(ap->ws + OFF_CKV);
  p.QLAT = (bf16_t*)(GAS bf16_t*)(ap->ws + OFF_QLAT);
  p.KR = (bf16_t*)(GAS bf16_t*)(ap->ws + OFF_KR);
  p.QM = (bf16_t*)(GAS bf16_t*)(ap->ws + OFF_QM);
  p.KV = (bf16_t*)(GAS bf16_t*)(ap->ws + OFF_KV);
  p.ABTL = (bf16_t*)(GAS bf16_t*)(ap->ws + OFF_ABTL);
  p.ABTC = (bf16_t*)(GAS bf16_t*)(ap->ws + OFF_ABTC);
  p.GLA_B = (float*)(GAS float*)(ap->ws + OFF_GLA_B);
  p.GLA_DL = (float*)(GAS float*)(ap->ws + OFF_GLA_DL);
  p.GLA_S = (bf16_t*)(GAS bf16_t*)(ap->ws + OFF_GLA_S);
  p.MIX = (bf16_t*)(GAS bf16_t*)(ap->ws + OFF_MIX);
  p.DFTW = (bf16_t*)(GAS bf16_t*)(ap->ws + OFF_DFTW);
  p.ABTF = (bf16_t*)(GAS bf16_t*)(ap->ws + OFF_ABTF);
  p.F = (float*)(GAS float*)(ap->ws + OFF_Z);
  p.ACT = (bf16_t*)(GAS bf16_t*)(ap->ws + OFF_QS);
  return p;
}

DI int ltid() { int t = __builtin_amdgcn_workitem_id_x(); asm volatile("" : "+v"(t)); return t; }
DI int vtid() { return ltid() & 255; }
DI int vhalf() { return ltid() >> 8; }
DI int lbid() { int t = __builtin_amdgcn_workgroup_id_x(); asm volatile("" : "+s"(t)); return t; }
typedef float f32x2_t __attribute__((ext_vector_type(2)));
typedef __bf16 bf16x2_t __attribute__((ext_vector_type(2)));
DI bf16_t f2bf(float x) { return __builtin_bit_cast(bf16_t, (__bf16)x); }
DI float bf2f(bf16_t b) { return __uint_as_float(((unsigned)b) << 16); }
DI unsigned pack2(float a, float b) { f32x2_t v = {a, b}; return __builtin_bit_cast(unsigned, __builtin_convertvector(v, bf16x2_t)); }
DI float shx(float v, int o) { const int ln = ltid() & 63; return __int_as_float(__builtin_amdgcn_ds_bpermute((ln ^ o) << 2, __float_as_int(v))); }
DI float wave_sum(float v) {
#pragma unroll
  for (int o = 32; o > 0; o >>= 1) v += shx(v, o);
  return v;
}
DI float silu_f(float x) { return x * __builtin_amdgcn_rcpf(1.f + __builtin_amdgcn_exp2f(-1.4426950408889634f * x)); }
DI int crow(int r, int h) { return (r & 3) + 8 * (r >> 2) + 4 * h; }


#define XB_TMO      128
#define XB_XCNT(j)  (256  + 64 * (j))
#define XB_XSUB(j)  (1280 + 64 * (j))
#define XB_XGEN(j)  (2304 + 64 * (j))
#define XB_TOP      3328
#define XB_TOPGEN   3392
#define XCD_BAR_WORDS 3456
#define XB_SPIN_CAP (1u << 22)
#define LAS __attribute__((address_space(3)))
DI unsigned xb_ld(unsigned* p) { return __hip_atomic_load(p, __ATOMIC_RELAXED, __HIP_MEMORY_SCOPE_AGENT); }
DI unsigned xb_add(unsigned* p, unsigned v) { return __hip_atomic_fetch_add(p, v, __ATOMIC_RELAXED, __HIP_MEMORY_SCOPE_AGENT); }
DI unsigned xb_xcc_id() { return (unsigned)__builtin_amdgcn_s_getreg((3 << 11) | 20) & 0xFu; }
#define XB_SPIN(cond, bar) do { unsigned _sp = 0; while (cond) { __builtin_amdgcn_s_sleep(1); \
    if ((++_sp & 255u) == 0u) { if (xb_ld(&(bar)[XB_TMO])) break; if (_sp > XB_SPIN_CAP) { atomicAdd(&(bar)[XB_TMO], 1u); break; } } } } while (0)
struct XcdBarrier { unsigned* bar; unsigned x; volatile LAS unsigned* st; };
DI XcdBarrier xcd_barrier_post(unsigned* bar, volatile LAS unsigned* st) {
  XcdBarrier b; b.bar = bar; b.x = xb_xcc_id(); b.st = st;
  if (ltid() == 0) (void)xb_add(&bar[XB_XCNT(b.x)], 1u);
  return b;
}
DI void xcd_barrier_complete(unsigned* bar, unsigned x, unsigned& nloc, unsigned& nx) {
  const unsigned G = gridDim.x * gridDim.y * gridDim.z;
  unsigned sum, cnt, mine, sp = 0u;
  for (;;) {
    sum = 0u; cnt = 0u; mine = 0u;
#pragma unroll
    for (unsigned j = 0; j < 16; ++j) { const unsigned c = xb_ld(&bar[XB_XCNT(j)]); sum += c; cnt += (c > 0u) ? 1u : 0u; mine = (j == x) ? c : mine; }
    if (sum == G) break;
    __builtin_amdgcn_s_sleep(1);
    if ((++sp & 255u) == 0u) { if (xb_ld(&bar[XB_TMO])) break; if (sp > XB_SPIN_CAP) { atomicAdd(&bar[XB_TMO], 1u); break; } }
  }
  nloc = mine > 0u ? mine : 1u; nx = cnt > 0u ? cnt : 1u;
}
DI void xcd_barrier(const XcdBarrier& b) {
  asm volatile("s_waitcnt vmcnt(0)" ::: "memory");
  __syncthreads();
  if (ltid() == 0) {
    unsigned* bar = b.bar;
    __builtin_amdgcn_s_waitcnt(0);
    unsigned nloc = b.st[0], nx = b.st[1];
    if (nloc == 0u) { xcd_barrier_complete(bar, b.x, nloc, nx); b.st[0] = nloc; b.st[1] = nx; }
    const unsigned old = xb_add(&bar[XB_XSUB(b.x)], 1u);
    const unsigned gen = old / nloc;
    if (old + 1u == (gen + 1u) * nloc) {
      __builtin_amdgcn_fence(__ATOMIC_RELEASE, "agent");
      asm volatile("s_waitcnt vmcnt(0)" ::: "memory");
      const unsigned og = xb_add(&bar[XB_TOP], 1u);
      const unsigned tg = og / nx;
      if (og + 1u == (tg + 1u) * nx) xb_add(&bar[XB_TOPGEN], 1u);
      else XB_SPIN(xb_ld(&bar[XB_TOPGEN]) == tg, bar);
      __builtin_amdgcn_fence(__ATOMIC_ACQUIRE, "agent");
      xb_add(&bar[XB_XGEN(b.x)], 1u);
      asm volatile("s_waitcnt vmcnt(0)" ::: "memory");
    } else {
      XB_SPIN(xb_ld(&bar[XB_XGEN(b.x)]) == gen, bar);
      __builtin_amdgcn_fence(__ATOMIC_ACQUIRE, "agent");
      asm volatile("s_waitcnt vmcnt(0)" ::: "memory");
    }
  }
  __syncthreads();
}

template <int MB, class Epi>
DI void gemm_tile(const bf16_t* __restrict__ A, int lda, const bf16_t* __restrict__ Bt, int ldb, int K, int m0, int n0,
                  unsigned char* smem, const Epi& epi) {
  constexpr int BMR = 128 * MB, NA = 2 * MB;
  bf16_t* sA = (bf16_t*)smem;
  bf16_t* sB = sA + BMR * PITCH;
  const int tid = ltid(), lane = tid & 63, wid = tid >> 6, wm = wid >> 1, wn = wid & 1, l31 = lane & 31, h = lane >> 5;
  f32x16 acc[2][MB];
#pragma unroll
  for (int a = 0; a < 2; ++a)
#pragma unroll
    for (int b = 0; b < MB; ++b)
#pragma unroll
      for (int i = 0; i < 16; ++i) acc[a][b][i] = 0.f;
  const int lrow = tid >> 3, lkc = tid & 7;
  const bf16_t* Ap = A + (size_t)(m0 + lrow) * lda + lkc * 8;
  const bf16_t* Bp = Bt + (size_t)(n0 + lrow) * ldb + lkc * 8;
  const size_t sa32 = (size_t)64 * lda, sb32 = (size_t)64 * ldb;
  bf16_t* wA = sA + lrow * PITCH + lkc * 8;
  bf16_t* wB = sB + lrow * PITCH + lkc * 8;
  u32x4 ra[NA], rb[2];
#pragma unroll
  for (int i = 0; i < NA; ++i) ra[i] = *(const u32x4*)(Ap + i * sa32);
#pragma unroll
  for (int i = 0; i < 2; ++i) rb[i] = *(const u32x4*)(Bp + i * sb32);
  for (int k0 = 0; k0 < K; k0 += 64) {
    __syncthreads();
#pragma unroll
    for (int i = 0; i < NA; ++i) *(u32x4*)(wA + i * 64 * PITCH) = ra[i];
#pragma unroll
    for (int i = 0; i < 2; ++i) *(u32x4*)(wB + i * 64 * PITCH) = rb[i];
    __syncthreads();
    {
      const int kn = (k0 + 64 < K) ? k0 + 64 : k0;
#pragma unroll
      for (int i = 0; i < NA; ++i) ra[i] = *(const u32x4*)(Ap + kn + i * sa32);
#pragma unroll
      for (int i = 0; i < 2; ++i) rb[i] = *(const u32x4*)(Bp + kn + i * sb32);
    }
#pragma unroll
    for (int ks = 0; ks < 4; ++ks) {
      bf16x8 af[MB], bfr[2];
#pragma unroll
      for (int b = 0; b < MB; ++b) af[b] = *(const bf16x8*)(sA + (wm * 32 * MB + b * 32 + l31) * PITCH + ks * 16 + h * 8);
#pragma unroll
      for (int b = 0; b < 2; ++b) bfr[b] = *(const bf16x8*)(sB + (wn * 64 + b * 32 + l31) * PITCH + ks * 16 + h * 8);

#pragma unroll
      for (int nb = 0; nb < 2; ++nb)
#pragma unroll
        for (int mb = 0; mb < MB; ++mb) acc[nb][mb] = MFMA32(bfr[nb], af[mb], acc[nb][mb]);

    }
  }
  epi(acc, m0 + wm * 32 * MB, n0 + wn * 64, l31, h);
}

struct EpiF32 {
  float* C; int ldc;
  template <int MB> DI void operator()(const f32x16 (&acc)[2][MB], int mb0, int nb0, int l31, int h) const {
#pragma unroll
    for (int nb = 0; nb < 2; ++nb)
#pragma unroll
      for (int mb = 0; mb < MB; ++mb) {
        float* row = C + (size_t)(mb0 + mb * 32 + l31) * ldc + nb0 + nb * 32 + 4 * h;
#pragma unroll
        for (int g = 0; g < 4; ++g)
          *(float4*)(row + 8 * g) = make_float4(acc[nb][mb][4 * g], acc[nb][mb][4 * g + 1], acc[nb][mb][4 * g + 2], acc[nb][mb][4 * g + 3]);
      }
  }
};
struct EpiBf16 {
  bf16_t* C; int ldc; float scale; int ncols;
  template <int MB> DI void operator()(const f32x16 (&acc)[2][MB], int mb0, int nb0, int l31, int h) const {
#pragma unroll
    for (int nb = 0; nb < 2; ++nb)
#pragma unroll
      for (int mb = 0; mb < MB; ++mb) {
        const int col0 = nb0 + nb * 32 + 4 * h;
        bf16_t* row = C + (size_t)(mb0 + mb * 32 + l31) * ldc + col0;
#pragma unroll
        for (int g = 0; g < 4; ++g) {
          if (col0 + 8 * g < ncols) {
            uint2 w;
            w.x = pack2(acc[nb][mb][4 * g] * scale, acc[nb][mb][4 * g + 1] * scale);
            w.y = pack2(acc[nb][mb][4 * g + 2] * scale, acc[nb][mb][4 * g + 3] * scale);
            *(uint2*)(row + 8 * g) = w;
          }
        }
      }
  }
};
struct EpiGateUp {
  bf16_t* C;
  template <int MB> DI void operator()(const f32x16 (&acc)[2][MB], int mb0, int nb0, int l31, int h) const {
#pragma unroll
    for (int mb = 0; mb < MB; ++mb) {
      bf16_t* row = C + (size_t)(mb0 + mb * 32 + l31) * DFF + (nb0 >> 1) + 4 * h;
#pragma unroll
      for (int g = 0; g < 4; ++g) {
        float v[4];
#pragma unroll
        for (int i = 0; i < 4; ++i) v[i] = silu_f(acc[0][mb][4 * g + i]) * acc[1][mb][4 * g + i];
        uint2 w; w.x = pack2(v[0], v[1]); w.y = pack2(v[2], v[3]);
        *(uint2*)(row + 8 * g) = w;
      }
    }
  }
};
struct EpiWin {
  bf16_t* Z; float* out; int l;
  template <int MB> DI void operator()(const f32x16 (&acc)[2][MB], int mb0, int nb0, int l31, int h) const {
#pragma unroll
    for (int nb = 0; nb < 2; ++nb)
#pragma unroll
      for (int mb = 0; mb < MB; ++mb) {
        const int m = mb0 + mb * 32 + l31;
        const int col0 = nb0 + nb * 32 + 4 * h;
        bf16_t* row = Z + (size_t)m * DIN + col0;
#pragma unroll
        for (int g = 0; g < 4; ++g) {
          const int col = col0 + 8 * g;
          if (col < DIN) {
            uint2 w;
            w.x = pack2(acc[nb][mb][4 * g], acc[nb][mb][4 * g + 1]);
            w.y = pack2(acc[nb][mb][4 * g + 2], acc[nb][mb][4 * g + 3]);
            *(uint2*)(row + 8 * g) = w;
            if (m < M_CTX) {
              const int b = m >> 8, s = m & 255;
              const size_t tok = (size_t)((b * 4 + l) * 256 + s);
              float* dst = nullptr;
              if (col >= ZKS && col < ZVS) dst = out + O_SK + tok * 128 + (col - ZKS);
              else if (col >= ZVS && col < ZF) dst = out + O_SV + tok * 128 + (col - ZVS);
              else if (col >= ZKR) dst = out + O_KR + tok * 32 + (col - ZKR);
              if (dst) *(float4*)dst = make_float4(acc[nb][mb][4 * g], acc[nb][mb][4 * g + 1], acc[nb][mb][4 * g + 2], acc[nb][mb][4 * g + 3]);
            }
          }
        }
      }
  }
};
struct EpiQm {
  bf16_t* C; const float* rope_m;
  template <int MB> DI void operator()(const f32x16 (&acc)[2][MB], int mb0, int nb0, int l31, int h) const {
#pragma unroll
    for (int nb = 0; nb < 2; ++nb) {
      const int cb = nb0 + nb * 32;
      const bool isrope = ((cb >> 5) % 3) == 2;
#pragma unroll
      for (int mb = 0; mb < MB; ++mb) {
        const int m = mb0 + mb * 32 + l31;
        float v[16];
#pragma unroll
        for (int i = 0; i < 16; ++i) v[i] = acc[nb][mb][i];
        if (isrope && m >= M_CTX) {
          const int t = (m - M_CTX) & 4095;
          const int prow = t >> 6, pcol = t & 63;
#pragma unroll
          for (int half = 0; half < 2; ++half) {
            const int pos = half ? pcol : prow;
#pragma unroll
            for (int i = 0; i < 4; ++i) {
              const int j = 4 * h + i;
              const float cs = rope_m[(pos * 8 + j) * 2], sn = rope_m[(pos * 8 + j) * 2 + 1];
              const float x1 = v[8 * half + i], x2 = v[8 * half + 4 + i];
              v[8 * half + i] = x1 * cs - x2 * sn;
              v[8 * half + 4 + i] = x2 * cs + x1 * sn;
            }
          }
        }
        bf16_t* row = C + (size_t)m * 384 + cb + 4 * h;
#pragma unroll
        for (int g = 0; g < 4; ++g) {
          uint2 w; w.x = pack2(v[4 * g], v[4 * g + 1]); w.y = pack2(v[4 * g + 2], v[4 * g + 3]);
          *(uint2*)(row + 8 * g) = w;
        }
      }
    }
  }
};

struct EpiDft {
  bf16_t* ABTL; bf16_t* ABTC; int g;
  template <int MB> DI void operator()(const f32x16 (&acc)[2][MB], int mb0, int nb0, int l31, int h) const {
    const int type = nb0 >> 6;
#pragma unroll
    for (int mb = 0; mb < MB; ++mb) {
      const int m = mb0 + mb * 32 + l31;
      bf16_t* base; size_t stride;
      if (m >= M_CTX) { const int b = (m - M_CTX) >> 12, sq = (m - M_CTX) & 4095; base = ABTL + ((size_t)b * 256 + g * 64) * 8192 + type * 4096 + sq; stride = 8192; }
      else { const int b = m >> 8, sq = m & 255; base = ABTC + ((size_t)b * 256 + g * 64) * 512 + type * 256 + sq; stride = 512; }
#pragma unroll
      for (int nb = 0; nb < 2; ++nb)
#pragma unroll
        for (int i = 0; i < 16; ++i) base[(size_t)(nb * 32 + crow(i, h)) * stride] = f2bf(acc[nb][mb][i]);
    }
  }
};


typedef float f32x4v __attribute__((ext_vector_type(4)));
DI int g8_lds_byte(int r, int c) { const int st = (r >> 4) * 2 + (c >> 5), rr = r & 15, cc = c & 31, ob = rr * 64 + cc * 2; return st * 1024 + (ob ^ (((ob >> 9) & 1) << 5)); }
DI void g8_stage_rc(int b, int& R, int& C) { const int st = b / 1024, sb = b % 1024, swz = sb ^ (((sb >> 9) & 1) << 5); R = (st >> 1) * 16 + swz / 64; C = (st & 1) * 32 + (swz % 64) / 2; }
DI const char* uni_ptr(const void* p) { const unsigned long long v = (unsigned long long)p; const unsigned lo = __builtin_amdgcn_readfirstlane((unsigned)v), hi = __builtin_amdgcn_readfirstlane((unsigned)(v >> 32)); return (const char*)(((unsigned long long)hi << 32) | lo); }
template <class Epi>
DI void gemm8_tile(const bf16_t* __restrict__ A, const bf16_t* __restrict__ Bt, int K, int brow, int bcol, unsigned char* smem, const Epi& epi,
                   bool first = true, bool has_next = false, int nbrow = 0, int nbcol = 0) {
  constexpr int HTB = 16384;
  const int tid = ltid(), wid = tid >> 6, lane = tid & 63, wr = wid >> 2, wc = wid & 3, fr = lane & 15, fq = lane >> 4;
  int sr0, sc0, sr1, sc1;
  g8_stage_rc(tid * 16, sr0, sc0); g8_stage_rc(tid * 16 + 8192, sr1, sc1);
  const unsigned bo0 = (unsigned)(sr0 * K + sc0) * 2u;
  const int swz_ = (fr * 64 + fq * 16) ^ ((((fr * 64 + fq * 16) >> 9) & 1) << 5);
  const int aoff = wr * 8192 + swz_, boff = wc * 4096 + swz_;
#define G8_SA(b, h) (smem + ((b) * 2 + (h)) * HTB)
#define G8_SB(b, h) (smem + (4 + (b) * 2 + (h)) * HTB)
#define G8_STAGE(P, BASE, br, kt) do { const char* _g = uni_ptr((BASE) + (size_t)(br) * K + (size_t)(kt) * 64); \
    const char* _g2 = uni_ptr(_g + (size_t)128 * K); \
    __builtin_amdgcn_global_load_lds((const unsigned*)(_g + bo0), (unsigned*)((P) + tid * 16), 16, 0, 0); \
    __builtin_amdgcn_global_load_lds((const unsigned*)(_g2 + bo0), (unsigned*)((P) + tid * 16 + 8192), 16, 0, 0); } while (0)
#define G8_LDA(dst, b, h) _Pragma("unroll") for (int m = 0; m < 4; ++m) _Pragma("unroll") for (int k = 0; k < 2; ++k) \
    dst[m][k] = *(const bf16x8*)(G8_SA(b, h) + aoff + m * 2048 + k * 1024)
#define G8_LDB(dst, b, h) _Pragma("unroll") for (int n = 0; n < 2; ++n) _Pragma("unroll") for (int k = 0; k < 2; ++k) \
    dst[n][k] = *(const bf16x8*)(G8_SB(b, h) + boff + n * 2048 + k * 1024)
#define G8_MMA(ai, bj, At_, Bx_) do { __builtin_amdgcn_s_setprio(1); \
    _Pragma("unroll") for (int m = 0; m < 4; ++m) _Pragma("unroll") for (int n = 0; n < 2; ++n) _Pragma("unroll") for (int k = 0; k < 2; ++k) \
      acc[ai][bj][m][n] = __builtin_amdgcn_mfma_f32_16x16x32_bf16(Bx_[n][k], At_[m][k], acc[ai][bj][m][n], 0, 0, 0); \
    __builtin_amdgcn_s_setprio(0); } while (0)
#define G8_WAIT_V(n) asm volatile("s_waitcnt vmcnt(" #n ")" ::: "memory")
#define G8_WAIT_L(n) asm volatile("s_waitcnt lgkmcnt(" #n ")" ::: "memory")
#define G8_BAR __builtin_amdgcn_s_barrier()
#define G8_SCHED __builtin_amdgcn_sched_barrier(0)
  f32x4v acc[2][2][4][2];
#pragma unroll
  for (int a = 0; a < 2; ++a)
#pragma unroll
    for (int b = 0; b < 2; ++b)
#pragma unroll
      for (int m = 0; m < 4; ++m)
#pragma unroll
        for (int n = 0; n < 2; ++n) acc[a][b][m][n] = (f32x4v){0.f, 0.f, 0.f, 0.f};
  bf16x8 At[4][2], B0[2][2], B1[2][2];
  const int nt = K / 64;
  if (first) {
    G8_WAIT_V(0);
    __syncthreads();
    G8_STAGE(G8_SB(0, 0), Bt, bcol, 0); G8_STAGE(G8_SA(0, 0), A, brow, 0);
    G8_STAGE(G8_SB(0, 1), Bt, bcol + 128, 0); G8_STAGE(G8_SA(0, 1), A, brow + 128, 0);
  }
  if (wr == 1) G8_BAR;
  G8_WAIT_V(4); G8_BAR;
  G8_STAGE(G8_SB(1, 0), Bt, bcol, 1); G8_STAGE(G8_SA(1, 0), A, brow, 1); G8_STAGE(G8_SB(1, 1), Bt, bcol + 128, 1);
  G8_WAIT_V(6); G8_BAR;
  for (int t = 0; t < nt - 2; t += 2) {
    G8_LDB(B0, 0, 0); G8_SCHED; G8_LDA(At, 0, 0); G8_STAGE(G8_SA(1, 1), A, brow + 128, t + 1);
    G8_WAIT_L(8); G8_BAR; G8_WAIT_L(0); G8_MMA(0, 0, At, B0); G8_BAR; G8_SCHED;
    G8_LDB(B1, 0, 1); G8_STAGE(G8_SB(0, 0), Bt, bcol, t + 2);
    G8_BAR; G8_WAIT_L(0); G8_MMA(0, 1, At, B1); G8_BAR;
    G8_LDA(At, 0, 1); G8_STAGE(G8_SA(0, 0), A, brow, t + 2);
    G8_BAR; G8_WAIT_L(0); G8_MMA(1, 0, At, B0); G8_BAR; G8_SCHED;
    G8_STAGE(G8_SB(0, 1), Bt, bcol + 128, t + 2);
    G8_WAIT_V(6); G8_BAR; G8_MMA(1, 1, At, B1); G8_BAR;
    G8_LDB(B0, 1, 0); G8_SCHED; G8_LDA(At, 1, 0); G8_STAGE(G8_SA(0, 1), A, brow + 128, t + 2);
    G8_WAIT_L(8); G8_BAR; G8_WAIT_L(0); G8_MMA(0, 0, At, B0); G8_BAR; G8_SCHED;
    G8_LDB(B1, 1, 1); G8_STAGE(G8_SB(1, 0), Bt, bcol, t + 3);
    G8_BAR; G8_WAIT_L(0); G8_MMA(0, 1, At, B1); G8_BAR;
    G8_LDA(At, 1, 1); G8_STAGE(G8_SA(1, 0), A, brow, t + 3);
    G8_BAR; G8_WAIT_L(0); G8_MMA(1, 0, At, B0); G8_BAR; G8_SCHED;
    G8_STAGE(G8_SB(1, 1), Bt, bcol + 128, t + 3);
    G8_WAIT_V(6); G8_BAR; G8_MMA(1, 1, At, B1); G8_BAR;
  }
  { G8_LDB(B0, 0, 0); G8_LDA(At, 0, 0); G8_STAGE(G8_SA(1, 1), A, brow + 128, nt - 1);
    G8_BAR; G8_WAIT_L(0); G8_MMA(0, 0, At, B0); G8_BAR;
    G8_LDB(B1, 0, 1); G8_BAR; G8_WAIT_L(0); G8_MMA(0, 1, At, B1); G8_BAR;
    G8_LDA(At, 0, 1); G8_WAIT_V(4); G8_BAR; G8_WAIT_L(0); G8_MMA(1, 0, At, B0); G8_MMA(1, 1, At, B1); G8_BAR; }
  { G8_LDB(B0, 1, 0); G8_LDA(At, 1, 0); G8_WAIT_V(2); G8_BAR; G8_WAIT_L(0); G8_MMA(0, 0, At, B0); G8_BAR;
    G8_LDB(B1, 1, 1); G8_WAIT_V(0); G8_BAR; G8_WAIT_L(0); G8_MMA(0, 1, At, B1); G8_BAR;
    G8_LDA(At, 1, 1); G8_BAR; G8_WAIT_L(0); G8_MMA(1, 0, At, B0); G8_MMA(1, 1, At, B1); G8_BAR; }
  if (wr == 0) G8_BAR;
  if (has_next) {
    G8_STAGE(G8_SB(0, 0), Bt, nbcol, 0); G8_STAGE(G8_SA(0, 0), A, nbrow, 0);
    G8_STAGE(G8_SB(0, 1), Bt, nbcol + 128, 0); G8_STAGE(G8_SA(0, 1), A, nbrow + 128, 0);
  }
  epi(acc, brow, bcol);
}
struct Epi8Bf16 {
  bf16_t* C; int ldc; float scale; int ncols;
  DI void operator()(const f32x4v (&acc)[2][2][4][2], int brow, int bcol) const {
    const int tid_ = ltid(), wid_ = tid_ >> 6, wr = wid_ >> 2, wc = wid_ & 3, fr = tid_ & 15, fq = (tid_ & 63) >> 4;
#pragma unroll
    for (int ai = 0; ai < 2; ++ai)
#pragma unroll
      for (int m = 0; m < 4; ++m) {
        bf16_t* row = C + (size_t)(brow + ai * 128 + wr * 64 + m * 16 + fr) * ldc;
#pragma unroll
        for (int bj = 0; bj < 2; ++bj)
#pragma unroll
          for (int n = 0; n < 2; ++n) {
            const int col = bcol + bj * 128 + wc * 32 + n * 16 + 4 * fq;
            if (col < ncols) {
              const f32x4v v = acc[ai][bj][m][n];
              u32x2 w; w[0] = pack2(v[0] * scale, v[1] * scale); w[1] = pack2(v[2] * scale, v[3] * scale);
              *(u32x2*)(row + col) = w;
            }
          }
      }
  }
};
struct Epi8GateUp {
  bf16_t* C;
  DI void operator()(const f32x4v (&acc)[2][2][4][2], int brow, int bcol) const {
    const int tid_ = ltid(), wid_ = tid_ >> 6, wr = wid_ >> 2, wc = wid_ & 3, fr = tid_ & 15, fq = (tid_ & 63) >> 4;
#pragma unroll
    for (int ai = 0; ai < 2; ++ai)
#pragma unroll
      for (int m = 0; m < 4; ++m) {
        bf16_t* row = C + (size_t)(brow + ai * 128 + wr * 64 + m * 16 + fr) * DFF;
#pragma unroll
        for (int bj = 0; bj < 2; ++bj) {
          const int col = ((bcol + bj * 128 + wc * 32) >> 1) + 4 * fq;
          const f32x4v g = acc[ai][bj][m][0], u = acc[ai][bj][m][1];
          u32x2 w; w[0] = pack2(silu_f(g[0]) * u[0], silu_f(g[1]) * u[1]); w[1] = pack2(silu_f(g[2]) * u[2], silu_f(g[3]) * u[3]);
          *(u32x2*)(row + col) = w;
        }
      }
  }
};
struct Epi8Win {
  bf16_t* Z; float* out; int l;
  DI void operator()(const f32x4v (&acc)[2][2][4][2], int brow, int bcol) const {
    const int tid_ = ltid(), wid_ = tid_ >> 6, wr = wid_ >> 2, wc = wid_ & 3, fr = tid_ & 15, fq = (tid_ & 63) >> 4;
#pragma unroll
    for (int ai = 0; ai < 2; ++ai)
#pragma unroll
      for (int m = 0; m < 4; ++m) {
        const int mrow = brow + ai * 128 + wr * 64 + m * 16 + fr;
        bf16_t* row = Z + (size_t)mrow * DIN;
#pragma unroll
        for (int bj = 0; bj < 2; ++bj)
#pragma unroll
          for (int n = 0; n < 2; ++n) {
            const int col = bcol + bj * 128 + wc * 32 + n * 16 + 4 * fq;
            if (col < DIN) {
              const f32x4v v = acc[ai][bj][m][n];
              u32x2 w; w[0] = pack2(v[0], v[1]); w[1] = pack2(v[2], v[3]);
              *(u32x2*)(row + col) = w;
              if (mrow < M_CTX) {
                const int b = mrow >> 8, sq = mrow & 255;
                const size_t tok = (size_t)((b * 4 + l) * 256 + sq);
                float* dst = nullptr;
                if (col >= ZKS && col < ZVS) dst = out + O_SK + tok * 128 + (col - ZKS);
                else if (col >= ZVS && col < ZF) dst = out + O_SV + tok * 128 + (col - ZVS);
                else if (col >= ZKR) dst = out + O_KR + tok * 32 + (col - ZKR);
                if (dst) *(float4*)dst = make_float4(v[0], v[1], v[2], v[3]);
              }
            }
          }
      }
  }
};

DI void mod_item(const Params& p, int it, unsigned char* smem) {
  float* sc = (float*)smem;
  float* red = sc + 5 * 1024;
  const int tid = vtid(), lane = tid & 63, wid = tid >> 6;
  const int l = it / 144, n = (it % 144) * 64 + lane;
  __syncthreads();
  for (int e = tid; e < 5 * 1024; e += VT) {
    const int i = e >> 10, k = e & 1023;
    const float v = i == 0 ? p.c_ctx[k] : p.c[(i - 1) * 1024 + k];
    sc[e] = v / (1.f + expf(-v));
  }
  __syncthreads();
  float a0 = 0, a1 = 0, a2 = 0, a3 = 0, a4 = 0;
  const float* w = p.w_mod + ((size_t)l * 1024 + wid * 256) * 9216 + n;
#pragma unroll 32
  for (int k = 0; k < 256; ++k) {
    const float wv = w[(size_t)k * 9216];
    const int kk = wid * 256 + k;
    a0 += sc[kk] * wv; a1 += sc[1024 + kk] * wv; a2 += sc[2048 + kk] * wv; a3 += sc[3072 + kk] * wv; a4 += sc[4096 + kk] * wv;
  }
  red[(wid * 5 + 0) * 64 + lane] = a0; red[(wid * 5 + 1) * 64 + lane] = a1; red[(wid * 5 + 2) * 64 + lane] = a2;
  red[(wid * 5 + 3) * 64 + lane] = a3; red[(wid * 5 + 4) * 64 + lane] = a4;
  __syncthreads();
  for (int e = tid; e < 320; e += VT) {
    const int i = e >> 6, cl = e & 63;
    float s = 0.f;
    for (int w4 = 0; w4 < 4; ++w4) s += red[(w4 * 5 + i) * 64 + cl];
    const int col = (it % 144) * 64 + cl;
    p.MOD[(size_t)(l * 5 + i) * 9216 + col] = s + p.b_mod[(size_t)l * 9216 + col];
  }
}

DI void phase_init(const Params& p, unsigned char* smem) {
  const int nb = gridDim.x, bid = lbid(), tid = ltid();
  for (int pr = bid; pr < 288; pr += nb) mod_item(p, 2 * pr + vhalf(), smem + vhalf() * HALF_BYTES);
  for (int it = 576 + bid; it < 1602; it += nb) {
    if (it < 1600) {
      const int r0 = (it - 576) * 4;
      for (int e = tid; e < 4 * 512; e += NT) {
        const int r = r0 + (e >> 9), k8 = (e & 511) * 8;
        unsigned w[4];
#pragma unroll
        for (int j = 0; j < 4; ++j) {
          float v[2];
#pragma unroll
          for (int q = 0; q < 2; ++q) {
            const int k = k8 + 2 * j + q;
            const int kk = k <= 2048 ? k : k - 2048;
            const int idx = (r * kk) & 4095;
            const float ang = (float)idx * (1.0f / 2048.0f);
            v[q] = k <= 2048 ? cospif(ang) : -sinpif(ang);
          }
          w[j] = pack2(v[0], v[1]);
        }
        *(uint4*)(p.TWL + (size_t)r * 4096 + k8) = make_uint4(w[0], w[1], w[2], w[3]);
      }
    } else if (it == 1600) {
      for (int e = tid; e < 256 * 512; e += NT) {
        const int r = e >> 9, k = e & 511;
        const int idx = (r * (k & 255)) & 255;
        const float ang = (float)idx * (1.0f / 128.0f);
        p.TWC[e] = f2bf(k < 256 ? cospif(ang) : -sinpif(ang));
      }
    } else {
      for (int e = tid; e < 64 * 16; e += NT) {
        const int pos = e >> 4, j = e & 15;
        const float inv = powf(10000.0f, -(float)(2 * j) / 32.0f);
        const float ang = (float)pos * inv;
        p.ROPE_S[e * 2] = cosf(ang); p.ROPE_S[e * 2 + 1] = sinf(ang);
      }
      for (int e = tid; e < 128 * 64; e += NT) {
        const int n = e >> 6, c = e & 63;
        const float ang = (float)((c * (n & 63)) & 63) * (1.f / 32.f);
        p.DFTW[e] = f2bf(n < 64 ? cospif(ang) : sinpif(ang));
      }
      for (int e = tid; e < 64 * 8; e += NT) {
        const int pos = e >> 3, j = e & 7;
        const float inv = powf(10000.0f, -(float)(2 * j) / 16.0f);
        const float ang = (float)pos * inv;
        p.ROPE_M[e * 2] = cosf(ang); p.ROPE_M[e * 2 + 1] = sinf(ang);
      }
    }
  }
}

DI void conv_tile(const float* __restrict__ src, int N, bf16_t* __restrict__ dst, int K, int kt, int nt, int mode, unsigned char* smem) {
  float* ts = (float*)smem;
  const int tid = vtid();
  __syncthreads();
#pragma unroll
  for (int i = 0; i < 4; ++i) {
    const int r = (tid >> 4) + 16 * i, c4 = (tid & 15) * 4;
    const float4 v = *(const float4*)(src + (size_t)(kt * 64 + r) * N + nt * 64 + c4);
    ts[r * 65 + c4] = v.x; ts[r * 65 + c4 + 1] = v.y; ts[r * 65 + c4 + 2] = v.z; ts[r * 65 + c4 + 3] = v.w;
  }
  __syncthreads();
  const int nl = tid >> 2, ks = (tid & 3) * 16;
  const int n = nt * 64 + nl;
  int drow = n;
  if (mode == 1) drow = (n >> 4) * 32 + (n & 15);
  else if (mode == 2) drow = (n >> 4) * 32 + 16 + (n & 15);
  unsigned w[8];
#pragma unroll
  for (int j = 0; j < 8; ++j) w[j] = pack2(ts[(ks + 2 * j) * 65 + nl], ts[(ks + 2 * j + 1) * 65 + nl]);
  bf16_t* d = dst + (size_t)drow * K + kt * 64 + ks;
  *(uint4*)d = make_uint4(w[0], w[1], w[2], w[3]);
  *(uint4*)(d + 8) = make_uint4(w[4], w[5], w[6], w[7]);
}
DI void convert_layer(const Params& p, int l, unsigned char* smem) {
  smem += vhalf() * HALF_BYTES;
  for (int t = 2 * lbid() + vhalf(); t < 5080; t += 2 * gridDim.x) {
    if (t < 2816) {
      const int q = t / 704, r = t % 704, i = q >> 1, which = q & 1;
      const float* src = (which ? p.w_up : p.w_gate) + (size_t)(l * 2 + i) * 1024 * DFF;
      conv_tile(src, DFF, p.WGU + (size_t)i * 5632 * 1024, 1024, r / 44, r % 44, 1 + which, smem);
    } else if (t < 4224) {
      const int q = (t - 2816) / 704, r = (t - 2816) % 704;
      conv_tile(p.w_down + (size_t)(l * 2 + q) * DFF * 1024, 1024, p.WD + (size_t)q * 1024 * DFF, DFF, r / 16, r % 16, 0, smem);
    } else if (t < 4784) {
      const int r = t - 4224;
      conv_tile(p.w_in + (size_t)l * 1024 * DIN, DIN, p.WIN, 1024, r / 35, r % 35, 0, smem);
    } else if (t < 5040) {
      const int r = t - 4784;
      conv_tile(p.w_out + (size_t)l * 1024 * 1024, 1024, p.WOUT, 1024, r / 16, r % 16, 0, smem);
    } else if (t < 5064) {
      const int r = t - 5040;
      conv_tile(p.w_qb + (size_t)l * 256 * 384, 384, p.WQB, 256, r / 6, r % 6, 0, smem);
    } else {
      const int r = t - 5064;
      conv_tile(p.w_kvb + (size_t)l * 128 * 512, 512, p.WKVB, 128, r / 8, r % 8, 0, smem);
    }
  }
}

struct EwArgs {
  const void *xin_ctx, *xin_lat; void *xout_ctx, *xout_lat;
  int in_f32, out_f32;
  const float* F; int lu, gate_idx, gpost_idx; float res_w;
  int do_norm, ln, sc_idx, sh_idx, gpre_idx;
  int r_lo, r_hi, vb, nvb;
};
DI float4 ld4_bf16(const bf16_t* p) { const u32x2 v = *(const u32x2*)p; return make_float4(__uint_as_float(v[0] << 16), __uint_as_float(v[0] & 0xffff0000u), __uint_as_float(v[1] << 16), __uint_as_float(v[1] & 0xffff0000u)); }
DI void phase_ew(const Params& p, const EwArgs& a) {
  const int lane = ltid() & 63, gw = a.vb * NW + (ltid() >> 6), nwv = a.nvb * NW;
  const bool upd = a.F != nullptr;
  const int rpw = (a.r_hi - a.r_lo + nwv - 1) / nwv;
  const int r0 = a.r_lo + gw * rpw, r1 = r0 + rpw < a.r_hi ? r0 + rpw : a.r_hi;
  float4 g[4], q[4], s4[4], t4[4], u4[4];
  int cur_mi = -1;
  for (int r = r0; r < r1; ++r) {
    const int mi = r < M_CTX ? 0 : 1 + ((r - M_CTX) >> 12);
    if (mi != cur_mi) {
      cur_mi = mi;
      const float* __restrict__ gate = p.MOD + (size_t)(a.lu * 5 + mi) * 9216 + a.gate_idx * 1024;
      const float* __restrict__ gpo = p.g_norm + (size_t)(a.lu * 6 + a.gpost_idx) * 1024;
      const float* __restrict__ sc = p.MOD + (size_t)(a.ln * 5 + mi) * 9216 + a.sc_idx * 1024;
      const float* __restrict__ sh = p.MOD + (size_t)(a.ln * 5 + mi) * 9216 + a.sh_idx * 1024;
      const float* __restrict__ gpr = p.g_norm + (size_t)(a.ln * 6 + a.gpre_idx) * 1024;
#pragma unroll
      for (int j = 0; j < 4; ++j) {
        const int c = lane * 4 + 256 * j;
        if (upd) { g[j] = *(const float4*)(gate + c); q[j] = *(const float4*)(gpo + c); }
        if (a.do_norm) { s4[j] = *(const float4*)(sc + c); t4[j] = *(const float4*)(sh + c); u4[j] = *(const float4*)(gpr + c); }
      }
    }
    const size_t ro = r < M_CTX ? (size_t)r * DM : (size_t)(r - M_CTX) * DM;
    const void* xb = r < M_CTX ? a.xin_ctx : a.xin_lat;
    float4 x[4], f[4];
#pragma unroll
    for (int j = 0; j < 4; ++j) {
      const int c = lane * 4 + 256 * j;
      x[j] = a.in_f32 ? *(const float4*)((const float*)xb + ro + c) : ld4_bf16((const bf16_t*)xb + ro + c);
      if (upd) f[j] = ld4_bf16((const bf16_t*)a.F + (size_t)r * DM + c);
    }
    if (upd) {
      float ss = 0.f;
#pragma unroll
      for (int j = 0; j < 4; ++j) ss += f[j].x * f[j].x + f[j].y * f[j].y + f[j].z * f[j].z + f[j].w * f[j].w;
      ss = wave_sum(ss);
      const float rs = rsqrtf(ss * (1.f / 1024.f) + EPS) * a.res_w;
      void* ob = r < M_CTX ? a.xout_ctx : a.xout_lat;
#pragma unroll
      for (int j = 0; j < 4; ++j) {
        const int c = lane * 4 + 256 * j;
        x[j].x += g[j].x * (f[j].x * rs * q[j].x); x[j].y += g[j].y * (f[j].y * rs * q[j].y);
        x[j].z += g[j].z * (f[j].z * rs * q[j].z); x[j].w += g[j].w * (f[j].w * rs * q[j].w);
        if (a.out_f32) *(float4*)((float*)ob + ro + c) = x[j];
        else { u32x2 w; w[0] = pack2(x[j].x, x[j].y); w[1] = pack2(x[j].z, x[j].w); *(u32x2*)((bf16_t*)ob + ro + c) = w; }
      }
    }
    if (a.do_norm) {
      float ss = 0.f;
#pragma unroll
      for (int j = 0; j < 4; ++j) ss += x[j].x * x[j].x + x[j].y * x[j].y + x[j].z * x[j].z + x[j].w * x[j].w;
      ss = wave_sum(ss);
      const float rs = rsqrtf(ss * (1.f / 1024.f) + EPS);
      bf16_t* hr = p.H + (size_t)r * DM;
#pragma unroll
      for (int j = 0; j < 4; ++j) {
        u32x2 w;
        w[0] = pack2(x[j].x * rs * u4[j].x * (1.f + s4[j].x) + t4[j].x, x[j].y * rs * u4[j].y * (1.f + s4[j].y) + t4[j].y);
        w[1] = pack2(x[j].z * rs * u4[j].z * (1.f + s4[j].z) + t4[j].z, x[j].w * rs * u4[j].w * (1.f + s4[j].w) + t4[j].w);
        *(u32x2*)(hr + lane * 4 + 256 * j) = w;
      }
    }
  }
}

DI void prep_item(const Params& p, int l, int it, unsigned char* smem) {
  const int tid = ltid(), lane = tid & 63, wid = tid >> 6;
  const int r0 = it * 32;
  if (r0 >= M_TOT) {
    for (int e = tid; e < 32 * 128; e += NT) {
      const int rr = e >> 7, cc = e & 127, idx = r0 - M_TOT + rr, b = idx >> 8, j = idx & 255;
      const size_t src = ((size_t)(b * 4 + l) * 256 + j) * 128 + cc;
      const size_t dst = (size_t)(r0 + rr) * 128 + cc;
      p.KS[dst] = f2bf(p.cache_swa_k[src]);
      p.VS[dst] = f2bf(p.cache_swa_v[src]);
      p.CKV[dst] = f2bf(p.cache_mla_ckv[src]);
    }
    for (int e = tid; e < 32 * 32; e += NT) {
      const int rr = e >> 5, cc = e & 31, idx = r0 - M_TOT + rr, b = idx >> 8, j = idx & 255;
      p.KR[(size_t)(r0 + rr) * 32 + cc] = f2bf(p.cache_mla_krope[((size_t)(b * 4 + l) * 256 + j) * 32 + cc]);
    }
    return;
  }
  const bool lat = r0 >= M_CTX;
  const bf16_t* __restrict__ Zr = p.Z; bf16_t* __restrict__ QSr = p.QS; bf16_t* __restrict__ KSr = p.KS; bf16_t* __restrict__ VSr = p.VS; const float* __restrict__ RSr = p.ROPE_S;
#pragma unroll 4
  for (int e = tid; e < 32 * 128; e += NT) {
    const int rr = e >> 7, rem = e & 127, head = rem >> 5, half = (rem >> 4) & 1, j = rem & 15;
    const int r = r0 + rr;
    const bf16_t* __restrict__ z = Zr + (size_t)r * DIN;
    const int d1 = head * 64 + half * 32 + j, d2 = d1 + 16;
    float x1 = bf2f(z[ZQS + d1]), x2 = bf2f(z[ZQS + d2]);
    float cs = 1.f, sn = 0.f;
    if (lat) { const int t = (r - M_CTX) & 4095; const int pos = half ? (t & 63) : (t >> 6); cs = RSr[(pos * 16 + j) * 2]; sn = RSr[(pos * 16 + j) * 2 + 1]; }
    QSr[(size_t)r * 256 + d1] = f2bf((x1 * cs - x2 * sn) * 0.125f);
    QSr[(size_t)r * 256 + d2] = f2bf((x2 * cs + x1 * sn) * 0.125f);
    if (head < 2) {
      x1 = bf2f(z[ZKS + d1]); x2 = bf2f(z[ZKS + d2]);
      KSr[(size_t)r * 128 + d1] = f2bf(x1 * cs - x2 * sn);
      KSr[(size_t)r * 128 + d2] = f2bf(x2 * cs + x1 * sn);
      VSr[(size_t)r * 128 + d1] = z[ZVS + d1];
      VSr[(size_t)r * 128 + d2] = z[ZVS + d2];
    }
  }
  for (int e = tid; e < 32 * 16; e += NT) {
    const int rr = e >> 4, half = (e >> 3) & 1, j = e & 7, r = r0 + rr;
    const bf16_t* z = p.Z + (size_t)r * DIN + ZKR;
    const int d1 = half * 16 + j, d2 = d1 + 8;
    const float x1 = bf2f(z[d1]), x2 = bf2f(z[d2]);
    float cs = 1.f, sn = 0.f;
    if (lat) { const int t = (r - M_CTX) & 4095; const int pos = half ? (t & 63) : (t >> 6); cs = p.ROPE_M[(pos * 8 + j) * 2]; sn = p.ROPE_M[(pos * 8 + j) * 2 + 1]; }
    p.KR[(size_t)r * 32 + d1] = f2bf(x1 * cs - x2 * sn);
    p.KR[(size_t)r * 32 + d2] = f2bf(x2 * cs + x1 * sn);
  }
#pragma unroll
  for (int rr0 = 0; rr0 < 32; rr0 += NW) {
    const int rr = rr0 + wid;
    const int r = r0 + rr;
    const bf16_t* __restrict__ z = Zr + (size_t)r * DIN;
    {
      const float a = bf2f(z[ZKVA + lane]), b = bf2f(z[ZKVA + 64 + lane]);
      const float rs = rsqrtf(wave_sum(a * a + b * b) * (1.f / 128.f) + EPS);
      const float o0 = a * rs * p.mla_g_kv[l * 128 + lane], o1 = b * rs * p.mla_g_kv[l * 128 + 64 + lane];
      p.CKV[(size_t)r * 128 + lane] = f2bf(o0); p.CKV[(size_t)r * 128 + 64 + lane] = f2bf(o1);
      if (!lat) {
        const int b_ = r >> 8, s = r & 255;
        float* dst = p.out + O_CKV + ((size_t)(b_ * 4 + l) * 256 + s) * 128;
        dst[lane] = o0; dst[64 + lane] = o1;
      }
    }
    {
      float v[4]; float ss = 0.f;
#pragma unroll
      for (int j = 0; j < 4; ++j) { v[j] = bf2f(z[ZQA + lane + 64 * j]); ss += v[j] * v[j]; }
      const float rs = rsqrtf(wave_sum(ss) * (1.f / 256.f) + EPS);
#pragma unroll
      for (int j = 0; j < 4; ++j) p.QLAT[(size_t)r * 256 + lane + 64 * j] = f2bf(v[j] * rs * p.mla_g_q[l * 256 + lane + 64 * j]);
    }
  }
}

DI void gla_cum(const Params& p, int l, int head, int dir, int row0, int rstep, float* sa, float* qt, f32x16& cum, float& last) {
  const int tid = vtid(), dk = tid & 63, quarter = tid >> 6;
  __syncthreads();
  for (int e = tid; e < 64 * 16; e += VT) {
    const int i = e >> 4, rr = e & 15;
    sa[e] = bf2f(p.Z[(size_t)(row0 + i * rstep) * DIN + ZAF + dir * 16 + rr]);
  }
  __syncthreads();
  float wg[16];
  const float* W = p.gla_w_gate + ((size_t)(l * 2 + dir) * 16) * 256 + head * 64 + dk;
#pragma unroll
  for (int rr = 0; rr < 16; ++rr) wg[rr] = W[rr * 256];
  const float bg = p.gla_b_gate[(l * 2 + dir) * 256 + head * 64 + dk];
  float run = 0.f;
#pragma unroll
  for (int ii = 0; ii < 16; ++ii) {
    const int i = quarter * 16 + ii;
    float lg = bg;
#pragma unroll
    for (int rr = 0; rr < 16; ++rr) lg += sa[i * 16 + rr] * wg[rr];
    const float ls = fminf(lg, 0.f) - __logf(1.f + __expf(-fabsf(lg)));
    run += ls * (1.f / 16.f);
    cum[ii] = run;
  }
  qt[quarter * 64 + dk] = run;
  __syncthreads();
  float offs = 0.f, tot = 0.f;
#pragma unroll
  for (int q = 0; q < 4; ++q) { const float v = qt[q * 64 + dk]; tot += v; if (q < quarter) offs += v; }
#pragma unroll
  for (int ii = 0; ii < 16; ++ii) cum[ii] += offs;
  last = tot;
}

DI void gla_seq_info(int sq_global, int& grp, int& b, int& head, int& dir, int& S, int& base) {
  if (sq_global < 32) { grp = 1; b = sq_global >> 3; head = (sq_global >> 1) & 3; dir = sq_global & 1; S = 4096; base = M_CTX + b * 4096; }
  else { const int s = sq_global - 32; grp = 0; b = s >> 3; head = (s >> 1) & 3; dir = s & 1; S = 256; base = b * 256; }
}

DI void gla_pass_a(const Params& p, int l, int ci, unsigned char* smem) {
  float* sa = (float*)smem;
  float* qt = sa + 1024;
  bf16_t* kdT = (bf16_t*)(qt + 256);
  bf16_t* vT = kdT + 64 * PITCH;
  const int tid = vtid(), lane = tid & 63, wid = tid >> 6, dk = tid & 63, quarter = tid >> 6, l31 = lane & 31, h = lane >> 5;
  int sqg, c;
  if (ci < 2048) { sqg = ci >> 6; c = ci & 63; } else { sqg = 32 + ((ci - 2048) >> 2); c = (ci - 2048) & 3; }
  int grp, b, head, dir, S, base;
  gla_seq_info(sqg, grp, b, head, dir, S, base);
  const int row0 = dir ? base + S - 1 - 64 * c : base + 64 * c, rstep = dir ? -1 : 1;
  f32x16 kraw, vraw;
#pragma unroll
  for (int ii = 0; ii < 16; ++ii) {
    const bf16_t* __restrict__ z = p.Z + (size_t)(row0 + (quarter * 16 + ii) * rstep) * DIN;
    kraw[ii] = bf2f(z[ZKG + head * 64 + dk]);
    vraw[ii] = bf2f(z[ZVG + head * 64 + dk]);
  }
  f32x16 cum; float last;
  gla_cum(p, l, head, dir, row0, rstep, sa, qt, cum, last);
  unsigned kw[8], vw[8];
#pragma unroll
  for (int j = 0; j < 8; ++j) {
    kw[j] = pack2(kraw[2 * j] * __expf(last - cum[2 * j]), kraw[2 * j + 1] * __expf(last - cum[2 * j + 1]));
    vw[j] = pack2(vraw[2 * j], vraw[2 * j + 1]);
  }
  *(uint4*)(kdT + dk * PITCH + quarter * 16) = make_uint4(kw[0], kw[1], kw[2], kw[3]);
  *(uint4*)(kdT + dk * PITCH + quarter * 16 + 8) = make_uint4(kw[4], kw[5], kw[6], kw[7]);
  *(uint4*)(vT + dk * PITCH + quarter * 16) = make_uint4(vw[0], vw[1], vw[2], vw[3]);
  *(uint4*)(vT + dk * PITCH + quarter * 16 + 8) = make_uint4(vw[4], vw[5], vw[6], vw[7]);
  if (quarter == 0) p.GLA_DL[(size_t)ci * 64 + dk] = expf(last);
  __syncthreads();
  const int wr = wid >> 1, wc = wid & 1;
  f32x16 acc;
#pragma unroll
  for (int i = 0; i < 16; ++i) acc[i] = 0.f;
#pragma unroll
  for (int ks = 0; ks < 4; ++ks) {
    const bf16x8 a = *(const bf16x8*)(kdT + (wr * 32 + l31) * PITCH + ks * 16 + h * 8);
    const bf16x8 bb = *(const bf16x8*)(vT + (wc * 32 + l31) * PITCH + ks * 16 + h * 8);
    acc = MFMA32(a, bb, acc);
  }
  float* Bc = p.GLA_B + (size_t)ci * 4096;
#pragma unroll
  for (int i = 0; i < 16; ++i) Bc[(wr * 32 + crow(i, h)) * 64 + wc * 32 + l31] = acc[i];
}

typedef float f32x8 __attribute__((ext_vector_type(8)));
DI void gla_pass_b(const Params& p, int l, int sqg) {
  const int tid = ltid(), dv = tid >> 3, dk0 = (tid & 7) * 8;
  int grp, b, head, dir, S, base;
  gla_seq_info(sqg, grp, b, head, dir, S, base);
  const int nch = S >> 6;
  const int ci0 = grp ? sqg * 64 : 2048 + (sqg - 32) * 4;
  f32x8 s;
  if (grp) {
    const float* __restrict__ s0 = p.state_gla + ((((size_t)b * 4 + l) * 2 + dir) * 4 + head) * 4096;
#pragma unroll
    for (int j = 0; j < 8; ++j) s[j] = s0[(dk0 + j) * 64 + dv];
  } else {
#pragma unroll
    for (int j = 0; j < 8; ++j) s[j] = 0.f;
  }
  const float* __restrict__ GB = p.GLA_B; const float* __restrict__ GD = p.GLA_DL; bf16_t* __restrict__ GS = p.GLA_S;
  if (grp) {
    const char* pb = (const char*)(GB + (size_t)ci0 * 4096) + tid * 16;
#pragma unroll 1
    for (int i = 0; i < 128; i += 32) {
      u32x4 tv[32];
#pragma unroll
      for (int j = 0; j < 32; ++j) tv[j] = *(const u32x4*)(pb + (size_t)(i + j) * 8192);
#pragma unroll
      for (int j = 0; j < 32; ++j) asm volatile("" :: "v"(tv[j]));
    }
  }
  f32x8 cb[4], cd[4], nb_[4], nd_[4];
#pragma unroll
  for (int q = 0; q < 4; ++q) {
    const float* Bc = GB + (size_t)(ci0 + q) * 4096; const float* dl = GD + (size_t)(ci0 + q) * 64 + dk0;
#pragma unroll
    for (int j = 0; j < 8; ++j) { cb[q][j] = Bc[(dk0 + j) * 64 + dv]; cd[q][j] = dl[j]; }
  }
  for (int c0 = 0; c0 < nch; c0 += 4) {
    const int cn0 = c0 + 4 < nch ? c0 + 4 : c0;
#pragma unroll
    for (int q = 0; q < 4; ++q) {
      const float* Bc = GB + (size_t)(ci0 + cn0 + q) * 4096; const float* dl = GD + (size_t)(ci0 + cn0 + q) * 64 + dk0;
#pragma unroll
      for (int j = 0; j < 8; ++j) { nb_[q][j] = Bc[(dk0 + j) * 64 + dv]; nd_[q][j] = dl[j]; }
    }
#pragma unroll
    for (int q = 0; q < 4; ++q) {
      u32x4 w;
      w[0] = pack2(s[0], s[1]); w[1] = pack2(s[2], s[3]); w[2] = pack2(s[4], s[5]); w[3] = pack2(s[6], s[7]);
      *(u32x4*)(GS + (size_t)(ci0 + c0 + q) * 4096 + dv * 64 + dk0) = w;
#pragma unroll
      for (int j = 0; j < 8; ++j) s[j] = cd[q][j] * s[j] + cb[q][j];
    }
#pragma unroll
    for (int q = 0; q < 4; ++q) { cb[q] = nb_[q]; cd[q] = nd_[q]; }
  }
  if (!grp) {
    float* so = p.out + O_ST + ((((size_t)b * 4 + l) * 2 + dir) * 4 + head) * 4096;
#pragma unroll
    for (int j = 0; j < 8; ++j) so[(dk0 + j) * 64 + dv] = s[j];
  }
}

DI void gla_pass_c(const Params& p, int l, int item, unsigned char* smem) {
  float* sa = (float*)smem;
  float* qt = sa + 1024;
  bf16_t* qd = (bf16_t*)(qt + 256);
  bf16_t* ki = qd + 64 * PITCH;
  bf16_t* vT = ki + 64 * PITCH;
  bf16_t* stT = vT + 64 * PITCH;
  float* osum = (float*)(stT + 64 * PITCH);
  const int tid = vtid(), lane = tid & 63, wid = tid >> 6, dk = tid & 63, quarter = tid >> 6, l31 = lane & 31, h = lane >> 5;
  int grp, b, head, c, S, base, nch;
  if (item < 1024) { grp = 1; b = item >> 8; head = (item >> 6) & 3; c = item & 63; S = 4096; base = M_CTX + b * 4096; nch = 64; }
  else { const int it = item - 1024; grp = 0; b = it >> 4; head = (it >> 2) & 3; c = it & 3; S = 256; base = b * 256; nch = 4; }
  const int wd = wid >> 1, wp = wid & 1;
  const int tk = tid >> 2, q4 = tid & 3, frow = base + 64 * c + tk;
  const u32x4 rg0 = *(const u32x4*)(p.Z + (size_t)frow * DIN + ZRG + head * 64 + q4 * 16);
  const u32x4 rg1 = *(const u32x4*)(p.Z + (size_t)frow * DIN + ZRG + head * 64 + q4 * 16 + 8);
  for (int dir = 0; dir < 2; ++dir) {
    const int cs = dir ? nch - 1 - c : c;
    const int sq = b * 8 + head * 2 + dir;
    const size_t ci = grp ? (size_t)sq * 64 + cs : 2048 + (size_t)sq * 4 + cs;
    const int row0 = dir ? base + S - 1 - 64 * cs : base + 64 * cs, rstep = dir ? -1 : 1;
    f32x16 qraw, kraw, vraw;
#pragma unroll
    for (int ii = 0; ii < 16; ++ii) {
      const bf16_t* __restrict__ z = p.Z + (size_t)(row0 + (quarter * 16 + ii) * rstep) * DIN;
      qraw[ii] = bf2f(z[ZQG + head * 64 + dk]);
      kraw[ii] = bf2f(z[ZKG + head * 64 + dk]);
      vraw[ii] = bf2f(z[ZVG + head * 64 + dk]);
    }
    u32x4 st0, st1;
    {
      const bf16_t* Sg = p.GLA_S + ci * 4096;
      st0 = *(const u32x4*)(Sg + (tid >> 3) * 64 + (tid & 7) * 8);
      st1 = *(const u32x4*)(Sg + (32 + (tid >> 3)) * 64 + (tid & 7) * 8);
    }
    f32x16 cum; float last;
    gla_cum(p, l, head, dir, row0, rstep, sa, qt, cum, last);
    unsigned vw[8];
#pragma unroll
    for (int ii = 0; ii < 16; ++ii) {
      const int i = quarter * 16 + ii;
      const float e = __expf(cum[ii]);
      qd[i * PITCH + dk] = f2bf(qraw[ii] * 0.125f * e);
      ki[i * PITCH + dk] = f2bf(kraw[ii] * __expf(-cum[ii]));
    }
#pragma unroll
    for (int j = 0; j < 8; ++j) vw[j] = pack2(vraw[2 * j], vraw[2 * j + 1]);
    *(uint4*)(vT + dk * PITCH + quarter * 16) = make_uint4(vw[0], vw[1], vw[2], vw[3]);
    *(uint4*)(vT + dk * PITCH + quarter * 16 + 8) = make_uint4(vw[4], vw[5], vw[6], vw[7]);
    *(u32x4*)(stT + (tid >> 3) * PITCH + (tid & 7) * 8) = st0;
    *(u32x4*)(stT + (32 + (tid >> 3)) * PITCH + (tid & 7) * 8) = st1;
    __syncthreads();
    f32x16 acco;
#pragma unroll
    for (int i = 0; i < 16; ++i) acco[i] = 0.f;
#pragma unroll
    for (int ks = 0; ks < 4; ++ks) {
      const bf16x8 a = *(const bf16x8*)(stT + (wd * 32 + l31) * PITCH + ks * 16 + h * 8);
      const bf16x8 bb = *(const bf16x8*)(qd + (wp * 32 + l31) * PITCH + ks * 16 + h * 8);
      acco = MFMA32(a, bb, acco);
    }
    for (int jb = 0; jb <= wp; ++jb) {
      f32x16 att;
#pragma unroll
      for (int i = 0; i < 16; ++i) att[i] = 0.f;
#pragma unroll
      for (int ks = 0; ks < 4; ++ks) {
        const bf16x8 a = *(const bf16x8*)(ki + (jb * 32 + l31) * PITCH + ks * 16 + h * 8);
        const bf16x8 bb = *(const bf16x8*)(qd + (wp * 32 + l31) * PITCH + ks * 16 + h * 8);
        att = MFMA32(a, bb, att);
      }
      const int ipos = wp * 32 + l31;
#pragma unroll
      for (int i = 0; i < 16; ++i) if (jb * 32 + crow(i, h) > ipos) att[i] = 0.f;
#pragma unroll
      for (int s = 0; s < 2; ++s) {
        union { bf16x8 v; unsigned u[4]; } pf;
#pragma unroll
        for (int j = 0; j < 4; ++j) pf.u[j] = pack2(att[8 * s + 2 * j], att[8 * s + 2 * j + 1]);
        union { bf16x8 v; bf16x4 hlf[2]; } vf;
        vf.hlf[0] = *(const bf16x4*)(vT + (wd * 32 + l31) * PITCH + jb * 32 + 16 * s + 4 * h);
        vf.hlf[1] = *(const bf16x4*)(vT + (wd * 32 + l31) * PITCH + jb * 32 + 16 * s + 8 + 4 * h);
        acco = MFMA32(vf.v, pf.v, acco);
      }
    }
    {
      const int i = wp * 32 + l31, tl = dir ? 63 - i : i;
#pragma unroll
      for (int r = 0; r < 16; ++r) {
        float* o = osum + tl * 65 + wd * 32 + crow(r, h);
        if (dir) *o += acco[r]; else *o = acco[r];
      }
    }
  }
  __syncthreads();
  {
    float v[16]; float ss = 0.f;
#pragma unroll
    for (int j = 0; j < 16; ++j) { v[j] = osum[tk * 65 + q4 * 16 + j]; ss += v[j] * v[j]; }
    ss += shx(ss, 1); ss += shx(ss, 2);
    const float rs = rsqrtf(ss * (1.f / 64.f) + EPS);
    const float* __restrict__ gp = p.gla_g_out + l * 64 + q4 * 16;
    unsigned w[8];
#pragma unroll
    for (int j = 0; j < 8; ++j) {
      const unsigned ru = j < 4 ? rg0[j & 3] : rg1[j & 3];
      const float r0 = __uint_as_float(ru << 16), r1 = __uint_as_float(ru & 0xffff0000u);
      w[j] = pack2(v[2 * j] * rs * gp[2 * j] * silu_f(r0), v[2 * j + 1] * rs * gp[2 * j + 1] * silu_f(r1));
    }
    bf16_t* dst = p.MIX + (size_t)frow * 1024 + head * 64 + q4 * 16;
    *(u32x4*)dst = (u32x4){w[0], w[1], w[2], w[3]};
    *(u32x4*)(dst + 8) = (u32x4){w[4], w[5], w[6], w[7]};
  }
}

struct AttnJob {
  const bf16_t* Q; int ldq;
  const bf16_t* K1; int ldk1;
  const bf16_t* K2; int ldk2;
  const bf16_t* V; int ldv;
  int ctx_row0, nctx;
  int loc_row0, loc_pos0, nloc;
  int qrow0, qpos0;
  int window;
  float scale; int has_sink; float sink;
  bf16_t* O; int ldo;
};
template <int DQ>
DI void attn_block(const AttnJob& jb, unsigned char* smem) {
  constexpr int NKS = DQ / 16, KP = DQ + 8, NCH = DQ / 8;
  constexpr int BUFE = 64 * KP + 64 * PITCH;
  bf16_t* sbuf = (bf16_t*)smem;
  const int tid = ltid(), lane = tid & 63, wid = tid >> 6, l31 = lane & 31, h = lane >> 5;
  const int qr = jb.qrow0 + wid * 32 + l31;
  bf16x8 qf[NKS];
#pragma unroll
  for (int ks = 0; ks < NKS; ++ks) {
    const u32x4 raw = *(const u32x4*)(jb.Q + (size_t)qr * jb.ldq + ks * 16 + h * 8);
    const float qs = jb.scale * 1.4426950408889634f;
    u32x4 sc;
#pragma unroll
    for (int j = 0; j < 4; ++j) sc[j] = pack2(__uint_as_float(raw[j] << 16) * qs, __uint_as_float(raw[j] & 0xffff0000u) * qs);
    qf[ks] = __builtin_bit_cast(bf16x8, sc);
  }
  const int qpos = jb.qpos0 + wid * 32 + l31;
  f32x16 o[2];
#pragma unroll
  for (int d = 0; d < 2; ++d)
#pragma unroll
    for (int i = 0; i < 16; ++i) o[d][i] = 0.f;
  float m = -1e30f, lsum = 0.f;
  const int nt = jb.nctx + jb.nloc;
  const int kk0 = tid / NCH, kd0 = tid % NCH;
  const bool k1v = (NCH > 8) && (tid + NT < 64 * NCH);
  const int kk1 = k1v ? (tid + NT) / NCH : 0, kd1 = k1v ? (tid + NT) % NCH : 0;
  const int vk0 = tid & 63, vd0 = tid >> 6;
  u32x4 ka0, ka1 = {0u, 0u, 0u, 0u}, va0, kb0, kb1 = {0u, 0u, 0u, 0u}, vb0, kc0, kc1 = {0u, 0u, 0u, 0u}, vc0;
#define ATT_KLD(key, dc, krow) ((dc) < 8 ? *(const u32x4*)(jb.K1 + (size_t)((krow) + (key)) * jb.ldk1 + (dc) * 8) \
                                       : *(const u32x4*)(jb.K2 + (size_t)((krow) + (key)) * jb.ldk2 + ((dc) - 8) * 8))
#define ATT_LOAD(tt, K0_, K1_, V0_) { const int tc_ = (tt) < nt ? (tt) : nt - 1; \
    const int kr_ = tc_ < jb.nctx ? jb.ctx_row0 + 64 * tc_ : jb.loc_row0 + jb.loc_pos0 + 64 * (tc_ - jb.nctx); \
    K0_ = ATT_KLD(kk0, kd0, kr_); if (k1v) K1_ = ATT_KLD(kk1, kd1, kr_); \
    V0_ = *(const u32x4*)(jb.V + (size_t)(kr_ + vk0) * jb.ldv + vd0 * 8); }
#define ATT_VST(dst, v, dc) { _Pragma("unroll") for (int j = 0; j < 4; ++j) { \
      (dst)[((dc) * 8 + 2 * j) * PITCH + vk0] = (bf16_t)((v)[j] & 0xffffu); (dst)[((dc) * 8 + 2 * j + 1) * PITCH + vk0] = (bf16_t)((v)[j] >> 16); } }
#define ATT_FILL(buf, K0_, K1_, V0_) { bf16_t* sKw = sbuf + (buf) * BUFE; bf16_t* sVw = sKw + 64 * KP; \
    *(u32x4*)(sKw + kk0 * KP + kd0 * 8) = K0_; if (k1v) *(u32x4*)(sKw + kk1 * KP + kd1 * 8) = K1_; ATT_VST(sVw, V0_, vd0); }
  ATT_LOAD(0, ka0, ka1, va0); ATT_LOAD(1, kb0, kb1, vb0); ATT_LOAD(2, kc0, kc1, vc0);
  __syncthreads();
  ATT_FILL(0, ka0, ka1, va0); ATT_LOAD(3, ka0, ka1, va0);
  ATT_FILL(1, kb0, kb1, vb0); ATT_LOAD(4, kb0, kb1, vb0);
  __syncthreads();
#define ATT_QK(dst, buf) { const bf16_t* sKq = sbuf + (buf) * BUFE; _Pragma("unroll") for (int kb = 0; kb < 2; ++kb) { \
      _Pragma("unroll") for (int i = 0; i < 16; ++i) dst[kb][i] = 0.f; \
      _Pragma("unroll") for (int ks = 0; ks < NKS; ++ks) { \
        const bf16x8 a = *(const bf16x8*)(sKq + (kb * 32 + l31) * KP + ks * 16 + h * 8); dst[kb] = MFMA32(a, qf[ks], dst[kb]); } } }
  f32x16 sn[2];
  ATT_QK(sn, 0);
  auto body = [&](const int t, const int bm, u32x4& kr0, u32x4& kr1, u32x4& vr0) __attribute__((always_inline)) {
    int kpos0; bool masked;
    if (t < jb.nctx) { kpos0 = 0; masked = false; }
    else { kpos0 = jb.loc_pos0 + 64 * (t - jb.nctx); masked = jb.window > 0; }
    ATT_FILL((bm + 2) % 3, kr0, kr1, vr0);
    ATT_LOAD(t + 5, kr0, kr1, vr0);
    const bf16_t* sVt = sbuf + bm * BUFE + 64 * KP;
    f32x16 st[2];
    st[0] = sn[0]; st[1] = sn[1];
    ATT_QK(sn, (bm + 1) % 3);
    float mx = -1e30f;
#pragma unroll
    for (int kb = 0; kb < 2; ++kb)
#pragma unroll
      for (int i = 0; i < 16; ++i) {
        float s = st[kb][i];
        if (masked) {
          const int kp = kpos0 + kb * 32 + crow(i, h);
          const int d = qpos - kp;
          if (d > jb.window || d < -jb.window) s = -1e30f;
        }
        st[kb][i] = s;
        mx = fmaxf(mx, s);
      }
    mx = fmaxf(mx, shx(mx, 32));
    const float mn = fmaxf(m, mx);
    const bool grow = __builtin_amdgcn_ballot_w64(mn > m) != 0ull;
    float ps = 0.f;
#pragma unroll
    for (int kb = 0; kb < 2; ++kb)
#pragma unroll
      for (int i = 0; i < 16; ++i) { const float pv = __builtin_amdgcn_exp2f(st[kb][i] - mn); st[kb][i] = pv; ps += pv; }
    if (grow) {
      const float alpha = __builtin_amdgcn_exp2f(m - mn);
      lsum *= alpha;
#pragma unroll
      for (int d = 0; d < 2; ++d)
#pragma unroll
        for (int i = 0; i < 16; ++i) o[d][i] *= alpha;
    }
    m = mn;
    lsum += ps;
#pragma unroll
    for (int kb = 0; kb < 2; ++kb)
#pragma unroll
      for (int s = 0; s < 2; ++s) {
        union { bf16x8 v; unsigned u[4]; } pf;
#pragma unroll
        for (int j = 0; j < 4; ++j) pf.u[j] = pack2(st[kb][8 * s + 2 * j], st[kb][8 * s + 2 * j + 1]);
#pragma unroll
        for (int d = 0; d < 2; ++d) {
          union { bf16x8 v; bf16x4 hlf[2]; } vf;
          vf.hlf[0] = *(const bf16x4*)(sVt + (d * 32 + l31) * PITCH + kb * 32 + 16 * s + 4 * h);
          vf.hlf[1] = *(const bf16x4*)(sVt + (d * 32 + l31) * PITCH + kb * 32 + 16 * s + 8 + 4 * h);
          o[d] = MFMA32(vf.v, pf.v, o[d]);
        }
      }
    __syncthreads();
  };
  for (int t = 0; t < nt; t += 3) {
    body(t, 0, kc0, kc1, vc0);
    if (t + 1 < nt) body(t + 1, 1, ka0, ka1, va0);
    if (t + 2 < nt) body(t + 2, 2, kb0, kb1, vb0);
  }
  lsum += shx(lsum, 32);
  float inv;
  if (jb.has_sink) {
    const float sk2 = jb.sink * 1.4426950408889634f;
    const float mf = fmaxf(m, sk2);
    const float corr = __builtin_amdgcn_exp2f(m - mf);
    inv = corr / (lsum * corr + __builtin_amdgcn_exp2f(sk2 - mf));
  } else inv = 1.f / lsum;
  bf16_t* orow = jb.O + (size_t)qr * jb.ldo;
#pragma unroll
  for (int d = 0; d < 2; ++d)
#pragma unroll
    for (int g = 0; g < 4; ++g) {
      uint2 w;
      w.x = pack2(o[d][4 * g] * inv, o[d][4 * g + 1] * inv);
      w.y = pack2(o[d][4 * g + 2] * inv, o[d][4 * g + 3] * inv);
      *(uint2*)(orow + d * 32 + 8 * g + 4 * h) = w;
    }
}

DI void mla_item(const Params& p, int l, int grp, int it, unsigned char* smem) {
  AttnJob j;
  int b, head, qb;
  if (grp) { b = it >> 6; head = (it >> 4) & 3; qb = it & 15; } else { b = it >> 2; head = it & 3; qb = 0; }
  const int base = grp ? M_CTX + b * 4096 : b * 256;
  j.Q = p.QM + head * 96; j.ldq = 384;
  j.K1 = p.KV + head * 128; j.ldk1 = 512; j.K2 = p.KR; j.ldk2 = 32; j.V = p.KV + head * 128 + 64; j.ldv = 512;
  j.ctx_row0 = M_TOT + b * 256; j.nctx = grp ? 4 : 0;
  j.loc_row0 = base; j.loc_pos0 = 0; j.nloc = grp ? 64 : 4;
  j.qrow0 = base + qb * 256; j.qpos0 = qb * 256; j.window = 0;
  j.scale = 0.10206207261596577f; j.has_sink = 0; j.sink = 0.f;
  j.O = p.MIX + 768 + head * 64; j.ldo = 1024;
  attn_block<96>(j, smem);
}
DI void swa_item(const Params& p, int l, int grp, int it, unsigned char* smem) {
  AttnJob j;
  int b, hq, qb;
  if (grp) { b = it >> 6; hq = (it >> 4) & 3; qb = it & 15; } else { b = it >> 2; hq = it & 3; qb = 0; }
  const int base = grp ? M_CTX + b * 4096 : b * 256;
  const int g = hq >> 1;
  j.Q = p.QS + hq * 64; j.ldq = 256;
  j.K1 = p.KS + g * 64; j.ldk1 = 128; j.K2 = p.KS; j.ldk2 = 128; j.V = p.VS + g * 64; j.ldv = 128;
  j.ctx_row0 = M_TOT + b * 256; j.nctx = grp ? 4 : 0;
  if (grp) {
    const int lo = qb > 0 ? qb * 256 - 128 : 0, hi = qb < 15 ? qb * 256 + 384 : 4096;
    j.loc_pos0 = lo; j.nloc = (hi - lo) >> 6; j.window = 128;
  } else { j.loc_pos0 = 0; j.nloc = 4; j.window = 0; }
  j.loc_row0 = base;
  j.qrow0 = base + qb * 256; j.qpos0 = qb * 256;
  j.scale = 1.0f;
  j.has_sink = 1; j.sink = p.swa_sink[l * 4 + hq];
  j.O = p.MIX + 256 + hq * 64; j.ldo = 1024;
  attn_block<64>(j, smem);
}

DI bool tile_swz(int i, int nN, int T, int& tm, int& tn) {
  const int bid = lbid(), slots = gridDim.x >> 3;
  const int L = (i * 8 + (bid & 7)) * slots + (bid >> 3);
  if (L >= T) return false;
  const int pw = 8 * nN, pnl = L / pw, rem = L - pnl * pw;
  tn = rem >> 3; tm = pnl * 8 + (rem & 7);
  return true;
}
DI void phase_gemm_gu(const Params& p, int i, unsigned char* smem) {
  Epi8GateUp epi{p.ACT};
  const bf16_t* W = p.WGU + (size_t)i * 5632 * 1024;
  int tm, tn, nm = 0, nn = 0; bool has = tile_swz(0, 22, 80 * 22, tm, tn), first = true;
  for (int i2 = 0; has; ++i2) {
    const bool hn = tile_swz(i2 + 1, 22, 80 * 22, nm, nn);
    gemm8_tile(p.H, W, 1024, tm * 256, tn * 256, smem, epi, first, hn, nm * 256, nn * 256);
    first = false; tm = nm; tn = nn; has = hn;
  }
}
DI void phase_gemm_down(const Params& p, int i, unsigned char* smem, int round) {
  Epi8Bf16 epi{(bf16_t*)p.F, 1024, 1.f, 1024};
  const bf16_t* W = p.WD + (size_t)i * 1024 * DFF;
  int tm, tn;
  if (tile_swz(round, 4, 80 * 4, tm, tn)) gemm8_tile(p.ACT, W, DFF, tm * 256, tn * 256, smem, epi);
}
DI void phase_gemm_win(const Params& p, int l, unsigned char* smem) {
  Epi8Win epi{p.Z, p.out, l};
  int tm, tn, nm = 0, nn = 0; bool has = tile_swz(0, 9, 80 * 9, tm, tn), first = true;
  for (int i2 = 0; has; ++i2) {
    const bool hn = tile_swz(i2 + 1, 9, 80 * 9, nm, nn);
    gemm8_tile(p.H, p.WIN, 1024, tm * 256, tn * 256, smem, epi, first, hn, nm * 256, nn * 256);
    first = false; tm = nm; tn = nn; has = hn;
  }
}
DI void phase_gemm_wout(const Params& p, unsigned char* smem) {
  Epi8Bf16 epi{(bf16_t*)p.F, 1024, 1.f, 1024};
  { int tm, tn; const int nit = (80 * 4 + gridDim.x - 1) / gridDim.x + 8; for (int i2 = 0; i2 < nit; ++i2) if (tile_swz(i2, 4, 80 * 4, tm, tn)) gemm8_tile(p.MIX, p.WOUT, 1024, tm * 256, tn * 256, smem, epi); }
}
DI void phase_prep(const Params& p, int l, unsigned char* smem, unsigned* ctr) {
  volatile int* s_item = (volatile int*)(smem + S_ITEM_OFF);
  for (;;) {
    __syncthreads();
    if (ltid() == 0) *s_item = (int)atomicAdd(ctr, 1u);
    __syncthreads();
    const int t = *s_item;
    if (t >= 2272) break;
    if (t < 672) prep_item(p, l, t, smem);
    else if (t < 992) {
      const int u = t - 672, g = u & 3, tm = u >> 2;
      EpiDft e{p.ABTL, p.ABTC, g};
      gemm_tile<2>(p.Z + ZF + g * 64, DIN, p.DFTW, 64, 64, tm * 256, 0, smem, e);
    } else gla_pass_a(p, l, 2 * (t - 992) + vhalf(), smem + vhalf() * HALF_BYTES);
  }
}
DI void fft_fold_item(const Params& p, int it) {
  const int tid = ltid(), row0 = it * 8;
  for (int e = tid; e < 8 * 4096; e += NT) {
    const int rr = e >> 12, k = e & 4095;
    const bf16_t* __restrict__ src = p.ABTL + (size_t)(row0 + rr) * 8192;
    float v;
    if (k <= 2048) { v = bf2f(src[k]); if (k != 0 && k != 2048) v += bf2f(src[4096 - k]); }
    else { const int kk = k - 2048; v = bf2f(src[4096 + kk]) - bf2f(src[8192 - kk]); }
    p.ABTF[(size_t)(row0 + rr) * 4096 + k] = f2bf(v);
  }
}
DI void phase_qkv(const Params& p, int l, unsigned char* smem, unsigned* ctr) {
  EpiQm eq{p.QM, p.ROPE_M};
  EpiBf16 ekv{p.KV, 512, 1.f, 512};
  volatile int* s_item = (volatile int*)(smem + S_ITEM_OFF);
  for (;;) {
    __syncthreads();
    if (ltid() == 0) *s_item = (int)atomicAdd(ctr, 1u);
    __syncthreads();
    const int t = *s_item;
    if (t >= 864) break;
    if (t < 32 || t >= 736) gla_pass_b(p, l, t < 32 ? t : t - 704);
    else if (t < 160) fft_fold_item(p, t - 32);
    else if (t < 400) { const int u = t - 160, tm = u / 3, tn = u % 3; gemm_tile<2>(p.QLAT, 256, p.WQB, 256, 256, tm * 256, tn * 128, smem, eq); }
    else { const int u = t - 400, tm = u >> 2, tn = u & 3; gemm_tile<2>(p.CKV, 128, p.WKVB, 128, 128, tm * 256, tn * 128, smem, ekv); }
  }
}
DI void phase_mixers(const Params& p, int l, unsigned char* smem, unsigned* ctr, unsigned long long* tc) {
  volatile int* s_item = (volatile int*)(smem + S_ITEM_OFF);
  const int x = lbid() & 7;
  for (;;) {
    __syncthreads();
    if (ltid() == 0) *s_item = (int)atomicAdd(ctr + x, 1u);
    __syncthreads();
    const int u = *s_item;
    if (u >= 172) break;
    volatile unsigned long long* tl = (volatile unsigned long long*)(smem + S_ITEM_OFF + 16);
    if (PROBE_SPIN >= 9 && ltid() == 0) tl[0] = __builtin_amdgcn_s_memrealtime();
    if (u < 8) {
      const int tm = x + 8 * (u >> 2), b = u & 3;
      Epi8Bf16 e{p.MIX + (size_t)(M_CTX + b * 4096) * 1024 + 512, 1024, 1.f / 512.f, 256};
      gemm8_tile(p.TWL, p.ABTF + (size_t)b * 256 * 4096, 4096, tm * 256, 0, smem, e);
    } else if (u < 40) { const int v = u - 8; mla_item(p, l, 1, (x + 8 * (v >> 4)) * 16 + (v & 15), smem); }
    else if (u < 72) { const int v = u - 40; swa_item(p, l, 1, (x + 8 * (v >> 4)) * 16 + (v & 15), smem); }
    else if (u < 136) gla_pass_c(p, l, 2 * (x * 64 + (u - 72)) + vhalf(), smem + vhalf() * HALF_BYTES);
    else if (u < 144) mla_item(p, l, 0, x * 8 + (u - 136), smem);
    else if (u < 152) swa_item(p, l, 0, x * 8 + (u - 144), smem);
    else if (u < 156) {
      const int w = x * 4 + (u - 152), b = w >> 1, tn = w & 1;
      EpiBf16 e{p.MIX + (size_t)(b * 256) * 1024 + 512, 1024, 1.f / 128.f, 256};
      gemm_tile<2>(p.TWC, 512, p.ABTC + (size_t)b * 256 * 512, 512, 512, 0, tn * 128, smem, e);
    } else gla_pass_c(p, l, 1024 + 2 * (x * 16 + (u - 156)) + vhalf(), smem + vhalf() * HALF_BYTES);
    if (PROBE_SPIN >= 9 && ltid() == 0) { const int cat = u < 8 ? 11 : u < 40 ? 9 : u < 72 ? 12 : u < 136 ? 10 : 13; if (cat == PROBE_SPIN) tl[1] += __builtin_amdgcn_s_memrealtime() - tl[0]; }
  }
}

#ifndef PROBE_DBL
#define PROBE_DBL 0
#endif
#define DBL(bit) (((PROBE_DBL) >> (bit)) & 1)
#ifndef ONLY_J
#define ONLY_J -1
#endif
#define EN(x) (ONLY_J < 0 || ONLY_J == (x))
constexpr int PPL = 14, N_PHASES = 2 + 4 * PPL;
constexpr int R_SPLIT = 16384;
#define MKP KP4 kq = kp; asm volatile("" : "+s"(kq)); const Params p = make_params(kq)
DI EwArgs ew_args(const Params& p, int kind, int l, int r_lo, int r_hi, int vb, int nvb) {
  float* Xc = p.X; float* Xl = Xc + (size_t)M_CTX * DM;
  EwArgs a{};
  a.r_lo = r_lo; a.r_hi = r_hi; a.vb = vb; a.nvb = nvb;
  a.xin_ctx = Xc; a.xin_lat = Xl; a.xout_ctx = Xc; a.xout_lat = Xl; a.in_f32 = 1; a.out_f32 = 1; a.F = p.F;
  if (kind == 0) { a.xin_ctx = p.x_prompt; a.xin_lat = p.x_sample; a.in_f32 = 1; a.F = nullptr; a.do_norm = 1; a.ln = 0; a.sc_idx = 1; a.sh_idx = 0; a.gpre_idx = 0; }
  else if (kind == 1) { if (l == 0) { a.xin_ctx = p.x_prompt; a.xin_lat = p.x_sample; a.in_f32 = 1; } a.lu = l; a.gate_idx = 2; a.gpost_idx = 1; a.res_w = 0.5f; a.do_norm = 1; a.ln = l; a.sc_idx = 4; a.sh_idx = 3; a.gpre_idx = 2; }
  else if (kind == 2) { a.lu = l; a.gate_idx = 5; a.gpost_idx = 3; a.res_w = 1.0f; a.do_norm = 1; a.ln = l; a.sc_idx = 7; a.sh_idx = 6; a.gpre_idx = 4; }
  else { a.lu = l; a.gate_idx = 8; a.gpost_idx = 5; a.res_w = 0.5f;
    if (l < 3) { a.do_norm = 1; a.ln = l + 1; a.sc_idx = 1; a.sh_idx = 0; a.gpre_idx = 0; }
    else { a.do_norm = 0; a.out_f32 = 1; a.xout_ctx = p.out + O_YP; a.xout_lat = p.out + O_YS; } }
  return a;
}
DI void run_phase(KP4 kp, int ph, unsigned char* smem, unsigned long long* tc) {
  MKP;
  if (ph == 0) { phase_init(p, smem); return; }
  const int bid = lbid(), nb = gridDim.x;
  const bool g2 = (bid & 7) < 2;
  const int vb2 = (bid >> 3) * 6 + ((bid & 7) - 2), nvb2 = (nb >> 3) * 6;
  int ew_kind = -1, ew_l = 0, ew_lo = 0, ew_hi = M_TOT, ew_vb = bid, ew_nvb = nb;
  if (ph == N_PHASES - 1) { ew_kind = 3; ew_l = 3; ew_lo = R_SPLIT; }
  else {
    const int l = (ph - 1) / PPL, j = (ph - 1) % PPL;
    switch (j) {
      case 0: convert_layer(p, l, smem);
        if (l == 0) { ew_kind = 0; } else { ew_kind = 3; ew_l = l - 1; ew_lo = R_SPLIT; } break;
      case 1: case 11: phase_gemm_gu(p, j == 11 ? 1 : 0, smem); break;
      case 2: case 3: case 12: case 13: {
        const int i = j >= 12 ? 1 : 0, round = j & 1;
        if (round == 0 || g2) phase_gemm_down(p, i, smem, round);
        else { ew_kind = i ? 3 : 1; ew_l = l; ew_hi = R_SPLIT; ew_vb = vb2; ew_nvb = nvb2; }
      } break;
      case 4: ew_kind = 1; ew_l = l; ew_lo = R_SPLIT; break;
      case 5: phase_gemm_win(p, l, smem); break;
      case 6: phase_prep(p, l, smem, (unsigned*)(GAS unsigned*)(kq->ws + OFF_BAR) + 3610 + l); break;
      case 7: phase_qkv(p, l, smem, (unsigned*)(GAS unsigned*)(kq->ws + OFF_BAR) + 3670 + l); break;
      case 8: phase_mixers(p, l, smem, (unsigned*)(GAS unsigned*)(kq->ws + OFF_BAR) + 3620 + l * 8, tc); break;
      case 9: phase_gemm_wout(p, smem); break;
      case 10: ew_kind = 2; ew_l = l; break;
    }
  }
  if (ew_kind >= 0) { const EwArgs a = ew_args(p, ew_kind, ew_l, ew_lo, ew_hi, ew_vb, ew_nvb); phase_ew(p, a); }
}

__global__ void __launch_bounds__(NT, 2) fwd_kernel(PArg pa, int ph_lo, int ph_hi) {
  extern __shared__ __attribute__((aligned(16))) unsigned char smem[];
  KP4 kp = (KP4)__builtin_amdgcn_kernarg_segment_ptr();
#if MULTI_LAUNCH
  unsigned long long tdummy = 0; for (int ph = ph_lo; ph < ph_hi; ++ph) run_phase(kp, ph, smem, &tdummy);
#else
  cg::grid_group grid = cg::this_grid();
  __shared__ uint4 xb_words;
  if (ltid() == 0) { xb_words = make_uint4(0u, 0u, 0u, 0u); if (PROBE_SPIN >= 9) ((volatile unsigned long long*)(smem + S_ITEM_OFF + 16))[1] = 0ull; }
  __syncthreads();
  const XcdBarrier xb = xcd_barrier_post((unsigned*)(pa.ws + OFF_BAR), (volatile LAS unsigned*)&xb_words);
#ifndef PROBE_SPIN
#define PROBE_SPIN 0
#endif
  unsigned long long tacc = 0;
  for (int ph = ph_lo; ph < ph_hi; ++ph) {
    const unsigned long long t0 = PROBE_SPIN ? __builtin_amdgcn_s_memrealtime() : 0ull;
    run_phase(kp, ph, smem, &tacc);
    if (ph + 1 < ph_hi) { if (ph == ph_lo) grid.sync(); else xcd_barrier(xb); }
    if (PROBE_SPIN) {
      const int j = (ph - 1) % PPL;
      const bool lay = ph >= 1 && ph < N_PHASES - 1;
      bool hit = false;
      if (PROBE_SPIN == 1) hit = lay && (j == 1 || j == 11);
      if (PROBE_SPIN == 2) hit = lay && (j == 2 || j == 3 || j == 12 || j == 13);
      if (PROBE_SPIN == 3) hit = ph == 0;
      if (PROBE_SPIN == 4) hit = lay && j == 6;
      if (PROBE_SPIN == 5) hit = lay && j == 8;
      if (PROBE_SPIN == 6) hit = lay && j == 7;
      if (PROBE_SPIN == 7) hit = lay && (j == 5 || j == 9);
      if (PROBE_SPIN == 8) hit = (lay && (j == 0 || j == 4 || j == 10)) || ph == N_PHASES - 1;
      if (hit) tacc += __builtin_amdgcn_s_memrealtime() - t0;
    }
  }
  if (PROBE_SPIN && blockIdx.x == 0 && threadIdx.x == 0) {
    if (PROBE_SPIN >= 9) tacc = ((volatile unsigned long long*)(smem + S_ITEM_OFF + 16))[1];
    const unsigned long long te = __builtin_amdgcn_s_memrealtime();
    while (__builtin_amdgcn_s_memrealtime() - te < tacc * 4ull) __builtin_amdgcn_s_sleep(8);
  }
#endif
}

extern "C" void kernel_launch(void* const* d_in, const int* in_sizes, int n_in, void* d_out, int out_size, void* d_ws, size_t ws_size,
                              hipStream_t stream) {
  PArg p{};
  for (int i = 0; i < 25; ++i) p.in[i] = (const float*)d_in[i];
  p.out = (float*)d_out;
  p.ws = (unsigned char*)d_ws;
  if (WS_NEED > ws_size) { fprintf(stderr, "workspace too small: need %zu have %zu\n", (size_t)WS_NEED, ws_size); return; }
#if MULTI_LAUNCH
  for (int ph = 0; ph < N_PHASES; ++ph) hipLaunchKernelGGL(fwd_kernel, dim3(256), dim3(NT), LDS_TOTAL, stream, p, ph, ph + 1);
#else
  static int grid_blocks = 0;
  if (!grid_blocks) {
    int dev = 0, cus = 0, per_cu = 0;
    (void)hipGetDevice(&dev);
    (void)hipDeviceGetAttribute(&cus, hipDeviceAttributeMultiprocessorCount, dev);
    if (hipFuncSetAttribute((const void*)fwd_kernel, hipFuncAttributeMaxDynamicSharedMemorySize, LDS_TOTAL) != hipSuccess) { fprintf(stderr, "hipFuncSetAttribute failed\n"); grid_blocks = -1; return; }
    (void)hipOccupancyMaxActiveBlocksPerMultiprocessor(&per_cu, fwd_kernel, NT, LDS_TOTAL);
    if (per_cu < 1) fprintf(stderr, "note: occupancy query reports %d blocks per CU\n", per_cu);
    (void)hipGetLastError();
    grid_blocks = cus;
  }
  if (grid_blocks < 0) return;
  (void)hipMemsetAsync((unsigned char*)d_ws + OFF_BAR, 0, 16384, stream);
  int lo = 0, hi = N_PHASES;
  void* args[] = {&p, &lo, &hi};
  hipError_t e = hipLaunchCooperativeKernel((void*)fwd_kernel, dim3(grid_blocks), dim3(NT), args, LDS_TOTAL, stream);
  if (e != hipSuccess) fprintf(stderr, "cooperative launch failed: %s (grid %d)\n", hipGetErrorString(e), grid_blocks);
#endif
}
```

```cpp
#include <hip/hip_runtime.h>
#include <hip/hip_cooperative_groups.h>
#include <cstdio>
#include <cstdint>
namespace cg = cooperative_groups;

#ifndef PROBE_SPIN
#define PROBE_SPIN 0
#endif
#ifndef MULTI_LAUNCH
#define MULTI_LAUNCH 0
#endif

#define DI __device__ __forceinline__
typedef unsigned short bf16_t;
typedef short bf16x8 __attribute__((ext_vector_type(8)));
typedef short bf16x4 __attribute__((ext_vector_type(4)));
typedef float f32x16 __attribute__((ext_vector_type(16)));
typedef unsigned u32x4 __attribute__((ext_vector_type(4)));
typedef unsigned u32x2 __attribute__((ext_vector_type(2)));
#define MFMA32(a, b, c) __builtin_amdgcn_mfma_f32_32x32x16_bf16((a), (b), (c), 0, 0, 0)

constexpr int NT = 512, NW = NT / 64, VT = 256, VW = 4;
constexpr int HALF_BYTES = 61440, S_ITEM_OFF = 131072, LDS_TOTAL = 131072 + 64;
constexpr int DM = 1024, M_CTX = 4096, M_LAT = 16384, M_TOT = 20480, M_EXT = 21504;
constexpr int DFF = 2816, DIN = 2240;
constexpr float EPS = 1e-6f;
constexpr int SMEM_BYTES = 60 * 1024;
constexpr int PITCH = 72;
constexpr int ZQG = 0, ZKG = 256, ZVG = 512, ZRG = 768, ZAF = 1024, ZQS = 1056, ZKS = 1312, ZVS = 1440, ZF = 1568, ZQA = 1824, ZKVA = 2080, ZKR = 2208;
constexpr size_t O_YP = 0, O_YS = 4194304, O_ST = 20971520, O_SK = 23068672, O_SV = 25165824, O_CKV = 27262976, O_KR = 29360128;

struct Params {
  const float *x_prompt, *x_sample, *c, *state_gla, *cache_swa_k, *cache_swa_v, *cache_mla_ckv, *cache_mla_krope, *c_ctx,
      *w_mod, *b_mod, *g_norm, *w_gate, *w_up, *w_down, *w_in, *gla_w_gate, *gla_b_gate, *gla_g_out, *swa_sink, *mla_g_q,
      *mla_g_kv, *w_qb, *w_kvb, *w_out;
  float* out;
  float *X, *F, *MOD, *ROPE_S, *ROPE_M, *GLA_B, *GLA_DL;
  bf16_t *H, *TWL, *TWC, *WGU, *WD, *WIN, *WOUT, *WQB, *WKVB, *ACT, *Z, *QS, *KS, *VS, *CKV, *QLAT, *KR, *QM, *KV, *ABTL,
      *ABTC, *GLA_S, *MIX, *DFTW, *ABTF;
};

constexpr size_t al256(size_t x) { return (x + 255) & ~(size_t)255; }
constexpr size_t OFF_X = 0;
constexpr size_t OFF_H = OFF_X + al256((size_t)M_TOT * DM * 4);
constexpr size_t OFF_MOD = OFF_H + al256((size_t)M_TOT * DM * 2);
constexpr size_t OFF_ROPE_S = OFF_MOD + al256((size_t)4 * 5 * 9216 * 4);
constexpr size_t OFF_ROPE_M = OFF_ROPE_S + al256(64 * 16 * 2 * 4);
constexpr size_t OFF_TWL = OFF_ROPE_M + al256(64 * 8 * 2 * 4);
constexpr size_t OFF_TWC = OFF_TWL + al256((size_t)4096 * 8192 * 2);
constexpr size_t OFF_WGU = OFF_TWC + al256((size_t)256 * 512 * 2);
constexpr size_t OFF_WD = OFF_WGU + al256((size_t)2 * 5632 * 1024 * 2);
constexpr size_t OFF_WIN = OFF_WD + al256((size_t)2 * 1024 * DFF * 2);
constexpr size_t OFF_WOUT = OFF_WIN + al256((size_t)2304 * 1024 * 2);
constexpr size_t OFF_WQB = OFF_WOUT + al256((size_t)1024 * 1024 * 2);
constexpr size_t OFF_WKVB = OFF_WQB + al256((size_t)384 * 256 * 2);
constexpr size_t OFF_Z = OFF_WKVB + al256((size_t)512 * 128 * 2);
constexpr size_t OFF_QS = OFF_Z + al256((size_t)M_TOT * DIN * 2);
constexpr size_t OFF_KS = OFF_QS + al256((size_t)M_TOT * 256 * 2);
constexpr size_t OFF_VS = OFF_KS + al256((size_t)M_EXT * 128 * 2);
constexpr size_t OFF_CKV = OFF_VS + al256((size_t)M_EXT * 128 * 2);
constexpr size_t OFF_QLAT = OFF_CKV + al256((size_t)M_EXT * 128 * 2);
constexpr size_t OFF_KR = OFF_QLAT + al256((size_t)M_TOT * 256 * 2);
constexpr size_t OFF_QM = OFF_KR + al256((size_t)M_EXT * 32 * 2);
constexpr size_t OFF_KV = OFF_QM + al256((size_t)M_TOT * 384 * 2);
constexpr size_t OFF_ABTL = OFF_KV + al256((size_t)M_EXT * 512 * 2);
constexpr size_t OFF_ABTC = OFF_ABTL + al256((size_t)4 * 256 * 8192 * 2);
constexpr size_t OFF_GLA_B = OFF_ABTC + al256((size_t)16 * 256 * 512 * 2);
constexpr size_t OFF_GLA_DL = OFF_GLA_B + al256((size_t)2560 * 4096 * 4);
constexpr size_t OFF_GLA_S = OFF_GLA_DL + al256((size_t)2560 * 64 * 4);
constexpr size_t OFF_MIX = OFF_GLA_S + al256((size_t)2560 * 4096 * 2);
constexpr size_t OFF_BAR = OFF_MIX + al256((size_t)M_TOT * 1024 * 2);
constexpr size_t OFF_DFTW = OFF_BAR + al256(16384);
constexpr size_t OFF_ABTF = OFF_DFTW + al256(128 * 64 * 2);
constexpr size_t OFF_END0 = OFF_ABTF + al256((size_t)4 * 256 * 4096 * 2);
constexpr size_t OFF_ACTEND = OFF_QS + al256((size_t)M_TOT * DFF * 2);
constexpr size_t WS_NEED = OFF_END0 > OFF_ACTEND ? OFF_END0 : OFF_ACTEND;
struct PArg { const float* in[25]; float* out; unsigned char* ws; };
#define GAS __attribute__((address_space(1)))
struct PArgG { GAS const float* in[25]; GAS float* out; GAS unsigned char* ws; };
typedef const __attribute__((address_space(4))) PArgG* KP4;
DI Params make_params(KP4 ap) {
  Params p;
  p.x_prompt = (const float*)ap->in[0];
  p.x_sample = (const float*)ap->in[1];
  p.c = (const float*)ap->in[2];
  p.state_gla = (const float*)ap->in[3];
  p.cache_swa_k = (const float*)ap->in[4];
  p.cache_swa_v = (const float*)ap->in[5];
  p.cache_mla_ckv = (const float*)ap->in[6];
  p.cache_mla_krope = (const float*)ap->in[7];
  p.c_ctx = (const float*)ap->in[8];
  p.w_mod = (const float*)ap->in[9];
  p.b_mod = (const float*)ap->in[10];
  p.g_norm = (const float*)ap->in[11];
  p.w_gate = (const float*)ap->in[12];
  p.w_up = (const float*)ap->in[13];
  p.w_down = (const float*)ap->in[14];
  p.w_in = (const float*)ap->in[15];
  p.gla_w_gate = (const float*)ap->in[16];
  p.gla_b_gate = (const float*)ap->in[17];
  p.gla_g_out = (const float*)ap->in[18];
  p.swa_sink = (const float*)ap->in[19];
  p.mla_g_q = (const float*)ap->in[20];
  p.mla_g_kv = (const float*)ap->in[21];
  p.w_qb = (const float*)ap->in[22];
  p.w_kvb = (const float*)ap->in[23];
  p.w_out = (const float*)ap->in[24];
  p.out = (float*)ap->out;
  p.X = (float*)(GAS float*)(ap->ws + OFF_X);
  p.H = (bf16_t*)(GAS bf16_t*)(ap->ws + OFF_H);
  p.MOD = (float*)(GAS float*)(ap->ws + OFF_MOD);
  p.ROPE_S = (float*)(GAS float*)(ap->ws + OFF_ROPE_S);
  p.ROPE_M = (float*)(GAS float*)(ap->ws + OFF_ROPE_M);
  p.TWL = (bf16_t*)(GAS bf16_t*)(ap->ws + OFF_TWL);
  p.TWC = (bf16_t*)(GAS bf16_t*)(ap->ws + OFF_TWC);
  p.WGU = (bf16_t*)(GAS bf16_t*)(ap->ws + OFF_WGU);
  p.WD = (bf16_t*)(GAS bf16_t*)(ap->ws + OFF_WD);
  p.WIN = (bf16_t*)(GAS bf16_t*)(ap->ws + OFF_WIN);
  p.WOUT = (bf16_t*)(GAS bf16_t*)(ap->ws + OFF_WOUT);
  p.WQB = (bf16_t*)(GAS bf16_t*)(ap->ws + OFF_WQB);
  p.WKVB = (bf16_t*)(GAS bf16_t*)(ap->ws + OFF_WKVB);
  p.Z = (bf16_t*)(GAS bf16_t*)(ap->ws + OFF_Z);
  p.QS = (bf16_t*)(GAS bf16_t*)(ap->ws + OFF_QS);
  p.KS = (bf16_t*)(GAS bf16_t*)(ap->ws + OFF_KS);
  p.VS = (bf16_t*)(GAS bf16_t*)(ap->ws + OFF_VS);
  p.CKV = (bf16_t*)(GAS bf16_t*)(ap->ws + OFF_CKV);
  p.QLAT = (bf16_t*)(GAS bf16_t*)(ap->ws + OFF_QLAT);
  p.KR = (bf16_t*)(GAS bf16_t*)(ap->ws + OFF_KR);
  p.QM = (bf16_t*)(GAS bf16_t*)(ap->ws + OFF_QM);
  p.KV = (bf16_t*)(GAS bf16_t*)(ap->ws + OFF_KV);
  p.ABTL = (bf16_t*)(GAS bf16_t*)(ap->ws + OFF_ABTL);
  p.ABTC = (bf16_t*)(GAS bf16_t*)(ap->ws + OFF_ABTC);
  p.GLA_B = (float*)(GAS float*)(ap->ws + OFF_GLA_B);
  p.GLA_DL = (float*)(GAS float*)(ap->ws + OFF_GLA_DL);
  p.GLA_S = (bf16_t*)(GAS bf16_t*)(ap->ws + OFF_GLA_S);
  p.MIX = (bf16_t*)(GAS bf16_t*)(ap->ws + OFF_MIX);
  p.DFTW = (bf16_t*)(GAS bf16_t*)(ap->ws + OFF_DFTW);
  p.ABTF = (bf16_t*)(GAS bf16_t*)(ap->ws + OFF_ABTF);
  p.F = (float*)(GAS float*)(ap->ws + OFF_Z);
  p.ACT = (bf16_t*)(GAS bf16_t*)(ap->ws + OFF_QS);
  return p;
}

DI int ltid() { int t = __builtin_amdgcn_workitem_id_x(); asm volatile("" : "+v"(t)); return t; }
DI int vtid() { return ltid() & 255; }
DI int vhalf() { return ltid() >> 8; }
DI int lbid() { int t = __builtin_amdgcn_workgroup_id_x(); asm volatile("" : "+s"(t)); return t; }
typedef float f32x2_t __attribute__((ext_vector_type(2)));
typedef __bf16 bf16x2_t __attribute__((ext_vector_type(2)));
DI bf16_t f2bf(float x) { return __builtin_bit_cast(bf16_t, (__bf16)x); }
DI float bf2f(bf16_t b) { return __uint_as_float(((unsigned)b) << 16); }
DI unsigned pack2(float a, float b) { f32x2_t v = {a, b}; return __builtin_bit_cast(unsigned, __builtin_convertvector(v, bf16x2_t)); }
DI float shx(float v, int o) { const int ln = ltid() & 63; return __int_as_float(__builtin_amdgcn_ds_bpermute((ln ^ o) << 2, __float_as_int(v))); }
DI float wave_sum(float v) {
#pragma unroll
  for (int o = 32; o > 0; o >>= 1) v += shx(v, o);
  return v;
}
DI float silu_f(float x) { return x * __builtin_amdgcn_rcpf(1.f + __builtin_amdgcn_exp2f(-1.4426950408889634f * x)); }
DI int crow(int r, int h) { return (r & 3) + 8 * (r >> 2) + 4 * h; }


#define XB_TMO      128
#define XB_XCNT(j)  (256  + 64 * (j))
#define XB_XSUB(j)  (1280 + 64 * (j))
#define XB_XGEN(j)  (2304 + 64 * (j))
#define XB_TOP      3328
#define XB_TOPGEN   3392
#define XCD_BAR_WORDS 3456
#define XB_SPIN_CAP (1u << 22)
#define LAS __attribute__((address_space(3)))
DI unsigned xb_ld(unsigned* p) { return __hip_atomic_load(p, __ATOMIC_RELAXED, __HIP_MEMORY_SCOPE_AGENT); }
DI unsigned xb_add(unsigned* p, unsigned v) { return __hip_atomic_fetch_add(p, v, __ATOMIC_RELAXED, __HIP_MEMORY_SCOPE_AGENT); }
DI unsigned xb_xcc_id() { return (unsigned)__builtin_amdgcn_s_getreg((3 << 11) | 20) & 0xFu; }
#define XB_SPIN(cond, bar) do { unsigned _sp = 0; while (cond) { __builtin_amdgcn_s_sleep(1); \
    if ((++_sp & 255u) == 0u) { if (xb_ld(&(bar)[XB_TMO])) break; if (_sp > XB_SPIN_CAP) { atomicAdd(&(bar)[XB_TMO], 1u); break; } } } } while (0)
struct XcdBarrier { unsigned* bar; unsigned x; volatile LAS unsigned* st; };
DI XcdBarrier xcd_barrier_post(unsigned* bar, volatile LAS unsigned* st) {
  XcdBarrier b; b.bar = bar; b.x = xb_xcc_id(); b.st = st;
  if (ltid() == 0) (void)xb_add(&bar[XB_XCNT(b.x)], 1u);
  return b;
}
DI void xcd_barrier_complete(unsigned* bar, unsigned x, unsigned& nloc, unsigned& nx) {
  const unsigned G = gridDim.x * gridDim.y * gridDim.z;
  unsigned sum, cnt, mine, sp = 0u;
  for (;;) {
    sum = 0u; cnt = 0u; mine = 0u;
#pragma unroll
    for (unsigned j = 0; j < 16; ++j) { const unsigned c = xb_ld(&bar[XB_XCNT(j)]); sum += c; cnt += (c > 0u) ? 1u : 0u; mine = (j == x) ? c : mine; }
    if (sum == G) break;
    __builtin_amdgcn_s_sleep(1);
    if ((++sp & 255u) == 0u) { if (xb_ld(&bar[XB_TMO])) break; if (sp > XB_SPIN_CAP) { atomicAdd(&bar[XB_TMO], 1u); break; } }
  }
  nloc = mine > 0u ? mine : 1u; nx = cnt > 0u ? cnt : 1u;
}
DI void xcd_barrier(const XcdBarrier& b) {
  asm volatile("s_waitcnt vmcnt(0)" ::: "memory");
  __syncthreads();
  if (ltid() == 0) {
    unsigned* bar = b.bar;
    __builtin_amdgcn_s_waitcnt(0);
    unsigned nloc = b.st[0], nx = b.st[1];
    if (nloc == 0u) { xcd_barrier_complete(bar, b.x, nloc, nx); b.st[0] = nloc; b.st[1] = nx; }
    const unsigned old = xb_add(&bar[XB_XSUB(b.x)], 1u);
    const unsigned gen = old / nloc;
    if (old + 1u == (gen + 1u) * nloc) {
      __builtin_amdgcn_fence(__ATOMIC_RELEASE, "agent");
      asm volatile("s_waitcnt vmcnt(0)" ::: "memory");
      const unsigned og = xb_add(&bar[XB_TOP], 1u);
      const unsigned tg = og / nx;
      if (og + 1u == (tg + 1u) * nx) xb_add(&bar[XB_TOPGEN], 1u);
      else XB_SPIN(xb_ld(&bar[XB_TOPGEN]) == tg, bar);
      __builtin_amdgcn_fence(__ATOMIC_ACQUIRE, "agent");
      xb_add(&bar[XB_XGEN(b.x)], 1u);
      asm volatile("s_waitcnt vmcnt(0)" ::: "memory");
    } else {
      XB_SPIN(xb_ld(&bar[XB_XGEN(b.x)]) == gen, bar);
      __builtin_amdgcn_fence(__ATOMIC_ACQUIRE, "agent");
      asm volatile("s_waitcnt vmcnt(0)" ::: "memory");
    }
  }
  __syncthreads();
}

template <int MB, class Epi>
DI void gemm_tile(const bf16_t* __restrict__ A, int lda, const bf16_t* __restrict__ Bt, int ldb, int K, int m0, int n0,
                  unsigned char* smem, const Epi& epi) {
  constexpr int BMR = 128 * MB, NA = 2 * MB;
  bf16_t* sA = (bf16_t*)smem;
  bf16_t* sB = sA + BMR * PITCH;
  const int tid = ltid(), lane = tid & 63, wid = tid >> 6, wm = wid >> 1, wn = wid & 1, l31 = lane & 31, h = lane >> 5;
  f32x16 acc[2][MB];
#pragma unroll
  for (int a = 0; a < 2; ++a)
#pragma unroll
    for (int b = 0; b < MB; ++b)
#pragma unroll
      for (int i = 0; i < 16; ++i) acc[a][b][i] = 0.f;
  const int lrow = tid >> 3, lkc = tid & 7;
  const bf16_t* Ap = A + (size_t)(m0 + lrow) * lda + lkc * 8;
  const bf16_t* Bp = Bt + (size_t)(n0 + lrow) * ldb + lkc * 8;
  const size_t sa32 = (size_t)64 * lda, sb32 = (size_t)64 * ldb;
  bf16_t* wA = sA + lrow * PITCH + lkc * 8;
  bf16_t* wB = sB + lrow * PITCH + lkc * 8;
  u32x4 ra[NA], rb[2];
#pragma unroll
  for (int i = 0; i < NA; ++i) ra[i] = *(const u32x4*)(Ap + i * sa32);
#pragma unroll
  for (int i = 0; i < 2; ++i) rb[i] = *(const u32x4*)(Bp + i * sb32);
  for (int k0 = 0; k0 < K; k0 += 64) {
    __syncthreads();
#pragma unroll
    for (int i = 0; i < NA; ++i) *(u32x4*)(wA + i * 64 * PITCH) = ra[i];
#pragma unroll
    for (int i = 0; i < 2; ++i) *(u32x4*)(wB + i * 64 * PITCH) = rb[i];
    __syncthreads();
    {
      const int kn = (k0 + 64 < K) ? k0 + 64 : k0;
#pragma unroll
      for (int i = 0; i < NA; ++i) ra[i] = *(const u32x4*)(Ap + kn + i * sa32);
#pragma unroll
      for (int i = 0; i < 2; ++i) rb[i] = *(const u32x4*)(Bp + kn + i * sb32);
    }
#pragma unroll
    for (int ks = 0; ks < 4; ++ks) {
      bf16x8 af[MB], bfr[2];
#pragma unroll
      for (int b = 0; b < MB; ++b) af[b] = *(const bf16x8*)(sA + (wm * 32 * MB + b * 32 + l31) * PITCH + ks * 16 + h * 8);
#pragma unroll
      for (int b = 0; b < 2; ++b) bfr[b] = *(const bf16x8*)(sB + (wn * 64 + b * 32 + l31) * PITCH + ks * 16 + h * 8);

#pragma unroll
      for (int nb = 0; nb < 2; ++nb)
#pragma unroll
        for (int mb = 0; mb < MB; ++mb) acc[nb][mb] = MFMA32(bfr[nb], af[mb], acc[nb][mb]);

    }
  }
  epi(acc, m0 + wm * 32 * MB, n0 + wn * 64, l31, h);
}

struct EpiF32 {
  float* C; int ldc;
  template <int MB> DI void operator()(const f32x16 (&acc)[2][MB], int mb0, int nb0, int l31, int h) const {
#pragma unroll
    for (int nb = 0; nb < 2; ++nb)
#pragma unroll
      for (int mb = 0; mb < MB; ++mb) {
        float* row = C + (size_t)(mb0 + mb * 32 + l31) * ldc + nb0 + nb * 32 + 4 * h;
#pragma unroll
        for (int g = 0; g < 4; ++g)
          *(float4*)(row + 8 * g) = make_float4(acc[nb][mb][4 * g], acc[nb][mb][4 * g + 1], acc[nb][mb][4 * g + 2], acc[nb][mb][4 * g + 3]);
      }
  }
};
struct EpiBf16 {
  bf16_t* C; int ldc; float scale; int ncols;
  template <int MB> DI void operator()(const f32x16 (&acc)[2][MB], int mb0, int nb0, int l31, int h) const {
#pragma unroll
    for (int nb = 0; nb < 2; ++nb)
#pragma unroll
      for (int mb = 0; mb < MB; ++mb) {
        const int col0 = nb0 + nb * 32 + 4 * h;
        bf16_t* row = C + (size_t)(mb0 + mb * 32 + l31) * ldc + col0;
#pragma unroll
        for (int g = 0; g < 4; ++g) {
          if (col0 + 8 * g < ncols) {
            uint2 w;
            w.x = pack2(acc[nb][mb][4 * g] * scale, acc[nb][mb][4 * g + 1] * scale);
            w.y = pack2(acc[nb][mb][4 * g + 2] * scale, acc[nb][mb][4 * g + 3] * scale);
            *(uint2*)(row + 8 * g) = w;
          }
        }
      }
  }
};
struct EpiGateUp {
  bf16_t* C;
  template <int MB> DI void operator()(const f32x16 (&acc)[2][MB], int mb0, int nb0, int l31, int h) const {
#pragma unroll
    for (int mb = 0; mb < MB; ++mb) {
      bf16_t* row = C + (size_t)(mb0 + mb * 32 + l31) * DFF + (nb0 >> 1) + 4 * h;
#pragma unroll
      for (int g = 0; g < 4; ++g) {
        float v[4];
#pragma unroll
        for (int i = 0; i < 4; ++i) v[i] = silu_f(acc[0][mb][4 * g + i]) * acc[1][mb][4 * g + i];
        uint2 w; w.x = pack2(v[0], v[1]); w.y = pack2(v[2], v[3]);
        *(uint2*)(row + 8 * g) = w;
      }
    }
  }
};
struct EpiWin {
  bf16_t* Z; float* out; int l;
  template <int MB> DI void operator()(const f32x16 (&acc)[2][MB], int mb0, int nb0, int l31, int h) const {
#pragma unroll
    for (int nb = 0; nb < 2; ++nb)
#pragma unroll
      for (int mb = 0; mb < MB; ++mb) {
        const int m = mb0 + mb * 32 + l31;
        const int col0 = nb0 + nb * 32 + 4 * h;
        bf16_t* row = Z + (size_t)m * DIN + col0;
#pragma unroll
        for (int g = 0; g < 4; ++g) {
          const int col = col0 + 8 * g;
          if (col < DIN) {
            uint2 w;
            w.x = pack2(acc[nb][mb][4 * g], acc[nb][mb][4 * g + 1]);
            w.y = pack2(acc[nb][mb][4 * g + 2], acc[nb][mb][4 * g + 3]);
            *(uint2*)(row + 8 * g) = w;
            if (m < M_CTX) {
              const int b = m >> 8, s = m & 255;
              const size_t tok = (size_t)((b * 4 + l) * 256 + s);
              float* dst = nullptr;
              if (col >= ZKS && col < ZVS) dst = out + O_SK + tok * 128 + (col - ZKS);
              else if (col >= ZVS && col < ZF) dst = out + O_SV + tok * 128 + (col - ZVS);
              else if (col >= ZKR) dst = out + O_KR + tok * 32 + (col - ZKR);
              if (dst) *(float4*)dst = make_float4(acc[nb][mb][4 * g], acc[nb][mb][4 * g + 1], acc[nb][mb][4 * g + 2], acc[nb][mb][4 * g + 3]);
            }
          }
        }
      }
  }
};
struct EpiQm {
  bf16_t* C; const float* rope_m;
  template <int MB> DI void operator()(const f32x16 (&acc)[2][MB], int mb0, int nb0, int l31, int h) const {
#pragma unroll
    for (int nb = 0; nb < 2; ++nb) {
      const int cb = nb0 + nb * 32;
      const bool isrope = ((cb >> 5) % 3) == 2;
#pragma unroll
      for (int mb = 0; mb < MB; ++mb) {
        const int m = mb0 + mb * 32 + l31;
        float v[16];
#pragma unroll
        for (int i = 0; i < 16; ++i) v[i] = acc[nb][mb][i];
        if (isrope && m >= M_CTX) {
          const int t = (m - M_CTX) & 4095;
          const int prow = t >> 6, pcol = t & 63;
#pragma unroll
          for (int half = 0; half < 2; ++half) {
            const int pos = half ? pcol : prow;
#pragma unroll
            for (int i = 0; i < 4; ++i) {
              const int j = 4 * h + i;
              const float cs = rope_m[(pos * 8 + j) * 2], sn = rope_m[(pos * 8 + j) * 2 + 1];
              const float x1 = v[8 * half + i], x2 = v[8 * half + 4 + i];
              v[8 * half + i] = x1 * cs - x2 * sn;
              v[8 * half + 4 + i] = x2 * cs + x1 * sn;
            }
          }
        }
        bf16_t* row = C + (size_t)m * 384 + cb + 4 * h;
#pragma unroll
        for (int g = 0; g < 4; ++g) {
          uint2 w; w.x = pack2(v[4 * g], v[4 * g + 1]); w.y = pack2(v[4 * g + 2], v[4 * g + 3]);
          *(uint2*)(row + 8 * g) = w;
        }
      }
    }
  }
};

struct EpiDft {
  bf16_t* ABTL; bf16_t* ABTC; int g;
  template <int MB> DI void operator()(const f32x16 (&acc)[2][MB], int mb0, int nb0, int l31, int h) const {
    const int type = nb0 >> 6;
#pragma unroll
    for (int mb = 0; mb < MB; ++mb) {
      const int m = mb0 + mb * 32 + l31;
      bf16_t* base; size_t stride;
      if (m >= M_CTX) { const int b = (m - M_CTX) >> 12, sq = (m - M_CTX) & 4095; base = ABTL + ((size_t)b * 256 + g * 64) * 8192 + type * 4096 + sq; stride = 8192; }
      else { const int b = m >> 8, sq = m & 255; base = ABTC + ((size_t)b * 256 + g * 64) * 512 + type * 256 + sq; stride = 512; }
#pragma unroll
      for (int nb = 0; nb < 2; ++nb)
#pragma unroll
        for (int i = 0; i < 16; ++i) base[(size_t)(nb * 32 + crow(i, h)) * stride] = f2bf(acc[nb][mb][i]);
    }
  }
};


typedef float f32x4v __attribute__((ext_vector_type(4)));
DI int g8_lds_byte(int r, int c) { const int st = (r >> 4) * 2 + (c >> 5), rr = r & 15, cc = c & 31, ob = rr * 64 + cc * 2; return st * 1024 + (ob ^ (((ob >> 9) & 1) << 5)); }
DI void g8_stage_rc(int b, int& R, int& C) { const int st = b / 1024, sb = b % 1024, swz = sb ^ (((sb >> 9) & 1) << 5); R = (st >> 1) * 16 + swz / 64; C = (st & 1) * 32 + (swz % 64) / 2; }
DI const char* uni_ptr(const void* p) { const unsigned long long v = (unsigned long long)p; const unsigned lo = __builtin_amdgcn_readfirstlane((unsigned)v), hi = __builtin_amdgcn_readfirstlane((unsigned)(v >> 32)); return (const char*)(((unsigned long long)hi << 32) | lo); }
template <class Epi>
DI void gemm8_tile(const bf16_t* __restrict__ A, const bf16_t* __restrict__ Bt, int K, int brow, int bcol, unsigned char* smem, const Epi& epi,
                   bool first = true, bool has_next = false, int nbrow = 0, int nbcol = 0) {
  constexpr int HTB = 16384;
  const int tid = ltid(), wid = tid >> 6, lane = tid & 63, wr = wid >> 2, wc = wid & 3, fr = lane & 15, fq = lane >> 4;
  int sr0, sc0, sr1, sc1;
  g8_stage_rc(tid * 16, sr0, sc0); g8_stage_rc(tid * 16 + 8192, sr1, sc1);
  const unsigned bo0 = (unsigned)(sr0 * K + sc0) * 2u;
  const int swz_ = (fr * 64 + fq * 16) ^ ((((fr * 64 + fq * 16) >> 9) & 1) << 5);
  const int aoff = wr * 8192 + swz_, boff = wc * 4096 + swz_;
#define G8_SA(b, h) (smem + ((b) * 2 + (h)) * HTB)
#define G8_SB(b, h) (smem + (4 + (b) * 2 + (h)) * HTB)
#define G8_STAGE(P, BASE, br, kt) do { const char* _g = uni_ptr((BASE) + (size_t)(br) * K + (size_t)(kt) * 64); \
    const char* _g2 = uni_ptr(_g + (size_t)128 * K); \
    __builtin_amdgcn_global_load_lds((const unsigned*)(_g + bo0), (unsigned*)((P) + tid * 16), 16, 0, 0); \
    __builtin_amdgcn_global_load_lds((const unsigned*)(_g2 + bo0), (unsigned*)((P) + tid * 16 + 8192), 16, 0, 0); } while (0)
#define G8_LDA(dst, b, h) _Pragma("unroll") for (int m = 0; m < 4; ++m) _Pragma("unroll") for (int k = 0; k < 2; ++k) \
    dst[m][k] = *(const bf16x8*)(G8_SA(b, h) + aoff + m * 2048 + k * 1024)
#define G8_LDB(dst, b, h) _Pragma("unroll") for (int n = 0; n < 2; ++n) _Pragma("unroll") for (int k = 0; k < 2; ++k) \
    dst[n][k] = *(const bf16x8*)(G8_SB(b, h) + boff + n * 2048 + k * 1024)
#define G8_MMA(ai, bj, At_, Bx_) do { __builtin_amdgcn_s_setprio(1); \
    _Pragma("unroll") for (int m = 0; m < 4; ++m) _Pragma("unroll") for (int n = 0; n < 2; ++n) _Pragma("unroll") for (int k = 0; k < 2; ++k) \
      acc[ai][bj][m][n] = __builtin_amdgcn_mfma_f32_16x16x32_bf16(Bx_[n][k], At_[m][k], acc[ai][bj][m][n], 0, 0, 0); \
    __builtin_amdgcn_s_setprio(0); } while (0)
#define G8_WAIT_V(n) asm volatile("s_waitcnt vmcnt(" #n ")" ::: "memory")
#define G8_WAIT_L(n) asm volatile("s_waitcnt lgkmcnt(" #n ")" ::: "memory")
#define G8_BAR __builtin_amdgcn_s_barrier()
#define G8_SCHED __builtin_amdgcn_sched_barrier(0)
  f32x4v acc[2][2][4][2];
#pragma unroll
  for (int a = 0; a < 2; ++a)
#pragma unroll
    for (int b = 0; b < 2; ++b)
#pragma unroll
      for (int m = 0; m < 4; ++m)
#pragma unroll
        for (int n = 0; n < 2; ++n) acc[a][b][m][n] = (f32x4v){0.f, 0.f, 0.f, 0.f};
  bf16x8 At[4][2], B0[2][2], B1[2][2];
  const int nt = K / 64;
  if (first) {
    G8_WAIT_V(0);
    __syncthreads();
    G8_STAGE(G8_SB(0, 0), Bt, bcol, 0); G8_STAGE(G8_SA(0, 0), A, brow, 0);
    G8_STAGE(G8_SB(0, 1), Bt, bcol + 128, 0); G8_STAGE(G8_SA(0, 1), A, brow + 128, 0);
  }
  if (wr == 1) G8_BAR;
  G8_WAIT_V(4); G8_BAR;
  G8_STAGE(G8_SB(1, 0), Bt, bcol, 1); G8_STAGE(G8_SA(1, 0), A, brow, 1); G8_STAGE(G8_SB(1, 1), Bt, bcol + 128, 1);
  G8_WAIT_V(6); G8_BAR;
  for (int t = 0; t < nt - 2; t += 2) {
    G8_LDB(B0, 0, 0); G8_SCHED; G8_LDA(At, 0, 0); G8_STAGE(G8_SA(1, 1), A, brow + 128, t + 1);
    G8_WAIT_L(8); G8_BAR; G8_WAIT_L(0); G8_MMA(0, 0, At, B0); G8_BAR; G8_SCHED;
    G8_LDB(B1, 0, 1); G8_STAGE(G8_SB(0, 0), Bt, bcol, t + 2);
    G8_BAR; G8_WAIT_L(0); G8_MMA(0, 1, At, B1); G8_BAR;
    G8_LDA(At, 0, 1); G8_STAGE(G8_SA(0, 0), A, brow, t + 2);
    G8_BAR; G8_WAIT_L(0); G8_MMA(1, 0, At, B0); G8_BAR; G8_SCHED;
    G8_STAGE(G8_SB(0, 1), Bt, bcol + 128, t + 2);
    G8_WAIT_V(6); G8_BAR; G8_MMA(1, 1, At, B1); G8_BAR;
    G8_LDB(B0, 1, 0); G8_SCHED; G8_LDA(At, 1, 0); G8_STAGE(G8_SA(0, 1), A, brow + 128, t + 2);
    G8_WAIT_L(8); G8_BAR; G8_WAIT_L(0); G8_MMA(0, 0, At, B0); G8_BAR; G8_SCHED;
    G8_LDB(B1, 1, 1); G8_STAGE(G8_SB(1, 0), Bt, bcol, t + 3);
    G8_BAR; G8_WAIT_L(0); G8_MMA(0, 1, At, B1); G8_BAR;
    G8_LDA(At, 1, 1); G8_STAGE(G8_SA(1, 0), A, brow, t + 3);
    G8_BAR; G8_WAIT_L(0); G8_MMA(1, 0, At, B0); G8_BAR; G8_SCHED;
    G8_STAGE(G8_SB(1, 1), Bt, bcol + 128, t + 3);
    G8_WAIT_V(6); G8_BAR; G8_MMA(1, 1, At, B1); G8_BAR;
  }
  { G8_LDB(B0, 0, 0); G8_LDA(At, 0, 0); G8_STAGE(G8_SA(1, 1), A, brow + 128, nt - 1);
    G8_BAR; G8_WAIT_L(0); G8_MMA(0, 0, At, B0); G8_BAR;
    G8_LDB(B1, 0, 1); G8_BAR; G8_WAIT_L(0); G8_MMA(0, 1, At, B1); G8_BAR;
    G8_LDA(At, 0, 1); G8_WAIT_V(4); G8_BAR; G8_WAIT_L(0); G8_MMA(1, 0, At, B0); G8_MMA(1, 1, At, B1); G8_BAR; }
  { G8_LDB(B0, 1, 0); G8_LDA(At, 1, 0); G8_WAIT_V(2); G8_BAR; G8_WAIT_L(0); G8_MMA(0, 0, At, B0); G8_BAR;
    G8_LDB(B1, 1, 1); G8_WAIT_V(0); G8_BAR; G8_WAIT_L(0); G8_MMA(0, 1, At, B1); G8_BAR;
    G8_LDA(At, 1, 1); G8_BAR; G8_WAIT_L(0); G8_MMA(1, 0, At, B0); G8_MMA(1, 1, At, B1); G8_BAR; }
  if (wr == 0) G8_BAR;
  if (has_next) {
    G8_STAGE(G8_SB(0, 0), Bt, nbcol, 0); G8_STAGE(G8_SA(0, 0), A, nbrow, 0);
    G8_STAGE(G8_SB(0, 1), Bt, nbcol + 128, 0); G8_STAGE(G8_SA(0, 1), A, nbrow + 128, 0);
  }
  epi(acc, brow, bcol);
}
struct Epi8Bf16 {
  bf16_t* C; int ldc; float scale; int ncols;
  DI void operator()(const f32x4v (&acc)[2][2][4][2], int brow, int bcol) const {
    const int tid_ = ltid(), wid_ = tid_ >> 6, wr = wid_ >> 2, wc = wid_ & 3, fr = tid_ & 15, fq = (tid_ & 63) >> 4;
#pragma unroll
    for (int ai = 0; ai < 2; ++ai)
#pragma unroll
      for (int m = 0; m < 4; ++m) {
        bf16_t* row = C + (size_t)(brow + ai * 128 + wr * 64 + m * 16 + fr) * ldc;
#pragma unroll
        for (int bj = 0; bj < 2; ++bj)
#pragma unroll
          for (int n = 0; n < 2; ++n) {
            const int col = bcol + bj * 128 + wc * 32 + n * 16 + 4 * fq;
            if (col < ncols) {
              const f32x4v v = acc[ai][bj][m][n];
              u32x2 w; w[0] = pack2(v[0] * scale, v[1] * scale); w[1] = pack2(v[2] * scale, v[3] * scale);
              *(u32x2*)(row + col) = w;
            }
          }
      }
  }
};
struct Epi8GateUp {
  bf16_t* C;
  DI void operator()(const f32x4v (&acc)[2][2][4][2], int brow, int bcol) const {
    const int tid_ = ltid(), wid_ = tid_ >> 6, wr = wid_ >> 2, wc = wid_ & 3, fr = tid_ & 15, fq = (tid_ & 63) >> 4;
#pragma unroll
    for (int ai = 0; ai < 2; ++ai)
#pragma unroll
      for (int m = 0; m < 4; ++m) {
        bf16_t* row = C + (size_t)(brow + ai * 128 + wr * 64 + m * 16 + fr) * DFF;
#pragma unroll
        for (int bj = 0; bj < 2; ++bj) {
          const int col = ((bcol + bj * 128 + wc * 32) >> 1) + 4 * fq;
          const f32x4v g = acc[ai][bj][m][0], u = acc[ai][bj][m][1];
          u32x2 w; w[0] = pack2(silu_f(g[0]) * u[0], silu_f(g[1]) * u[1]); w[1] = pack2(silu_f(g[2]) * u[2], silu_f(g[3]) * u[3]);
          *(u32x2*)(row + col) = w;
        }
      }
  }
};
struct Epi8Win {
  bf16_t* Z; float* out; int l;
  DI void operator()(const f32x4v (&acc)[2][2][4][2], int brow, int bcol) const {
    const int tid_ = ltid(), wid_ = tid_ >> 6, wr = wid_ >> 2, wc = wid_ & 3, fr = tid_ & 15, fq = (tid_ & 63) >> 4;
#pragma unroll
    for (int ai = 0; ai < 2; ++ai)
#pragma unroll
      for (int m = 0; m < 4; ++m) {
        const int mrow = brow + ai * 128 + wr * 64 + m * 16 + fr;
        bf16_t* row = Z + (size_t)mrow * DIN;
#pragma unroll
        for (int bj = 0; bj < 2; ++bj)
#pragma unroll
          for (int n = 0; n < 2; ++n) {
            const int col = bcol + bj * 128 + wc * 32 + n * 16 + 4 * fq;
            if (col < DIN) {
              const f32x4v v = acc[ai][bj][m][n];
              u32x2 w; w[0] = pack2(v[0], v[1]); w[1] = pack2(v[2], v[3]);
              *(u32x2*)(row + col) = w;
              if (mrow < M_CTX) {
                const int b = mrow >> 8, sq = mrow & 255;
                const size_t tok = (size_t)((b * 4 + l) * 256 + sq);
                float* dst = nullptr;
                if (col >= ZKS && col < ZVS) dst = out + O_SK + tok * 128 + (col - ZKS);
                else if (col >= ZVS && col < ZF) dst = out + O_SV + tok * 128 + (col - ZVS);
                else if (col >= ZKR) dst = out + O_KR + tok * 32 + (col - ZKR);
                if (dst) *(float4*)dst = make_float4(v[0], v[1], v[2], v[3]);
              }
            }
          }
      }
  }
};

DI void mod_item(const Params& p, int it, unsigned char* smem) {
  float* sc = (float*)smem;
  float* red = sc + 5 * 1024;
  const int tid = vtid(), lane = tid & 63, wid = tid >> 6;
  const int l = it / 144, n = (it % 144) * 64 + lane;
  __syncthreads();
  for (int e = tid; e < 5 * 1024; e += VT) {
    const int i = e >> 10, k = e & 1023;
    const float v = i == 0 ? p.c_ctx[k] : p.c[(i - 1) * 1024 + k];
    sc[e] = v / (1.f + expf(-v));
  }
  __syncthreads();
  float a0 = 0, a1 = 0, a2 = 0, a3 = 0, a4 = 0;
  const float* w = p.w_mod + ((size_t)l * 1024 + wid * 256) * 9216 + n;
#pragma unroll 32
  for (int k = 0; k < 256; ++k) {
    const float wv = w[(size_t)k * 9216];
    const int kk = wid * 256 + k;
    a0 += sc[kk] * wv; a1 += sc[1024 + kk] * wv; a2 += sc[2048 + kk] * wv; a3 += sc[3072 + kk] * wv; a4 += sc[4096 + kk] * wv;
  }
  red[(wid * 5 + 0) * 64 + lane] = a0; red[(wid * 5 + 1) * 64 + lane] = a1; red[(wid * 5 + 2) * 64 + lane] = a2;
  red[(wid * 5 + 3) * 64 + lane] = a3; red[(wid * 5 + 4) * 64 + lane] = a4;
  __syncthreads();
  for (int e = tid; e < 320; e += VT) {
    const int i = e >> 6, cl = e & 63;
    float s = 0.f;
    for (int w4 = 0; w4 < 4; ++w4) s += red[(w4 * 5 + i) * 64 + cl];
    const int col = (it % 144) * 64 + cl;
    p.MOD[(size_t)(l * 5 + i) * 9216 + col] = s + p.b_mod[(size_t)l * 9216 + col];
  }
}

DI void phase_init(const Params& p, unsigned char* smem) {
  const int nb = gridDim.x, bid = lbid(), tid = ltid();
  for (int pr = bid; pr < 288; pr += nb) mod_item(p, 2 * pr + vhalf(), smem + vhalf() * HALF_BYTES);
  for (int it = 576 + bid; it < 1602; it += nb) {
    if (it < 1600) {
      const int r0 = (it - 576) * 4;
      for (int e = tid; e < 4 * 512; e += NT) {
        const int r = r0 + (e >> 9), k8 = (e & 511) * 8;
        unsigned w[4];
#pragma unroll
        for (int j = 0; j < 4; ++j) {
          float v[2];
#pragma unroll
          for (int q = 0; q < 2; ++q) {
            const int k = k8 + 2 * j + q;
            const int kk = k <= 2048 ? k : k - 2048;
            const int idx = (r * kk) & 4095;
            const float ang = (float)idx * (1.0f / 2048.0f);
            v[q] = k <= 2048 ? cospif(ang) : -sinpif(ang);
          }
          w[j] = pack2(v[0], v[1]);
        }
        *(uint4*)(p.TWL + (size_t)r * 4096 + k8) = make_uint4(w[0], w[1], w[2], w[3]);
      }
    } else if (it == 1600) {
      for (int e = tid; e < 256 * 512; e += NT) {
        const int r = e >> 9, k = e & 511;
        const int idx = (r * (k & 255)) & 255;
        const float ang = (float)idx * (1.0f / 128.0f);
        p.TWC[e] = f2bf(k < 256 ? cospif(ang) : -sinpif(ang));
      }
    } else {
      for (int e = tid; e < 64 * 16; e += NT) {
        const int pos = e >> 4, j = e & 15;
        const float inv = powf(10000.0f, -(float)(2 * j) / 32.0f);
        const float ang = (float)pos * inv;
        p.ROPE_S[e * 2] = cosf(ang); p.ROPE_S[e * 2 + 1] = sinf(ang);
      }
      for (int e = tid; e < 128 * 64; e += NT) {
        const int n = e >> 6, c = e & 63;
        const float ang = (float)((c * (n & 63)) & 63) * (1.f / 32.f);
        p.DFTW[e] = f2bf(n < 64 ? cospif(ang) : sinpif(ang));
      }
      for (int e = tid; e < 64 * 8; e += NT) {
        const int pos = e >> 3, j = e & 7;
        const float inv = powf(10000.0f, -(float)(2 * j) / 16.0f);
        const float ang = (float)pos * inv;
        p.ROPE_M[e * 2] = cosf(ang); p.ROPE_M[e * 2 + 1] = sinf(ang);
      }
    }
  }
}

DI void conv_tile(const float* __restrict__ src, int N, bf16_t* __restrict__ dst, int K, int kt, int nt, int mode, unsigned char* smem) {
  float* ts = (float*)smem;
  const int tid = vtid();
  __syncthreads();
#pragma unroll
  for (int i = 0; i < 4; ++i) {
    const int r = (tid >> 4) + 16 * i, c4 = (tid & 15) * 4;
    const float4 v = *(const float4*)(src + (size_t)(kt * 64 + r) * N + nt * 64 + c4);
    ts[r * 65 + c4] = v.x; ts[r * 65 + c4 + 1] = v.y; ts[r * 65 + c4 + 2] = v.z; ts[r * 65 + c4 + 3] = v.w;
  }
  __syncthreads();
  const int nl = tid >> 2, ks = (tid & 3) * 16;
  const int n = nt * 64 + nl;
  int drow = n;
  if (mode == 1) drow = (n >> 4) * 32 + (n & 15);
  else if (mode == 2) drow = (n >> 4) * 32 + 16 + (n & 15);
  unsigned w[8];
#pragma unroll
  for (int j = 0; j < 8; ++j) w[j] = pack2(ts[(ks + 2 * j) * 65 + nl], ts[(ks + 2 * j + 1) * 65 + nl]);
  bf16_t* d = dst + (size_t)drow * K + kt * 64 + ks;
  *(uint4*)d = make_uint4(w[0], w[1], w[2], w[3]);
  *(uint4*)(d + 8) = make_uint4(w[4], w[5], w[6], w[7]);
}
DI void convert_layer(const Params& p, int l, unsigned char* smem) {
  smem += vhalf() * HALF_BYTES;
  for (int t = 2 * lbid() + vhalf(); t < 5080; t += 2 * gridDim.x) {
    if (t < 2816) {
      const int q = t / 704, r = t % 704, i = q >> 1, which = q & 1;
      const float* src = (which ? p.w_up : p.w_gate) + (size_t)(l * 2 + i) * 1024 * DFF;
      conv_tile(src, DFF, p.WGU + (size_t)i * 5632 * 1024, 1024, r / 44, r % 44, 1 + which, smem);
    } else if (t < 4224) {
      const int q = (t - 2816) / 704, r = (t - 2816) % 704;
      conv_tile(p.w_down + (size_t)(l * 2 + q) * DFF * 1024, 1024, p.WD + (size_t)q * 1024 * DFF, DFF, r / 16, r % 16, 0, smem);
    } else if (t < 4784) {
      const int r = t - 4224;
      conv_tile(p.w_in + (size_t)l * 1024 * DIN, DIN, p.WIN, 1024, r / 35, r % 35, 0, smem);
    } else if (t < 5040) {
      const int r = t - 4784;
      conv_tile(p.w_out + (size_t)l * 1024 * 1024, 1024, p.WOUT, 1024, r / 16, r % 16, 0, smem);
    } else if (t < 5064) {
      const int r = t - 5040;
      conv_tile(p.w_qb + (size_t)l * 256 * 384, 384, p.WQB, 256, r / 6, r % 6, 0, smem);
    } else {
      const int r = t - 5064;
      conv_tile(p.w_kvb + (size_t)l * 128 * 512, 512, p.WKVB, 128, r / 8, r % 8, 0, smem);
    }
  }
}

struct EwArgs {
  const void *xin_ctx, *xin_lat; void *xout_ctx, *xout_lat;
  int in_f32, out_f32;
  const float* F; int lu, gate_idx, gpost_idx; float res_w;
  int do_norm, ln, sc_idx, sh_idx, gpre_idx;
  int r_lo, r_hi, vb, nvb;
};
DI float4 ld4_bf16(const bf16_t* p) { const u32x2 v = *(const u32x2*)p; return make_float4(__uint_as_float(v[0] << 16), __uint_as_float(v[0] & 0xffff0000u), __uint_as_float(v[1] << 16), __uint_as_float(v[1] & 0xffff0000u)); }
DI void phase_ew(const Params& p, const EwArgs& a) {
  const int lane = ltid() & 63, gw = a.vb * NW + (ltid() >> 6), nwv = a.nvb * NW;
  const bool upd = a.F != nullptr;
  const int rpw = (a.r_hi - a.r_lo + nwv - 1) / nwv;
  const int r0 = a.r_lo + gw * rpw, r1 = r0 + rpw < a.r_hi ? r0 + rpw : a.r_hi;
  float4 g[4], q[4], s4[4], t4[4], u4[4];
  int cur_mi = -1;
  for (int r = r0; r < r1; ++r) {
    const int mi = r < M_CTX ? 0 : 1 + ((r - M_CTX) >> 12);
    if (mi != cur_mi) {
      cur_mi = mi;
      const float* __restrict__ gate = p.MOD + (size_t)(a.lu * 5 + mi) * 9216 + a.gate_idx * 1024;
      const float* __restrict__ gpo = p.g_norm + (size_t)(a.lu * 6 + a.gpost_idx) * 1024;
      const float* __restrict__ sc = p.MOD + (size_t)(a.ln * 5 + mi) * 9216 + a.sc_idx * 1024;
      const float* __restrict__ sh = p.MOD + (size_t)(a.ln * 5 + mi) * 9216 + a.sh_idx * 1024;
      const float* __restrict__ gpr = p.g_norm + (size_t)(a.ln * 6 + a.gpre_idx) * 1024;
#pragma unroll
      for (int j = 0; j < 4; ++j) {
        const int c = lane * 4 + 256 * j;
        if (upd) { g[j] = *(const float4*)(gate + c); q[j] = *(const float4*)(gpo + c); }
        if (a.do_norm) { s4[j] = *(const float4*)(sc + c); t4[j] = *(const float4*)(sh + c); u4[j] = *(const float4*)(gpr + c); }
      }
    }
    const size_t ro = r < M_CTX ? (size_t)r * DM : (size_t)(r - M_CTX) * DM;
    const void* xb = r < M_CTX ? a.xin_ctx : a.xin_lat;
    float4 x[4], f[4];
#pragma unroll
    for (int j = 0; j < 4; ++j) {
      const int c = lane * 4 + 256 * j;
      x[j] = a.in_f32 ? *(const float4*)((const float*)xb + ro + c) : ld4_bf16((const bf16_t*)xb + ro + c);
      if (upd) f[j] = ld4_bf16((const bf16_t*)a.F + (size_t)r * DM + c);
    }
    if (upd) {
      float ss = 0.f;
#pragma unroll
      for (int j = 0; j < 4; ++j) ss += f[j].x * f[j].x + f[j].y * f[j].y + f[j].z * f[j].z + f[j].w * f[j].w;
      ss = wave_sum(ss);
      const float rs = rsqrtf(ss * (1.f / 1024.f) + EPS) * a.res_w;
      void* ob = r < M_CTX ? a.xout_ctx : a.xout_lat;
#pragma unroll
      for (int j = 0; j < 4; ++j) {
        const int c = lane * 4 + 256 * j;
        x[j].x += g[j].x * (f[j].x * rs * q[j].x); x[j].y += g[j].y * (f[j].y * rs * q[j].y);
        x[j].z += g[j].z * (f[j].z * rs * q[j].z); x[j].w += g[j].w * (f[j].w * rs * q[j].w);
        if (a.out_f32) *(float4*)((float*)ob + ro + c) = x[j];
        else { u32x2 w; w[0] = pack2(x[j].x, x[j].y); w[1] = pack2(x[j].z, x[j].w); *(u32x2*)((bf16_t*)ob + ro + c) = w; }
      }
    }
    if (a.do_norm) {
      float ss = 0.f;
#pragma unroll
      for (int j = 0; j < 4; ++j) ss += x[j].x * x[j].x + x[j].y * x[j].y + x[j].z * x[j].z + x[j].w * x[j].w;
      ss = wave_sum(ss);
      const float rs = rsqrtf(ss * (1.f / 1024.f) + EPS);
      bf16_t* hr = p.H + (size_t)r * DM;
#pragma unroll
      for (int j = 0; j < 4; ++j) {
        u32x2 w;
        w[0] = pack2(x[j].x * rs * u4[j].x * (1.f + s4[j].x) + t4[j].x, x[j].y * rs * u4[j].y * (1.f + s4[j].y) + t4[j].y);
        w[1] = pack2(x[j].z * rs * u4[j].z * (1.f + s4[j].z) + t4[j].z, x[j].w * rs * u4[j].w * (1.f + s4[j].w) + t4[j].w);
        *(u32x2*)(hr + lane * 4 + 256 * j) = w;
      }
    }
  }
}

DI void prep_item(const Params& p, int l, int it, unsigned char* smem) {
  const int tid = ltid(), lane = tid & 63, wid = tid >> 6;
  const int r0 = it * 32;
  if (r0 >= M_TOT) {
    for (int e = tid; e < 32 * 128; e += NT) {
      const int rr = e >> 7, cc = e & 127, idx = r0 - M_TOT + rr, b = idx >> 8, j = idx & 255;
      const size_t src = ((size_t)(b * 4 + l) * 256 + j) * 128 + cc;
      const size_t dst = (size_t)(r0 + rr) * 128 + cc;
      p.KS[dst] = f2bf(p.cache_swa_k[src]);
      p.VS[dst] = f2bf(p.cache_swa_v[src]);
      p.CKV[dst] = f2bf(p.cache_mla_ckv[src]);
    }
    for (int e = tid; e < 32 * 32; e += NT) {
      const int rr = e >> 5, cc = e & 31, idx = r0 - M_TOT + rr, b = idx >> 8, j = idx & 255;
      p.KR[(size_t)(r0 + rr) * 32 + cc] = f2bf(p.cache_mla_krope[((size_t)(b * 4 + l) * 256 + j) * 32 + cc]);
    }
    return;
  }
  const bool lat = r0 >= M_CTX;
  const bf16_t* __restrict__ Zr = p.Z; bf16_t* __restrict__ QSr = p.QS; bf16_t* __restrict__ KSr = p.KS; bf16_t* __restrict__ VSr = p.VS; const float* __restrict__ RSr = p.ROPE_S;
#pragma unroll 4
  for (int e = tid; e < 32 * 128; e += NT) {
    const int rr = e >> 7, rem = e & 127, head = rem >> 5, half = (rem >> 4) & 1, j = rem & 15;
    const int r = r0 + rr;
    const bf16_t* __restrict__ z = Zr + (size_t)r * DIN;
    const int d1 = head * 64 + half * 32 + j, d2 = d1 + 16;
    float x1 = bf2f(z[ZQS + d1]), x2 = bf2f(z[ZQS + d2]);
    float cs = 1.f, sn = 0.f;
    if (lat) { const int t = (r - M_CTX) & 4095; const int pos = half ? (t & 63) : (t >> 6); cs = RSr[(pos * 16 + j) * 2]; sn = RSr[(pos * 16 + j) * 2 + 1]; }
    QSr[(size_t)r * 256 + d1] = f2bf((x1 * cs - x2 * sn) * 0.125f);
    QSr[(size_t)r * 256 + d2] = f2bf((x2 * cs + x1 * sn) * 0.125f);
    if (head < 2) {
      x1 = bf2f(z[ZKS + d1]); x2 = bf2f(z[ZKS + d2]);
      KSr[(size_t)r * 128 + d1] = f2bf(x1 * cs - x2 * sn);
      KSr[(size_t)r * 128 + d2] = f2bf(x2 * cs + x1 * sn);
      VSr[(size_t)r * 128 + d1] = z[ZVS + d1];
      VSr[(size_t)r * 128 + d2] = z[ZVS + d2];
    }
  }
  for (int e = tid; e < 32 * 16; e += NT) {
    const int rr = e >> 4, half = (e >> 3) & 1, j = e & 7, r = r0 + rr;
    const bf16_t* z = p.Z + (size_t)r * DIN + ZKR;
    const int d1 = half * 16 + j, d2 = d1 + 8;
    const float x1 = bf2f(z[d1]), x2 = bf2f(z[d2]);
    float cs = 1.f, sn = 0.f;
    if (lat) { const int t = (r - M_CTX) & 4095; const int pos = half ? (t & 63) : (t >> 6); cs = p.ROPE_M[(pos * 8 + j) * 2]; sn = p.ROPE_M[(pos * 8 + j) * 2 + 1]; }
    p.KR[(size_t)r * 32 + d1] = f2bf(x1 * cs - x2 * sn);
    p.KR[(size_t)r * 32 + d2] = f2bf(x2 * cs + x1 * sn);
  }
#pragma unroll
  for (int rr0 = 0; rr0 < 32; rr0 += NW) {
    const int rr = rr0 + wid;
    const int r = r0 + rr;
    const bf16_t* __restrict__ z = Zr + (size_t)r * DIN;
    {
      const float a = bf2f(z[ZKVA + lane]), b = bf2f(z[ZKVA + 64 + lane]);
      const float rs = rsqrtf(wave_sum(a * a + b * b) * (1.f / 128.f) + EPS);
      const float o0 = a * rs * p.mla_g_kv[l * 128 + lane], o1 = b * rs * p.mla_g_kv[l * 128 + 64 + lane];
      p.CKV[(size_t)r * 128 + lane] = f2bf(o0); p.CKV[(size_t)r * 128 + 64 + lane] = f2bf(o1);
      if (!lat) {
        const int b_ = r >> 8, s = r & 255;
        float* dst = p.out + O_CKV + ((size_t)(b_ * 4 + l) * 256 + s) * 128;
        dst[lane] = o0; dst[64 + lane] = o1;
      }
    }
    {
      float v[4]; float ss = 0.f;
#pragma unroll
      for (int j = 0; j < 4; ++j) { v[j] = bf2f(z[ZQA + lane + 64 * j]); ss += v[j] * v[j]; }
      const float rs = rsqrtf(wave_sum(ss) * (1.f / 256.f) + EPS);
#pragma unroll
      for (int j = 0; j < 4; ++j) p.QLAT[(size_t)r * 256 + lane + 64 * j] = f2bf(v[j] * rs * p.mla_g_q[l * 256 + lane + 64 * j]);
    }
  }
}

DI void gla_cum(const Params& p, int l, int head, int dir, int row0, int rstep, float* sa, float* qt, f32x16& cum, float& last) {
  const int tid = vtid(), dk = tid & 63, quarter = tid >> 6;
  __syncthreads();
  for (int e = tid; e < 64 * 16; e += VT) {
    const int i = e >> 4, rr = e & 15;
    sa[e] = bf2f(p.Z[(size_t)(row0 + i * rstep) * DIN + ZAF + dir * 16 + rr]);
  }
  __syncthreads();
  float wg[16];
  const float* W = p.gla_w_gate + ((size_t)(l * 2 + dir) * 16) * 256 + head * 64 + dk;
#pragma unroll
  for (int rr = 0; rr < 16; ++rr) wg[rr] = W[rr * 256];
  const float bg = p.gla_b_gate[(l * 2 + dir) * 256 + head * 64 + dk];
  float run = 0.f;
#pragma unroll
  for (int ii = 0; ii < 16; ++ii) {
    const int i = quarter * 16 + ii;
    float lg = bg;
#pragma unroll
    for (int rr = 0; rr < 16; ++rr) lg += sa[i * 16 + rr] * wg[rr];
    const float ls = fminf(lg, 0.f) - __logf(1.f + __expf(-fabsf(lg)));
    run += ls * (1.f / 16.f);
    cum[ii] = run;
  }
  qt[quarter * 64 + dk] = run;
  __syncthreads();
  float offs = 0.f, tot = 0.f;
#pragma unroll
  for (int q = 0; q < 4; ++q) { const float v = qt[q * 64 + dk]; tot += v; if (q < quarter) offs += v; }
#pragma unroll
  for (int ii = 0; ii < 16; ++ii) cum[ii] += offs;
  last = tot;
}

DI void gla_seq_info(int sq_global, int& grp, int& b, int& head, int& dir, int& S, int& base) {
  if (sq_global < 32) { grp = 1; b = sq_global >> 3; head = (sq_global >> 1) & 3; dir = sq_global & 1; S = 4096; base = M_CTX + b * 4096; }
  else { const int s = sq_global - 32; grp = 0; b = s >> 3; head = (s >> 1) & 3; dir = s & 1; S = 256; base = b * 256; }
}

DI void gla_pass_a(const Params& p, int l, int ci, unsigned char* smem) {
  float* sa = (float*)smem;
  float* qt = sa + 1024;
  bf16_t* kdT = (bf16_t*)(qt + 256);
  bf16_t* vT = kdT + 64 * PITCH;
  const int tid = vtid(), lane = tid & 63, wid = tid >> 6, dk = tid & 63, quarter = tid >> 6, l31 = lane & 31, h = lane >> 5;
  int sqg, c;
  if (ci < 2048) { sqg = ci >> 6; c = ci & 63; } else { sqg = 32 + ((ci - 2048) >> 2); c = (ci - 2048) & 3; }
  int grp, b, head, dir, S, base;
  gla_seq_info(sqg, grp, b, head, dir, S, base);
  const int row0 = dir ? base + S - 1 - 64 * c : base + 64 * c, rstep = dir ? -1 : 1;
  f32x16 kraw, vraw;
#pragma unroll
  for (int ii = 0; ii < 16; ++ii) {
    const bf16_t* __restrict__ z = p.Z + (size_t)(row0 + (quarter * 16 + ii) * rstep) * DIN;
    kraw[ii] = bf2f(z[ZKG + head * 64 + dk]);
    vraw[ii] = bf2f(z[ZVG + head * 64 + dk]);
  }
  f32x16 cum; float last;
  gla_cum(p, l, head, dir, row0, rstep, sa, qt, cum, last);
  unsigned kw[8], vw[8];
#pragma unroll
  for (int j = 0; j < 8; ++j) {
    kw[j] = pack2(kraw[2 * j] * __expf(last - cum[2 * j]), kraw[2 * j + 1] * __expf(last - cum[2 * j + 1]));
    vw[j] = pack2(vraw[2 * j], vraw[2 * j + 1]);
  }
  *(uint4*)(kdT + dk * PITCH + quarter * 16) = make_uint4(kw[0], kw[1], kw[2], kw[3]);
  *(uint4*)(kdT + dk * PITCH + quarter * 16 + 8) = make_uint4(kw[4], kw[5], kw[6], kw[7]);
  *(uint4*)(vT + dk * PITCH + quarter * 16) = make_uint4(vw[0], vw[1], vw[2], vw[3]);
  *(uint4*)(vT + dk * PITCH + quarter * 16 + 8) = make_uint4(vw[4], vw[5], vw[6], vw[7]);
  if (quarter == 0) p.GLA_DL[(size_t)ci * 64 + dk] = expf(last);
  __syncthreads();
  const int wr = wid >> 1, wc = wid & 1;
  f32x16 acc;
#pragma unroll
  for (int i = 0; i < 16; ++i) acc[i] = 0.f;
#pragma unroll
  for (int ks = 0; ks < 4; ++ks) {
    const bf16x8 a = *(const bf16x8*)(kdT + (wr * 32 + l31) * PITCH + ks * 16 + h * 8);
    const bf16x8 bb = *(const bf16x8*)(vT + (wc * 32 + l31) * PITCH + ks * 16 + h * 8);
    acc = MFMA32(a, bb, acc);
  }
  float* Bc = p.GLA_B + (size_t)ci * 4096;
#pragma unroll
  for (int i = 0; i < 16; ++i) Bc[(wr * 32 + crow(i, h)) * 64 + wc * 32 + l31] = acc[i];
}

typedef float f32x8 __attribute__((ext_vector_type(8)));
DI void gla_pass_b(const Params& p, int l, int sqg, int part) {
  const int tid = ltid(), dv = part * 16 + (tid & 15), dk0 = (tid >> 4) * 2;
  int grp, b, head, dir, S, base;
  gla_seq_info(sqg, grp, b, head, dir, S, base);
  const int nch = S >> 6;
  const int ci0 = grp ? sqg * 64 : 2048 + (sqg - 32) * 4;
  float s0v = 0.f, s1v = 0.f;
  if (grp) {
    const float* __restrict__ s0 = p.state_gla + ((((size_t)b * 4 + l) * 2 + dir) * 4 + head) * 4096;
    s0v = s0[dk0 * 64 + dv]; s1v = s0[(dk0 + 1) * 64 + dv];
  }
  const float* __restrict__ GB = p.GLA_B; const float* __restrict__ GD = p.GLA_DL; bf16_t* __restrict__ GS = p.GLA_S;
  float rb0[16], rb1[16], rd0[16], rd1[16];
#pragma unroll
  for (int q = 0; q < 16; ++q) {
    const int cq = q < nch ? q : nch - 1;
    const float* Bc = GB + (size_t)(ci0 + cq) * 4096 + dk0 * 64 + dv; const float* dl = GD + (size_t)(ci0 + cq) * 64 + dk0;
    rb0[q] = Bc[0]; rb1[q] = Bc[64]; rd0[q] = dl[0]; rd1[q] = dl[1];
  }
  for (int c0 = 0; c0 < nch; c0 += 16) {
#pragma unroll
    for (int q = 0; q < 16; ++q) {
      const int c = c0 + q;
      if (c < nch) {
        *(unsigned*)(GS + (size_t)(ci0 + c) * 4096 + dv * 64 + dk0) = pack2(s0v, s1v);
        s0v = rd0[q] * s0v + rb0[q]; s1v = rd1[q] * s1v + rb1[q];
      }
      const int cn = c + 16 < nch ? c + 16 : nch - 1;
      const float* Bc = GB + (size_t)(ci0 + cn) * 4096 + dk0 * 64 + dv; const float* dl = GD + (size_t)(ci0 + cn) * 64 + dk0;
      rb0[q] = Bc[0]; rb1[q] = Bc[64]; rd0[q] = dl[0]; rd1[q] = dl[1];
    }
  }
  if (!grp) {
    float* so = p.out + O_ST + ((((size_t)b * 4 + l) * 2 + dir) * 4 + head) * 4096;
    so[dk0 * 64 + dv] = s0v; so[(dk0 + 1) * 64 + dv] = s1v;
  }
}

DI void gla_pass_c(const Params& p, int l, int item, unsigned char* smem) {
  float* sa = (float*)smem;
  float* qt = sa + 1024;
  bf16_t* qd = (bf16_t*)(qt + 256);
  bf16_t* ki = qd + 64 * PITCH;
  bf16_t* vT = ki + 64 * PITCH;
  bf16_t* stT = vT + 64 * PITCH;
  float* osum = (float*)(stT + 64 * PITCH);
  const int tid = vtid(), lane = tid & 63, wid = tid >> 6, dk = tid & 63, quarter = tid >> 6, l31 = lane & 31, h = lane >> 5;
  int grp, b, head, c, S, base, nch;
  if (item < 1024) { grp = 1; b = item >> 8; head = (item >> 6) & 3; c = item & 63; S = 4096; base = M_CTX + b * 4096; nch = 64; }
  else { const int it = item - 1024; grp = 0; b = it >> 4; head = (it >> 2) & 3; c = it & 3; S = 256; base = b * 256; nch = 4; }
  const int wd = wid >> 1, wp = wid & 1;
  const int tk = tid >> 2, q4 = tid & 3, frow = base + 64 * c + tk;
  const u32x4 rg0 = *(const u32x4*)(p.Z + (size_t)frow * DIN + ZRG + head * 64 + q4 * 16);
  const u32x4 rg1 = *(const u32x4*)(p.Z + (size_t)frow * DIN + ZRG + head * 64 + q4 * 16 + 8);
  for (int dir = 0; dir < 2; ++dir) {
    const int cs = dir ? nch - 1 - c : c;
    const int sq = b * 8 + head * 2 + dir;
    const size_t ci = grp ? (size_t)sq * 64 + cs : 2048 + (size_t)sq * 4 + cs;
    const int row0 = dir ? base + S - 1 - 64 * cs : base + 64 * cs, rstep = dir ? -1 : 1;
    f32x16 qraw, kraw, vraw;
#pragma unroll
    for (int ii = 0; ii < 16; ++ii) {
      const bf16_t* __restrict__ z = p.Z + (size_t)(row0 + (quarter * 16 + ii) * rstep) * DIN;
      qraw[ii] = bf2f(z[ZQG + head * 64 + dk]);
      kraw[ii] = bf2f(z[ZKG + head * 64 + dk]);
      vraw[ii] = bf2f(z[ZVG + head * 64 + dk]);
    }
    u32x4 st0, st1;
    {
      const bf16_t* Sg = p.GLA_S + ci * 4096;
      st0 = *(const u32x4*)(Sg + (tid >> 3) * 64 + (tid & 7) * 8);
      st1 = *(const u32x4*)(Sg + (32 + (tid >> 3)) * 64 + (tid & 7) * 8);
    }
    f32x16 cum; float last;
    gla_cum(p, l, head, dir, row0, rstep, sa, qt, cum, last);
    unsigned vw[8];
#pragma unroll
    for (int ii = 0; ii < 16; ++ii) {
      const int i = quarter * 16 + ii;
      const float e = __expf(cum[ii]);
      qd[i * PITCH + dk] = f2bf(qraw[ii] * 0.125f * e);
      ki[i * PITCH + dk] = f2bf(kraw[ii] * __expf(-cum[ii]));
    }
#pragma unroll
    for (int j = 0; j < 8; ++j) vw[j] = pack2(vraw[2 * j], vraw[2 * j + 1]);
    *(uint4*)(vT + dk * PITCH + quarter * 16) = make_uint4(vw[0], vw[1], vw[2], vw[3]);
    *(uint4*)(vT + dk * PITCH + quarter * 16 + 8) = make_uint4(vw[4], vw[5], vw[6], vw[7]);
    *(u32x4*)(stT + (tid >> 3) * PITCH + (tid & 7) * 8) = st0;
    *(u32x4*)(stT + (32 + (tid >> 3)) * PITCH + (tid & 7) * 8) = st1;
    __syncthreads();
    f32x16 acco;
#pragma unroll
    for (int i = 0; i < 16; ++i) acco[i] = 0.f;
#pragma unroll
    for (int ks = 0; ks < 4; ++ks) {
      const bf16x8 a = *(const bf16x8*)(stT + (wd * 32 + l31) * PITCH + ks * 16 + h * 8);
      const bf16x8 bb = *(const bf16x8*)(qd + (wp * 32 + l31) * PITCH + ks * 16 + h * 8);
      acco = MFMA32(a, bb, acco);
    }
    for (int jb = 0; jb <= wp; ++jb) {
      f32x16 att;
#pragma unroll
      for (int i = 0; i < 16; ++i) att[i] = 0.f;
#pragma unroll
      for (int ks = 0; ks < 4; ++ks) {
        const bf16x8 a = *(const bf16x8*)(ki + (jb * 32 + l31) * PITCH + ks * 16 + h * 8);
        const bf16x8 bb = *(const bf16x8*)(qd + (wp * 32 + l31) * PITCH + ks * 16 + h * 8);
        att = MFMA32(a, bb, att);
      }
      const int ipos = wp * 32 + l31;
#pragma unroll
      for (int i = 0; i < 16; ++i) if (jb * 32 + crow(i, h) > ipos) att[i] = 0.f;
#pragma unroll
      for (int s = 0; s < 2; ++s) {
        union { bf16x8 v; unsigned u[4]; } pf;
#pragma unroll
        for (int j = 0; j < 4; ++j) pf.u[j] = pack2(att[8 * s + 2 * j], att[8 * s + 2 * j + 1]);
        union { bf16x8 v; bf16x4 hlf[2]; } vf;
        vf.hlf[0] = *(const bf16x4*)(vT + (wd * 32 + l31) * PITCH + jb * 32 + 16 * s + 4 * h);
        vf.hlf[1] = *(const bf16x4*)(vT + (wd * 32 + l31) * PITCH + jb * 32 + 16 * s + 8 + 4 * h);
        acco = MFMA32(vf.v, pf.v, acco);
      }
    }
    {
      const int i = wp * 32 + l31, tl = dir ? 63 - i : i;
#pragma unroll
      for (int r = 0; r < 16; ++r) {
        float* o = osum + tl * 65 + wd * 32 + crow(r, h);
        if (dir) *o += acco[r]; else *o = acco[r];
      }
    }
  }
  __syncthreads();
  {
    float v[16]; float ss = 0.f;
#pragma unroll
    for (int j = 0; j < 16; ++j) { v[j] = osum[tk * 65 + q4 * 16 + j]; ss += v[j] * v[j]; }
    ss += shx(ss, 1); ss += shx(ss, 2);
    const float rs = rsqrtf(ss * (1.f / 64.f) + EPS);
    const float* __restrict__ gp = p.gla_g_out + l * 64 + q4 * 16;
    unsigned w[8];
#pragma unroll
    for (int j = 0; j < 8; ++j) {
      const unsigned ru = j < 4 ? rg0[j & 3] : rg1[j & 3];
      const float r0 = __uint_as_float(ru << 16), r1 = __uint_as_float(ru & 0xffff0000u);
      w[j] = pack2(v[2 * j] * rs * gp[2 * j] * silu_f(r0), v[2 * j + 1] * rs * gp[2 * j + 1] * silu_f(r1));
    }
    bf16_t* dst = p.MIX + (size_t)frow * 1024 + head * 64 + q4 * 16;
    *(u32x4*)dst = (u32x4){w[0], w[1], w[2], w[3]};
    *(u32x4*)(dst + 8) = (u32x4){w[4], w[5], w[6], w[7]};
  }
}

struct AttnJob {
  const bf16_t* Q; int ldq;
  const bf16_t* K1; int ldk1;
  const bf16_t* K2; int ldk2;
  const bf16_t* V; int ldv;
  int ctx_row0, nctx;
  int loc_row0, loc_pos0, nloc;
  int qrow0, qpos0;
  int window;
  float scale; int has_sink; float sink;
  bf16_t* O; int ldo;
};
template <int DQ>
DI void attn_block(const AttnJob& jb, unsigned char* smem) {
  constexpr int NKS = DQ / 16, KP = DQ + 8, NCH = DQ / 8;
  constexpr int BUFE = 64 * KP + 64 * PITCH;
  bf16_t* sbuf = (bf16_t*)smem;
  const int tid = ltid(), lane = tid & 63, wid = tid >> 6, l31 = lane & 31, h = lane >> 5;
  const int qr = jb.qrow0 + wid * 32 + l31;
  bf16x8 qf[NKS];
#pragma unroll
  for (int ks = 0; ks < NKS; ++ks) {
    const u32x4 raw = *(const u32x4*)(jb.Q + (size_t)qr * jb.ldq + ks * 16 + h * 8);
    const float qs = jb.scale * 1.4426950408889634f;
    u32x4 sc;
#pragma unroll
    for (int j = 0; j < 4; ++j) sc[j] = pack2(__uint_as_float(raw[j] << 16) * qs, __uint_as_float(raw[j] & 0xffff0000u) * qs);
    qf[ks] = __builtin_bit_cast(bf16x8, sc);
  }
  const int qpos = jb.qpos0 + wid * 32 + l31;
  f32x16 o[2];
#pragma unroll
  for (int d = 0; d < 2; ++d)
#pragma unroll
    for (int i = 0; i < 16; ++i) o[d][i] = 0.f;
  float m = -1e30f, lsum = 0.f;
  const int nt = jb.nctx + jb.nloc;
  const int kk0 = tid / NCH, kd0 = tid % NCH;
  const bool k1v = (NCH > 8) && (tid + NT < 64 * NCH);
  const int kk1 = k1v ? (tid + NT) / NCH : 0, kd1 = k1v ? (tid + NT) % NCH : 0;
  const int vk0 = tid & 63, vd0 = tid >> 6;
  u32x4 ka0, ka1 = {0u, 0u, 0u, 0u}, va0, kb0, kb1 = {0u, 0u, 0u, 0u}, vb0, kc0, kc1 = {0u, 0u, 0u, 0u}, vc0;
#define ATT_KLD(key, dc, krow) ((dc) < 8 ? *(const u32x4*)(jb.K1 + (size_t)((krow) + (key)) * jb.ldk1 + (dc) * 8) \
                                       : *(const u32x4*)(jb.K2 + (size_t)((krow) + (key)) * jb.ldk2 + ((dc) - 8) * 8))
#define ATT_LOAD(tt, K0_, K1_, V0_) { const int tc_ = (tt) < nt ? (tt) : nt - 1; \
    const int kr_ = tc_ < jb.nctx ? jb.ctx_row0 + 64 * tc_ : jb.loc_row0 + jb.loc_pos0 + 64 * (tc_ - jb.nctx); \
    K0_ = ATT_KLD(kk0, kd0, kr_); if (k1v) K1_ = ATT_KLD(kk1, kd1, kr_); \
    V0_ = *(const u32x4*)(jb.V + (size_t)(kr_ + vk0) * jb.ldv + vd0 * 8); }
#define ATT_VST(dst, v, dc) { _Pragma("unroll") for (int j = 0; j < 4; ++j) { \
      (dst)[((dc) * 8 + 2 * j) * PITCH + vk0] = (bf16_t)((v)[j] & 0xffffu); (dst)[((dc) * 8 + 2 * j + 1) * PITCH + vk0] = (bf16_t)((v)[j] >> 16); } }
#define ATT_FILL(buf, K0_, K1_, V0_) { bf16_t* sKw = sbuf + (buf) * BUFE; bf16_t* sVw = sKw + 64 * KP; \
    *(u32x4*)(sKw + kk0 * KP + kd0 * 8) = K0_; if (k1v) *(u32x4*)(sKw + kk1 * KP + kd1 * 8) = K1_; ATT_VST(sVw, V0_, vd0); }
  ATT_LOAD(0, ka0, ka1, va0); ATT_LOAD(1, kb0, kb1, vb0); ATT_LOAD(2, kc0, kc1, vc0);
  __syncthreads();
  ATT_FILL(0, ka0, ka1, va0); ATT_LOAD(3, ka0, ka1, va0);
  ATT_FILL(1, kb0, kb1, vb0); ATT_LOAD(4, kb0, kb1, vb0);
  __syncthreads();
#define ATT_QK(dst, buf) { const bf16_t* sKq = sbuf + (buf) * BUFE; _Pragma("unroll") for (int kb = 0; kb < 2; ++kb) { \
      _Pragma("unroll") for (int i = 0; i < 16; ++i) dst[kb][i] = 0.f; \
      _Pragma("unroll") for (int ks = 0; ks < NKS; ++ks) { \
        const bf16x8 a = *(const bf16x8*)(sKq + (kb * 32 + l31) * KP + ks * 16 + h * 8); dst[kb] = MFMA32(a, qf[ks], dst[kb]); } } }
  f32x16 sn[2];
  ATT_QK(sn, 0);
  auto body = [&](const int t, const int bm, u32x4& kr0, u32x4& kr1, u32x4& vr0) __attribute__((always_inline)) {
    int kpos0; bool masked;
    if (t < jb.nctx) { kpos0 = 0; masked = false; }
    else { kpos0 = jb.loc_pos0 + 64 * (t - jb.nctx); masked = jb.window > 0; }
    ATT_FILL((bm + 2) % 3, kr0, kr1, vr0);
    ATT_LOAD(t + 5, kr0, kr1, vr0);
    const bf16_t* sVt = sbuf + bm * BUFE + 64 * KP;
    f32x16 st[2];
    st[0] = sn[0]; st[1] = sn[1];
    ATT_QK(sn, (bm + 1) % 3);
    float mx = -1e30f;
#pragma unroll
    for (int kb = 0; kb < 2; ++kb)
#pragma unroll
      for (int i = 0; i < 16; ++i) {
        float s = st[kb][i];
        if (masked) {
          const int kp = kpos0 + kb * 32 + crow(i, h);
          const int d = qpos - kp;
          if (d > jb.window || d < -jb.window) s = -1e30f;
        }
        st[kb][i] = s;
        mx = fmaxf(mx, s);
      }
    mx = fmaxf(mx, shx(mx, 32));
    const float mn = fmaxf(m, mx);
    const bool grow = __builtin_amdgcn_ballot_w64(mn > m) != 0ull;
    float ps = 0.f;
#pragma unroll
    for (int kb = 0; kb < 2; ++kb)
#pragma unroll
      for (int i = 0; i < 16; ++i) { const float pv = __builtin_amdgcn_exp2f(st[kb][i] - mn); st[kb][i] = pv; ps += pv; }
    if (grow) {
      const float alpha = __builtin_amdgcn_exp2f(m - mn);
      lsum *= alpha;
#pragma unroll
      for (int d = 0; d < 2; ++d)
#pragma unroll
        for (int i = 0; i < 16; ++i) o[d][i] *= alpha;
    }
    m = mn;
    lsum += ps;
#pragma unroll
    for (int kb = 0; kb < 2; ++kb)
#pragma unroll
      for (int s = 0; s < 2; ++s) {
        union { bf16x8 v; unsigned u[4]; } pf;
#pragma unroll
        for (int j = 0; j < 4; ++j) pf.u[j] = pack2(st[kb][8 * s + 2 * j], st[kb][8 * s + 2 * j + 1]);
#pragma unroll
        for (int d = 0; d < 2; ++d) {
          union { bf16x8 v; bf16x4 hlf[2]; } vf;
          vf.hlf[0] = *(const bf16x4*)(sVt + (d * 32 + l31) * PITCH + kb * 32 + 16 * s + 4 * h);
          vf.hlf[1] = *(const bf16x4*)(sVt + (d * 32 + l31) * PITCH + kb * 32 + 16 * s + 8 + 4 * h);
          o[d] = MFMA32(vf.v, pf.v, o[d]);
        }
      }
    __syncthreads();
  };
  for (int t = 0; t < nt; t += 3) {
    body(t, 0, kc0, kc1, vc0);
    if (t + 1 < nt) body(t + 1, 1, ka0, ka1, va0);
    if (t + 2 < nt) body(t + 2, 2, kb0, kb1, vb0);
  }
  lsum += shx(lsum, 32);
  float inv;
  if (jb.has_sink) {
    const float sk2 = jb.sink * 1.4426950408889634f;
    const float mf = fmaxf(m, sk2);
    const float corr = __builtin_amdgcn_exp2f(m - mf);
    inv = corr / (lsum * corr + __builtin_amdgcn_exp2f(sk2 - mf));
  } else inv = 1.f / lsum;
  bf16_t* orow = jb.O + (size_t)qr * jb.ldo;
#pragma unroll
  for (int d = 0; d < 2; ++d)
#pragma unroll
    for (int g = 0; g < 4; ++g) {
      uint2 w;
      w.x = pack2(o[d][4 * g] * inv, o[d][4 * g + 1] * inv);
      w.y = pack2(o[d][4 * g + 2] * inv, o[d][4 * g + 3] * inv);
      *(uint2*)(orow + d * 32 + 8 * g + 4 * h) = w;
    }
}

DI void mla_item(const Params& p, int l, int grp, int it, unsigned char* smem) {
  AttnJob j;
  int b, head, qb;
  if (grp) { b = it >> 6; head = (it >> 4) & 3; qb = it & 15; } else { b = it >> 2; head = it & 3; qb = 0; }
  const int base = grp ? M_CTX + b * 4096 : b * 256;
  j.Q = p.QM + head * 96; j.ldq = 384;
  j.K1 = p.KV + head * 128; j.ldk1 = 512; j.K2 = p.KR; j.ldk2 = 32; j.V = p.KV + head * 128 + 64; j.ldv = 512;
  j.ctx_row0 = M_TOT + b * 256; j.nctx = grp ? 4 : 0;
  j.loc_row0 = base; j.loc_pos0 = 0; j.nloc = grp ? 64 : 4;
  j.qrow0 = base + qb * 256; j.qpos0 = qb * 256; j.window = 0;
  j.scale = 0.10206207261596577f; j.has_sink = 0; j.sink = 0.f;
  j.O = p.MIX + 768 + head * 64; j.ldo = 1024;
  attn_block<96>(j, smem);
}
DI void swa_item(const Params& p, int l, int grp, int it, unsigned char* smem) {
  AttnJob j;
  int b, hq, qb;
  if (grp) { b = it >> 6; hq = (it >> 4) & 3; qb = it & 15; } else { b = it >> 2; hq = it & 3; qb = 0; }
  const int base = grp ? M_CTX + b * 4096 : b * 256;
  const int g = hq >> 1;
  j.Q = p.QS + hq * 64; j.ldq = 256;
  j.K1 = p.KS + g * 64; j.ldk1 = 128; j.K2 = p.KS; j.ldk2 = 128; j.V = p.VS + g * 64; j.ldv = 128;
  j.ctx_row0 = M_TOT + b * 256; j.nctx = grp ? 4 : 0;
  if (grp) {
    const int lo = qb > 0 ? qb * 256 - 128 : 0, hi = qb < 15 ? qb * 256 + 384 : 4096;
    j.loc_pos0 = lo; j.nloc = (hi - lo) >> 6; j.window = 128;
  } else { j.loc_pos0 = 0; j.nloc = 4; j.window = 0; }
  j.loc_row0 = base;
  j.qrow0 = base + qb * 256; j.qpos0 = qb * 256;
  j.scale = 1.0f;
  j.has_sink = 1; j.sink = p.swa_sink[l * 4 + hq];
  j.O = p.MIX + 256 + hq * 64; j.ldo = 1024;
  attn_block<64>(j, smem);
}

DI bool tile_swz(int i, int nN, int T, int& tm, int& tn) {
  const int bid = lbid(), slots = gridDim.x >> 3;
  const int L = (i * 8 + (bid & 7)) * slots + (bid >> 3);
  if (L >= T) return false;
  const int pw = 8 * nN, pnl = L / pw, rem = L - pnl * pw;
  tn = rem >> 3; tm = pnl * 8 + (rem & 7);
  return true;
}
DI void phase_gemm_gu(const Params& p, int i, unsigned char* smem) {
  Epi8GateUp epi{p.ACT};
  const bf16_t* W = p.WGU + (size_t)i * 5632 * 1024;
  int tm, tn, nm = 0, nn = 0; bool has = tile_swz(0, 22, 80 * 22, tm, tn), first = true;
  for (int i2 = 0; has; ++i2) {
    const bool hn = tile_swz(i2 + 1, 22, 80 * 22, nm, nn);
    gemm8_tile(p.H, W, 1024, tm * 256, tn * 256, smem, epi, first, hn, nm * 256, nn * 256);
    first = false; tm = nm; tn = nn; has = hn;
  }
}
DI void phase_gemm_down(const Params& p, int i, unsigned char* smem, int round) {
  Epi8Bf16 epi{(bf16_t*)p.F, 1024, 1.f, 1024};
  const bf16_t* W = p.WD + (size_t)i * 1024 * DFF;
  int tm, tn;
  if (tile_swz(round, 4, 80 * 4, tm, tn)) gemm8_tile(p.ACT, W, DFF, tm * 256, tn * 256, smem, epi);
}
DI void phase_gemm_win(const Params& p, int l, unsigned char* smem) {
  Epi8Win epi{p.Z, p.out, l};
  int tm, tn, nm = 0, nn = 0; bool has = tile_swz(0, 9, 80 * 9, tm, tn), first = true;
  for (int i2 = 0; has; ++i2) {
    const bool hn = tile_swz(i2 + 1, 9, 80 * 9, nm, nn);
    gemm8_tile(p.H, p.WIN, 1024, tm * 256, tn * 256, smem, epi, first, hn, nm * 256, nn * 256);
    first = false; tm = nm; tn = nn; has = hn;
  }
}
DI void phase_gemm_wout(const Params& p, unsigned char* smem) {
  Epi8Bf16 epi{(bf16_t*)p.F, 1024, 1.f, 1024};
  { int tm, tn; const int nit = (80 * 4 + gridDim.x - 1) / gridDim.x + 8; for (int i2 = 0; i2 < nit; ++i2) if (tile_swz(i2, 4, 80 * 4, tm, tn)) gemm8_tile(p.MIX, p.WOUT, 1024, tm * 256, tn * 256, smem, epi); }
}
DI void phase_prep(const Params& p, int l, unsigned char* smem, unsigned* ctr) {
  volatile int* s_item = (volatile int*)(smem + S_ITEM_OFF);
  for (;;) {
    __syncthreads();
    if (ltid() == 0) *s_item = (int)atomicAdd(ctr, 1u);
    __syncthreads();
    const int t = *s_item;
    if (t >= 2272) break;
    if (t < 672) prep_item(p, l, t, smem);
    else if (t < 992) {
      const int u = t - 672, g = u & 3, tm = u >> 2;
      EpiDft e{p.ABTL, p.ABTC, g};
      gemm_tile<2>(p.Z + ZF + g * 64, DIN, p.DFTW, 64, 64, tm * 256, 0, smem, e);
    } else gla_pass_a(p, l, 2 * (t - 992) + vhalf(), smem + vhalf() * HALF_BYTES);
  }
}
DI void fft_fold_item(const Params& p, int it) {
  const int tid = ltid(), row0 = it * 8;
  for (int e = tid; e < 8 * 4096; e += NT) {
    const int rr = e >> 12, k = e & 4095;
    const bf16_t* __restrict__ src = p.ABTL + (size_t)(row0 + rr) * 8192;
    float v;
    if (k <= 2048) { v = bf2f(src[k]); if (k != 0 && k != 2048) v += bf2f(src[4096 - k]); }
    else { const int kk = k - 2048; v = bf2f(src[4096 + kk]) - bf2f(src[8192 - kk]); }
    p.ABTF[(size_t)(row0 + rr) * 4096 + k] = f2bf(v);
  }
}
DI void phase_qkv(const Params& p, int l, unsigned char* smem, unsigned* ctr) {
  EpiQm eq{p.QM, p.ROPE_M};
  EpiBf16 ekv{p.KV, 512, 1.f, 512};
  volatile int* s_item = (volatile int*)(smem + S_ITEM_OFF);
  for (;;) {
    __syncthreads();
    if (ltid() == 0) *s_item = (int)atomicAdd(ctr, 1u);
    __syncthreads();
    const int t = *s_item;
    if (t >= 1344) break;
    if (t < 128 || t >= 832) { const int u = t < 128 ? t : 128 + (t - 832); gla_pass_b(p, l, u >> 2, u & 3); }
    else if (t < 256) fft_fold_item(p, t - 128);
    else if (t < 496) { const int u = t - 256, tm = u / 3, tn = u % 3; gemm_tile<2>(p.QLAT, 256, p.WQB, 256, 256, tm * 256, tn * 128, smem, eq); }
    else { const int u = t - 496, tm = u >> 2, tn = u & 3; gemm_tile<2>(p.CKV, 128, p.WKVB, 128, 128, tm * 256, tn * 128, smem, ekv); }
  }
}
DI void phase_mixers(const Params& p, int l, unsigned char* smem, unsigned* ctr, unsigned long long* tc) {
  volatile int* s_item = (volatile int*)(smem + S_ITEM_OFF);
  const int x = lbid() & 7;
  for (;;) {
    __syncthreads();
    if (ltid() == 0) *s_item = (int)atomicAdd(ctr + x, 1u);
    __syncthreads();
    const int u = *s_item;
    if (u >= 172) break;
    volatile unsigned long long* tl = (volatile unsigned long long*)(smem + S_ITEM_OFF + 16);
    if (PROBE_SPIN >= 9 && ltid() == 0) tl[0] = __builtin_amdgcn_s_memrealtime();
    if (u < 8) {
      const int tm = x + 8 * (u >> 2), b = u & 3;
      Epi8Bf16 e{p.MIX + (size_t)(M_CTX + b * 4096) * 1024 + 512, 1024, 1.f / 512.f, 256};
      gemm8_tile(p.TWL, p.ABTF + (size_t)b * 256 * 4096, 4096, tm * 256, 0, smem, e);
    } else if (u < 40) { const int v = u - 8; mla_item(p, l, 1, (x + 8 * (v >> 4)) * 16 + (v & 15), smem); }
    else if (u < 72) { const int v = u - 40; swa_item(p, l, 1, (x + 8 * (v >> 4)) * 16 + (v & 15), smem); }
    else if (u < 136) gla_pass_c(p, l, 2 * (x * 64 + (u - 72)) + vhalf(), smem + vhalf() * HALF_BYTES);
    else if (u < 144) mla_item(p, l, 0, x * 8 + (u - 136), smem);
    else if (u < 152) swa_item(p, l, 0, x * 8 + (u - 144), smem);
    else if (u < 156) {
      const int w = x * 4 + (u - 152), b = w >> 1, tn = w & 1;
      EpiBf16 e{p.MIX + (size_t)(b * 256) * 1024 + 512, 1024, 1.f / 128.f, 256};
      gemm_tile<2>(p.TWC, 512, p.ABTC + (size_t)b * 256 * 512, 512, 512, 0, tn * 128, smem, e);
    } else gla_pass_c(p, l, 1024 + 2 * (x * 16 + (u - 156)) + vhalf(), smem + vhalf() * HALF_BYTES);
    if (PROBE_SPIN >= 9 && ltid() == 0) { const int cat = u < 8 ? 11 : u < 40 ? 9 : u < 72 ? 12 : u < 136 ? 10 : 13; if (cat == PROBE_SPIN) tl[1] += __builtin_amdgcn_s_memrealtime() - tl[0]; }
  }
}

#ifndef PROBE_DBL
#define PROBE_DBL 0
#endif
#define DBL(bit) (((PROBE_DBL) >> (bit)) & 1)
#ifndef ONLY_J
#define ONLY_J -1
#endif
#define EN(x) (ONLY_J < 0 || ONLY_J == (x))
constexpr int PPL = 14, N_PHASES = 2 + 4 * PPL;
constexpr int R_SPLIT = 16384;
#define MKP KP4 kq = kp; asm volatile("" : "+s"(kq)); const Params p = make_params(kq)
DI EwArgs ew_args(const Params& p, int kind, int l, int r_lo, int r_hi, int vb, int nvb) {
  float* Xc = p.X; float* Xl = Xc + (size_t)M_CTX * DM;
  EwArgs a{};
  a.r_lo = r_lo; a.r_hi = r_hi; a.vb = vb; a.nvb = nvb;
  a.xin_ctx = Xc; a.xin_lat = Xl; a.xout_ctx = Xc; a.xout_lat = Xl; a.in_f32 = 1; a.out_f32 = 1; a.F = p.F;
  if (kind == 0) { a.xin_ctx = p.x_prompt; a.xin_lat = p.x_sample; a.in_f32 = 1; a.F = nullptr; a.do_norm = 1; a.ln = 0; a.sc_idx = 1; a.sh_idx = 0; a.gpre_idx = 0; }
  else if (kind == 1) { if (l == 0) { a.xin_ctx = p.x_prompt; a.xin_lat = p.x_sample; a.in_f32 = 1; } a.lu = l; a.gate_idx = 2; a.gpost_idx = 1; a.res_w = 0.5f; a.do_norm = 1; a.ln = l; a.sc_idx = 4; a.sh_idx = 3; a.gpre_idx = 2; }
  else if (kind == 2) { a.lu = l; a.gate_idx = 5; a.gpost_idx = 3; a.res_w = 1.0f; a.do_norm = 1; a.ln = l; a.sc_idx = 7; a.sh_idx = 6; a.gpre_idx = 4; }
  else { a.lu = l; a.gate_idx = 8; a.gpost_idx = 5; a.res_w = 0.5f;
    if (l < 3) { a.do_norm = 1; a.ln = l + 1; a.sc_idx = 1; a.sh_idx = 0; a.gpre_idx = 0; }
    else { a.do_norm = 0; a.out_f32 = 1; a.xout_ctx = p.out + O_YP; a.xout_lat = p.out + O_YS; } }
  return a;
}
DI void run_phase(KP4 kp, int ph, unsigned char* smem, unsigned long long* tc) {
  MKP;
  if (ph == 0) { phase_init(p, smem); return; }
  const int bid = lbid(), nb = gridDim.x;
  const bool g2 = (bid & 7) < 2;
  const int vb2 = (bid >> 3) * 6 + ((bid & 7) - 2), nvb2 = (nb >> 3) * 6;
  int ew_kind = -1, ew_l = 0, ew_lo = 0, ew_hi = M_TOT, ew_vb = bid, ew_nvb = nb;
  if (ph == N_PHASES - 1) { ew_kind = 3; ew_l = 3; ew_lo = R_SPLIT; }
  else {
    const int l = (ph - 1) / PPL, j = (ph - 1) % PPL;
    switch (j) {
      case 0: convert_layer(p, l, smem);
        if (l == 0) { ew_kind = 0; } else { ew_kind = 3; ew_l = l - 1; ew_lo = R_SPLIT; } break;
      case 1: case 11: phase_gemm_gu(p, j == 11 ? 1 : 0, smem); break;
      case 2: case 3: case 12: case 13: {
        const int i = j >= 12 ? 1 : 0, round = j & 1;
        if (round == 0 || g2) phase_gemm_down(p, i, smem, round);
        else { ew_kind = i ? 3 : 1; ew_l = l; ew_hi = R_SPLIT; ew_vb = vb2; ew_nvb = nvb2; }
      } break;
      case 4: ew_kind = 1; ew_l = l; ew_lo = R_SPLIT; break;
      case 5: phase_gemm_win(p, l, smem); break;
      case 6: phase_prep(p, l, smem, (unsigned*)(GAS unsigned*)(kq->ws + OFF_BAR) + 3610 + l); break;
      case 7: phase_qkv(p, l, smem, (unsigned*)(GAS unsigned*)(kq->ws + OFF_BAR) + 3670 + l); break;
      case 8: phase_mixers(p, l, smem, (unsigned*)(GAS unsigned*)(kq->ws + OFF_BAR) + 3620 + l * 8, tc); break;
      case 9: phase_gemm_wout(p, smem); break;
      case 10: ew_kind = 2; ew_l = l; break;
    }
  }
  if (ew_kind >= 0) { const EwArgs a = ew_args(p, ew_kind, ew_l, ew_lo, ew_hi, ew_vb, ew_nvb); phase_ew(p, a); }
}

__global__ void __launch_bounds__(NT, 2) fwd_kernel(PArg pa, int ph_lo, int ph_hi) {
  extern __shared__ __attribute__((aligned(16))) unsigned char smem[];
  KP4 kp = (KP4)__builtin_amdgcn_kernarg_segment_ptr();
#if MULTI_LAUNCH
  unsigned long long tdummy = 0; for (int ph = ph_lo; ph < ph_hi; ++ph) run_phase(kp, ph, smem, &tdummy);
#else
  cg::grid_group grid = cg::this_grid();
  __shared__ uint4 xb_words;
  if (ltid() == 0) { xb_words = make_uint4(0u, 0u, 0u, 0u); if (PROBE_SPIN >= 9) ((volatile unsigned long long*)(smem + S_ITEM_OFF + 16))[1] = 0ull; }
  __syncthreads();
  const XcdBarrier xb = xcd_barrier_post((unsigned*)(pa.ws + OFF_BAR), (volatile LAS unsigned*)&xb_words);
#ifndef PROBE_SPIN
#define PROBE_SPIN 0
#endif
  unsigned long long tacc = 0;
  for (int ph = ph_lo; ph < ph_hi; ++ph) {
    const unsigned long long t0 = PROBE_SPIN ? __builtin_amdgcn_s_memrealtime() : 0ull;
    run_phase(kp, ph, smem, &tacc);
    if (ph + 1 < ph_hi) { if (ph == ph_lo) grid.sync(); else xcd_barrier(xb); }
    if (PROBE_SPIN) {
      const int j = (ph - 1) % PPL;
      const bool lay = ph >= 1 && ph < N_PHASES - 1;
      bool hit = false;
      if (PROBE_SPIN == 1) hit = lay && (j == 1 || j == 11);
      if (PROBE_SPIN == 2) hit = lay && (j == 2 || j == 3 || j == 12 || j == 13);
      if (PROBE_SPIN == 3) hit = ph == 0;
      if (PROBE_SPIN == 4) hit = lay && j == 6;
      if (PROBE_SPIN == 5) hit = lay && j == 8;
      if (PROBE_SPIN == 6) hit = lay && j == 7;
      if (PROBE_SPIN == 7) hit = lay && (j == 5 || j == 9);
      if (PROBE_SPIN == 8) hit = (lay && (j == 0 || j == 4 || j == 10)) || ph == N_PHASES - 1;
      if (hit) tacc += __builtin_amdgcn_s_memrealtime() - t0;
    }
  }
  if (PROBE_SPIN && blockIdx.x == 0 && threadIdx.x == 0) {
    if (PROBE_SPIN >= 9) tacc = ((volatile unsigned long long*)(smem + S_ITEM_OFF + 16))[1];
    const unsigned long long te = __builtin_amdgcn_s_memrealtime();
    while (__builtin_amdgcn_s_memrealtime() - te < tacc * 4ull) __builtin_amdgcn_s_sleep(8);
  }
#endif
}

extern "C" void kernel_launch(void* const* d_in, const int* in_sizes, int n_in, void* d_out, int out_size, void* d_ws, size_t ws_size,
                              hipStream_t stream) {
  PArg p{};
  for (int i = 0; i < 25; ++i) p.in[i] = (const float*)d_in[i];
  p.out = (float*)d_out;
  p.ws = (unsigned char*)d_ws;
  if (WS_NEED > ws_size) { fprintf(stderr, "workspace too small: need %zu have %zu\n", (size_t)WS_NEED, ws_size); return; }
#if MULTI_LAUNCH
  for (int ph = 0; ph < N_PHASES; ++ph) hipLaunchKernelGGL(fwd_kernel, dim3(256), dim3(NT), LDS_TOTAL, stream, p, ph, ph + 1);
#else
  static int grid_blocks = 0;
  if (!grid_blocks) {
    int dev = 0, cus = 0, per_cu = 0;
    (void)hipGetDevice(&dev);
    (void)hipDeviceGetAttribute(&cus, hipDeviceAttributeMultiprocessorCount, dev);
    if (hipFuncSetAttribute((const void*)fwd_kernel, hipFuncAttributeMaxDynamicSharedMemorySize, LDS_TOTAL) != hipSuccess) { fprintf(stderr, "hipFuncSetAttribute failed\n"); grid_blocks = -1; return; }
    (void)hipOccupancyMaxActiveBlocksPerMultiprocessor(&per_cu, fwd_kernel, NT, LDS_TOTAL);
    if (per_cu < 1) fprintf(stderr, "note: occupancy query reports %d blocks per CU\n", per_cu);
    (void)hipGetLastError();
    grid_blocks = cus;
  }
  if (grid_blocks < 0) return;
  (void)hipMemsetAsync((unsigned char*)d_ws + OFF_BAR, 0, 16384, stream);
  int lo = 0, hi = N_PHASES;
  void* args[] = {&p, &lo, &hi};
  hipError_t e = hipLaunchCooperativeKernel((void*)fwd_kernel, dim3(grid_blocks), dim3(NT), args, LDS_TOTAL, stream);
  if (e != hipSuccess) fprintf(stderr, "cooperative launch failed: %s (grid %d)\n", hipGetErrorString(e), grid_blocks);
#endif
}
```

```cpp
#include <hip/hip_runtime.h>
#include <hip/hip_cooperative_groups.h>
#include <cstdio>
#include <cstdint>
namespace cg = cooperative_groups;

#ifndef PROBE_SPIN
#define PROBE_SPIN 0
#endif
#ifndef MULTI_LAUNCH
#define MULTI_LAUNCH 0
#endif

#define DI __device__ __forceinline__
typedef unsigned short bf16_t;
typedef short bf16x8 __attribute__((ext_vector_type(8)));
typedef short bf16x4 __attribute__((ext_vector_type(4)));
typedef float f32x16 __attribute__((ext_vector_type(16)));
typedef unsigned u32x4 __attribute__((ext_vector_type(4)));
typedef unsigned u32x2 __attribute__((ext_vector_type(2)));
#define MFMA32(a, b, c) __builtin_amdgcn_mfma_f32_32x32x16_bf16((a), (b), (c), 0, 0, 0)

constexpr int NT = 512, NW = NT / 64, VT = 256, VW = 4;
constexpr int HALF_BYTES = 61440, S_ITEM_OFF = 131072, LDS_TOTAL = 131072 + 64;
constexpr int DM = 1024, M_CTX = 4096, M_LAT = 16384, M_TOT = 20480, M_EXT = 21504;
constexpr int DFF = 2816, DIN = 2240;
constexpr float EPS = 1e-6f;
constexpr int SMEM_BYTES = 60 * 1024;
constexpr int PITCH = 72;
constexpr int ZQG = 0, ZKG = 256, ZVG = 512, ZRG = 768, ZAF = 1024, ZQS = 1056, ZKS = 1312, ZVS = 1440, ZF = 1568, ZQA = 1824, ZKVA = 2080, ZKR = 2208;
constexpr size_t O_YP = 0, O_YS = 4194304, O_ST = 20971520, O_SK = 23068672, O_SV = 25165824, O_CKV = 27262976, O_KR = 29360128;

struct Params {
  const float *x_prompt, *x_sample, *c, *state_gla, *cache_swa_k, *cache_swa_v, *cache_mla_ckv, *cache_mla_krope, *c_ctx,
      *w_mod, *b_mod, *g_norm, *w_gate, *w_up, *w_down, *w_in, *gla_w_gate, *gla_b_gate, *gla_g_out, *swa_sink, *mla_g_q,
      *mla_g_kv, *w_qb, *w_kvb, *w_out;
  float* out;
  float *X, *F, *MOD, *ROPE_S, *ROPE_M, *GLA_B, *GLA_DL;
  bf16_t *H, *TWL, *TWC, *WGU, *WD, *WIN, *WOUT, *WQB, *WKVB, *ACT, *Z, *QS, *KS, *VS, *CKV, *QLAT, *KR, *QM, *KV, *ABTL,
      *ABTC, *GLA_S, *MIX, *DFTW, *ABTF;
};

constexpr size_t al256(size_t x) { return (x + 255) & ~(size_t)255; }
constexpr size_t OFF_X = 0;
constexpr size_t OFF_H = OFF_X + al256((size_t)M_TOT * DM * 4);
constexpr size_t OFF_MOD = OFF_H + al256((size_t)M_TOT * DM * 2);
constexpr size_t OFF_ROPE_S = OFF_MOD + al256((size_t)4 * 5 * 9216 * 4);
constexpr size_t OFF_ROPE_M = OFF_ROPE_S + al256(64 * 16 * 2 * 4);
constexpr size_t OFF_TWL = OFF_ROPE_M + al256(64 * 8 * 2 * 4);
constexpr size_t OFF_TWC = OFF_TWL + al256((size_t)4096 * 8192 * 2);
constexpr size_t OFF_WGU = OFF_TWC + al256((size_t)256 * 512 * 2);
constexpr size_t OFF_WD = OFF_WGU + al256((size_t)2 * 5632 * 1024 * 2);
constexpr size_t OFF_WIN = OFF_WD + al256((size_t)2 * 1024 * DFF * 2);
constexpr size_t OFF_WOUT = OFF_WIN + al256((size_t)2304 * 1024 * 2);
constexpr size_t OFF_WQB = OFF_WOUT + al256((size_t)1024 * 1024 * 2);
constexpr size_t OFF_WKVB = OFF_WQB + al256((size_t)384 * 256 * 2);
constexpr size_t OFF_Z = OFF_WKVB + al256((size_t)512 * 128 * 2);
constexpr size_t OFF_QS = OFF_Z + al256((size_t)M_TOT * DIN * 2);
constexpr size_t OFF_KS = OFF_QS + al256((size_t)M_TOT * 256 * 2);
constexpr size_t OFF_VS = OFF_KS + al256((size_t)M_EXT * 128 * 2);
constexpr size_t OFF_CKV = OFF_VS + al256((size_t)M_EXT * 128 * 2);
constexpr size_t OFF_QLAT = OFF_CKV + al256((size_t)M_EXT * 128 * 2);
constexpr size_t OFF_KR = OFF_QLAT + al256((size_t)M_TOT * 256 * 2);
constexpr size_t OFF_QM = OFF_KR + al256((size_t)M_EXT * 32 * 2);
constexpr size_t OFF_KV = OFF_QM + al256((size_t)M_TOT * 384 * 2);
constexpr size_t OFF_ABTL = OFF_KV + al256((size_t)M_EXT * 512 * 2);
constexpr size_t OFF_ABTC = OFF_ABTL + al256((size_t)4 * 256 * 8192 * 2);
constexpr size_t OFF_GLA_B = OFF_ABTC + al256((size_t)16 * 256 * 512 * 2);
constexpr size_t OFF_GLA_DL = OFF_GLA_B + al256((size_t)2560 * 4096 * 4);
constexpr size_t OFF_GLA_S = OFF_GLA_DL + al256((size_t)2560 * 64 * 4);
constexpr size_t OFF_MIX = OFF_GLA_S + al256((size_t)2560 * 4096 * 2);
constexpr size_t OFF_BAR = OFF_MIX + al256((size_t)M_TOT * 1024 * 2);
constexpr size_t OFF_DFTW = OFF_BAR + al256(16384);
constexpr size_t OFF_ABTF = OFF_DFTW + al256(128 * 64 * 2);
constexpr size_t OFF_END0 = OFF_ABTF + al256((size_t)4 * 256 * 4096 * 2);
constexpr size_t OFF_ACTEND = OFF_QS + al256((size_t)M_TOT * DFF * 2);
constexpr size_t WS_NEED = OFF_END0 > OFF_ACTEND ? OFF_END0 : OFF_ACTEND;
struct PArg { const float* in[25]; float* out; unsigned char* ws; };
#define GAS __attribute__((address_space(1)))
struct PArgG { GAS const float* in[25]; GAS float* out; GAS unsigned char* ws; };
typedef const __attribute__((address_space(4))) PArgG* KP4;
DI Params make_params(KP4 ap) {
  Params p;
  p.x_prompt = (const float*)ap->in[0];
  p.x_sample = (const float*)ap->in[1];
  p.c = (const float*)ap->in[2];
  p.state_gla = (const float*)ap->in[3];
  p.cache_swa_k = (const float*)ap->in[4];
  p.cache_swa_v = (const float*)ap->in[5];
  p.cache_mla_ckv = (const float*)ap->in[6];
  p.cache_mla_krope = (const float*)ap->in[7];
  p.c_ctx = (const float*)ap->in[8];
  p.w_mod = (const float*)ap->in[9];
  p.b_mod = (const float*)ap->in[10];
  p.g_norm = (const float*)ap->in[11];
  p.w_gate = (const float*)ap->in[12];
  p.w_up = (const float*)ap->in[13];
  p.w_down = (const float*)ap->in[14];
  p.w_in = (const float*)ap->in[15];
  p.gla_w_gate = (const float*)ap->in[16];
  p.gla_b_gate = (const float*)ap->in[17];
  p.gla_g_out = (const float*)ap->in[18];
  p.swa_sink = (const float*)ap->in[19];
  p.mla_g_q = (const float*)ap->in[20];
  p.mla_g_kv = (const float*)ap->in[21];
  p.w_qb = (const float*)ap->in[22];
  p.w_kvb = (const float*)ap->in[23];
  p.w_out = (const float*)ap->in[24];
  p.out = (float*)ap->out;
  p.X = (float*)(GAS float*)(ap->ws + OFF_X);
  p.H = (bf16_t*)(GAS bf16_t*)(ap->ws + OFF_H);
  p.MOD = (float*)(GAS float*)(ap->ws + OFF_MOD);
  p.ROPE_S = (float*)(GAS float*)(ap->ws + OFF_ROPE_S);
  p.ROPE_M = (float*)(GAS float*)(ap->ws + OFF_ROPE_M);
  p.TWL = (bf16_t*)(GAS bf16_t*)(ap->ws + OFF_TWL);
  p.TWC = (bf16_t*)(GAS bf16_t*)(ap->ws + OFF_TWC);
  p.WGU = (bf16_t*)(GAS bf16_t*)(ap->ws + OFF_WGU);
  p.WD = (bf16_t*)(GAS bf16_t*)(ap->ws + OFF_WD);
  p.WIN = (bf16_t*)(GAS bf16_t*)(ap->ws + OFF_WIN);
  p.WOUT = (bf16_t*)(GAS bf16_t*)(ap->ws + OFF_WOUT);
  p.WQB = (bf16_t*)(GAS bf16_t*)(ap->ws + OFF_WQB);
  p.WKVB = (bf16_t*)(GAS bf16_t*)(ap->ws + OFF_WKVB);
  p.Z = (bf16_t*)(GAS bf16_t*)(ap->ws + OFF_Z);
  p.QS = (bf16_t*)(GAS bf16_t*)(ap->ws + OFF_QS);
  p.KS = (bf16_t*)(GAS bf16_t*)(ap->ws + OFF_KS);
  p.VS = (bf16_t*)(GAS bf16_t*)(ap->ws + OFF_VS);
  p.CKV = (bf16_t*)(GAS bf16_t*)(ap->ws + OFF_CKV);
  p.QLAT = (bf16_t*)(GAS bf16_t*)(ap->ws + OFF_QLAT);
  p.KR = (bf16_t*)(GAS bf16_t*)(ap->ws + OFF_KR);
  p.QM = (bf16_t*)(GAS bf16_t*)(ap->ws + OFF_QM);
  p.KV = (bf16_t*)(GAS bf16_t*)(ap->ws + OFF_KV);
  p.ABTL = (bf16_t*)(GAS bf16_t*)(ap->ws + OFF_ABTL);
  p.ABTC = (bf16_t*)(GAS bf16_t*)(ap->ws + OFF_ABTC);
  p.GLA_B = (float*)(GAS float*)(ap->ws + OFF_GLA_B);
  p.GLA_DL = (float*)(GAS float*)(ap->ws + OFF_GLA_DL);
  p.GLA_S = (bf16_t*)(GAS bf16_t*)(ap->ws + OFF_GLA_S);
  p.MIX = (bf16_t*)(GAS bf16_t*)(ap->ws + OFF_MIX);
  p.DFTW = (bf16_t*)(GAS bf16_t*)(ap->ws + OFF_DFTW);
  p.ABTF = (bf16_t*)(GAS bf16_t*)(ap->ws + OFF_ABTF);
  p.F = (float*)(GAS float*)(ap->ws + OFF_Z);
  p.ACT = (bf16_t*)(GAS bf16_t*)(ap->ws + OFF_QS);
  return p;
}

DI int ltid() { int t = __builtin_amdgcn_workitem_id_x(); asm volatile("" : "+v"(t)); return t; }
DI int vtid() { return ltid() & 255; }
DI int vhalf() { return ltid() >> 8; }
DI int lbid() { int t = __builtin_amdgcn_workgroup_id_x(); asm volatile("" : "+s"(t)); return t; }
typedef float f32x2_t __attribute__((ext_vector_type(2)));
typedef __bf16 bf16x2_t __attribute__((ext_vector_type(2)));
DI bf16_t f2bf(float x) { return __builtin_bit_cast(bf16_t, (__bf16)x); }
DI float bf2f(bf16_t b) { return __uint_as_float(((unsigned)b) << 16); }
DI unsigned pack2(float a, float b) { f32x2_t v = {a, b}; return __builtin_bit_cast(unsigned, __builtin_convertvector(v, bf16x2_t)); }
DI float shx(float v, int o) { const int ln = ltid() & 63; return __int_as_float(__builtin_amdgcn_ds_bpermute((ln ^ o) << 2, __float_as_int(v))); }
DI float wave_sum(float v) {
#pragma unroll
  for (int o = 32; o > 0; o >>= 1) v += shx(v, o);
  return v;
}
DI float silu_f(float x) { return x * __builtin_amdgcn_rcpf(1.f + __builtin_amdgcn_exp2f(-1.4426950408889634f * x)); }
DI int crow(int r, int h) { return (r & 3) + 8 * (r >> 2) + 4 * h; }


#define XB_TMO      128
#define XB_XCNT(j)  (256  + 64 * (j))
#define XB_XSUB(j)  (1280 + 64 * (j))
#define XB_XGEN(j)  (2304 + 64 * (j))
#define XB_TOP      3328
#define XB_TOPGEN   3392
#define XCD_BAR_WORDS 3456
#define XB_SPIN_CAP (1u << 22)
#define LAS __attribute__((address_space(3)))
DI unsigned xb_ld(unsigned* p) { return __hip_atomic_load(p, __ATOMIC_RELAXED, __HIP_MEMORY_SCOPE_AGENT); }
DI unsigned xb_add(unsigned* p, unsigned v) { return __hip_atomic_fetch_add(p, v, __ATOMIC_RELAXED, __HIP_MEMORY_SCOPE_AGENT); }
DI unsigned xb_xcc_id() { return (unsigned)__builtin_amdgcn_s_getreg((3 << 11) | 20) & 0xFu; }
#define XB_SPIN(cond, bar) do { unsigned _sp = 0; while (cond) { __builtin_amdgcn_s_sleep(1); \
    if ((++_sp & 255u) == 0u) { if (xb_ld(&(bar)[XB_TMO])) break; if (_sp > XB_SPIN_CAP) { atomicAdd(&(bar)[XB_TMO], 1u); break; } } } } while (0)
struct XcdBarrier { unsigned* bar; unsigned x; volatile LAS unsigned* st; };
DI XcdBarrier xcd_barrier_post(unsigned* bar, volatile LAS unsigned* st) {
  XcdBarrier b; b.bar = bar; b.x = xb_xcc_id(); b.st = st;
  if (ltid() == 0) (void)xb_add(&bar[XB_XCNT(b.x)], 1u);
  return b;
}
DI void xcd_barrier_complete(unsigned* bar, unsigned x, unsigned& nloc, unsigned& nx) {
  const unsigned G = gridDim.x * gridDim.y * gridDim.z;
  unsigned sum, cnt, mine, sp = 0u;
  for (;;) {
    sum = 0u; cnt = 0u; mine = 0u;
#pragma unroll
    for (unsigned j = 0; j < 16; ++j) { const unsigned c = xb_ld(&bar[XB_XCNT(j)]); sum += c; cnt += (c > 0u) ? 1u : 0u; mine = (j == x) ? c : mine; }
    if (sum == G) break;
    __builtin_amdgcn_s_sleep(1);
    if ((++sp & 255u) == 0u) { if (xb_ld(&bar[XB_TMO])) break; if (sp > XB_SPIN_CAP) { atomicAdd(&bar[XB_TMO], 1u); break; } }
  }
  nloc = mine > 0u ? mine : 1u; nx = cnt > 0u ? cnt : 1u;
}
DI void xcd_barrier(const XcdBarrier& b) {
  asm volatile("s_waitcnt vmcnt(0)" ::: "memory");
  __syncthreads();
  if (ltid() == 0) {
    unsigned* bar = b.bar;
    __builtin_amdgcn_s_waitcnt(0);
    unsigned nloc = b.st[0], nx = b.st[1];
    if (nloc == 0u) { xcd_barrier_complete(bar, b.x, nloc, nx); b.st[0] = nloc; b.st[1] = nx; }
    const unsigned old = xb_add(&bar[XB_XSUB(b.x)], 1u);
    const unsigned gen = old / nloc;
    if (old + 1u == (gen + 1u) * nloc) {
      __builtin_amdgcn_fence(__ATOMIC_RELEASE, "agent");
      asm volatile("s_waitcnt vmcnt(0)" ::: "memory");
      const unsigned og = xb_add(&bar[XB_TOP], 1u);
      const unsigned tg = og / nx;
      if (og + 1u == (tg + 1u) * nx) xb_add(&bar[XB_TOPGEN], 1u);
      else XB_SPIN(xb_ld(&bar[XB_TOPGEN]) == tg, bar);
      __builtin_amdgcn_fence(__ATOMIC_ACQUIRE, "agent");
      xb_add(&bar[XB_XGEN(b.x)], 1u);
      asm volatile("s_waitcnt vmcnt(0)" ::: "memory");
    } else {
      XB_SPIN(xb_ld(&bar[XB_XGEN(b.x)]) == gen, bar);
      __builtin_amdgcn_fence(__ATOMIC_ACQUIRE, "agent");
      asm volatile("s_waitcnt vmcnt(0)" ::: "memory");
    }
  }
  __syncthreads();
}

template <int MB, class Epi>
DI void gemm_tile(const bf16_t* __restrict__ A, int lda, const bf16_t* __restrict__ Bt, int ldb, int K, int m0, int n0,
                  unsigned char* smem, const Epi& epi) {
  constexpr int BMR = 128 * MB, NA = 2 * MB;
  bf16_t* sA = (bf16_t*)smem;
  bf16_t* sB = sA + BMR * PITCH;
  const int tid = ltid(), lane = tid & 63, wid = tid >> 6, wm = wid >> 1, wn = wid & 1, l31 = lane & 31, h = lane >> 5;
  f32x16 acc[2][MB];
#pragma unroll
  for (int a = 0; a < 2; ++a)
#pragma unroll
    for (int b = 0; b < MB; ++b)
#pragma unroll
      for (int i = 0; i < 16; ++i) acc[a][b][i] = 0.f;
  const int lrow = tid >> 3, lkc = tid & 7;
  const bf16_t* Ap = A + (size_t)(m0 + lrow) * lda + lkc * 8;
  const bf16_t* Bp = Bt + (size_t)(n0 + lrow) * ldb + lkc * 8;
  const size_t sa32 = (size_t)64 * lda, sb32 = (size_t)64 * ldb;
  bf16_t* wA = sA + lrow * PITCH + lkc * 8;
  bf16_t* wB = sB + lrow * PITCH + lkc * 8;
  u32x4 ra[NA], rb[2];
#pragma unroll
  for (int i = 0; i < NA; ++i) ra[i] = *(const u32x4*)(Ap + i * sa32);
#pragma unroll
  for (int i = 0; i < 2; ++i) rb[i] = *(const u32x4*)(Bp + i * sb32);
  for (int k0 = 0; k0 < K; k0 += 64) {
    __syncthreads();
#pragma unroll
    for (int i = 0; i < NA; ++i) *(u32x4*)(wA + i * 64 * PITCH) = ra[i];
#pragma unroll
    for (int i = 0; i < 2; ++i) *(u32x4*)(wB + i * 64 * PITCH) = rb[i];
    __syncthreads();
    {
      const int kn = (k0 + 64 < K) ? k0 + 64 : k0;
#pragma unroll
      for (int i = 0; i < NA; ++i) ra[i] = *(const u32x4*)(Ap + kn + i * sa32);
#pragma unroll
      for (int i = 0; i < 2; ++i) rb[i] = *(const u32x4*)(Bp + kn + i * sb32);
    }
#pragma unroll
    for (int ks = 0; ks < 4; ++ks) {
      bf16x8 af[MB], bfr[2];
#pragma unroll
      for (int b = 0; b < MB; ++b) af[b] = *(const bf16x8*)(sA + (wm * 32 * MB + b * 32 + l31) * PITCH + ks * 16 + h * 8);
#pragma unroll
      for (int b = 0; b < 2; ++b) bfr[b] = *(const bf16x8*)(sB + (wn * 64 + b * 32 + l31) * PITCH + ks * 16 + h * 8);

#pragma unroll
      for (int nb = 0; nb < 2; ++nb)
#pragma unroll
        for (int mb = 0; mb < MB; ++mb) acc[nb][mb] = MFMA32(bfr[nb], af[mb], acc[nb][mb]);

    }
  }
  epi(acc, m0 + wm * 32 * MB, n0 + wn * 64, l31, h);
}

struct EpiF32 {
  float* C; int ldc;
  template <int MB> DI void operator()(const f32x16 (&acc)[2][MB], int mb0, int nb0, int l31, int h) const {
#pragma unroll
    for (int nb = 0; nb < 2; ++nb)
#pragma unroll
      for (int mb = 0; mb < MB; ++mb) {
        float* row = C + (size_t)(mb0 + mb * 32 + l31) * ldc + nb0 + nb * 32 + 4 * h;
#pragma unroll
        for (int g = 0; g < 4; ++g)
          *(float4*)(row + 8 * g) = make_float4(acc[nb][mb][4 * g], acc[nb][mb][4 * g + 1], acc[nb][mb][4 * g + 2], acc[nb][mb][4 * g + 3]);
      }
  }
};
struct EpiBf16 {
  bf16_t* C; int ldc; float scale; int ncols;
  template <int MB> DI void operator()(const f32x16 (&acc)[2][MB], int mb0, int nb0, int l31, int h) const {
#pragma unroll
    for (int nb = 0; nb < 2; ++nb)
#pragma unroll
      for (int mb = 0; mb < MB; ++mb) {
        const int col0 = nb0 + nb * 32 + 4 * h;
        bf16_t* row = C + (size_t)(mb0 + mb * 32 + l31) * ldc + col0;
#pragma unroll
        for (int g = 0; g < 4; ++g) {
          if (col0 + 8 * g < ncols) {
            uint2 w;
            w.x = pack2(acc[nb][mb][4 * g] * scale, acc[nb][mb][4 * g + 1] * scale);
            w.y = pack2(acc[nb][mb][4 * g + 2] * scale, acc[nb][mb][4 * g + 3] * scale);
            *(uint2*)(row + 8 * g) = w;
          }
        }
      }
  }
};
struct EpiGateUp {
  bf16_t* C;
  template <int MB> DI void operator()(const f32x16 (&acc)[2][MB], int mb0, int nb0, int l31, int h) const {
#pragma unroll
    for (int mb = 0; mb < MB; ++mb) {
      bf16_t* row = C + (size_t)(mb0 + mb * 32 + l31) * DFF + (nb0 >> 1) + 4 * h;
#pragma unroll
      for (int g = 0; g < 4; ++g) {
        float v[4];
#pragma unroll
        for (int i = 0; i < 4; ++i) v[i] = silu_f(acc[0][mb][4 * g + i]) * acc[1][mb][4 * g + i];
        uint2 w; w.x = pack2(v[0], v[1]); w.y = pack2(v[2], v[3]);
        *(uint2*)(row + 8 * g) = w;
      }
    }
  }
};
struct EpiWin {
  bf16_t* Z; float* out; int l;
  template <int MB> DI void operator()(const f32x16 (&acc)[2][MB], int mb0, int nb0, int l31, int h) const {
#pragma unroll
    for (int nb = 0; nb < 2; ++nb)
#pragma unroll
      for (int mb = 0; mb < MB; ++mb) {
        const int m = mb0 + mb * 32 + l31;
        const int col0 = nb0 + nb * 32 + 4 * h;
        bf16_t* row = Z + (size_t)m * DIN + col0;
#pragma unroll
        for (int g = 0; g < 4; ++g) {
          const int col = col0 + 8 * g;
          if (col < DIN) {
            uint2 w;
            w.x = pack2(acc[nb][mb][4 * g], acc[nb][mb][4 * g + 1]);
            w.y = pack2(acc[nb][mb][4 * g + 2], acc[nb][mb][4 * g + 3]);
            *(uint2*)(row + 8 * g) = w;
            if (m < M_CTX) {
              const int b = m >> 8, s = m & 255;
              const size_t tok = (size_t)((b * 4 + l) * 256 + s);
              float* dst = nullptr;
              if (col >= ZKS && col < ZVS) dst = out + O_SK + tok * 128 + (col - ZKS);
              else if (col >= ZVS && col < ZF) dst = out + O_SV + tok * 128 + (col - ZVS);
              else if (col >= ZKR) dst = out + O_KR + tok * 32 + (col - ZKR);
              if (dst) *(float4*)dst = make_float4(acc[nb][mb][4 * g], acc[nb][mb][4 * g + 1], acc[nb][mb][4 * g + 2], acc[nb][mb][4 * g + 3]);
            }
          }
        }
      }
  }
};
struct EpiQm {
  bf16_t* C; const float* rope_m;
  template <int MB> DI void operator()(const f32x16 (&acc)[2][MB], int mb0, int nb0, int l31, int h) const {
#pragma unroll
    for (int nb = 0; nb < 2; ++nb) {
      const int cb = nb0 + nb * 32;
      const bool isrope = ((cb >> 5) % 3) == 2;
#pragma unroll
      for (int mb = 0; mb < MB; ++mb) {
        const int m = mb0 + mb * 32 + l31;
        float v[16];
#pragma unroll
        for (int i = 0; i < 16; ++i) v[i] = acc[nb][mb][i];
        if (isrope && m >= M_CTX) {
          const int t = (m - M_CTX) & 4095;
          const int prow = t >> 6, pcol = t & 63;
#pragma unroll
          for (int half = 0; half < 2; ++half) {
            const int pos = half ? pcol : prow;
#pragma unroll
            for (int i = 0; i < 4; ++i) {
              const int j = 4 * h + i;
              const float cs = rope_m[(pos * 8 + j) * 2], sn = rope_m[(pos * 8 + j) * 2 + 1];
              const float x1 = v[8 * half + i], x2 = v[8 * half + 4 + i];
              v[8 * half + i] = x1 * cs - x2 * sn;
              v[8 * half + 4 + i] = x2 * cs + x1 * sn;
            }
          }
        }
        bf16_t* row = C + (size_t)m * 384 + cb + 4 * h;
#pragma unroll
        for (int g = 0; g < 4; ++g) {
          uint2 w; w.x = pack2(v[4 * g], v[4 * g + 1]); w.y = pack2(v[4 * g + 2], v[4 * g + 3]);
          *(uint2*)(row + 8 * g) = w;
        }
      }
    }
  }
};

struct EpiDft {
  bf16_t* ABTL; bf16_t* ABTC; int g;
  template <int MB> DI void operator()(const f32x16 (&acc)[2][MB], int mb0, int nb0, int l31, int h) const {
    const int type = nb0 >> 6;
#pragma unroll
    for (int mb = 0; mb < MB; ++mb) {
      const int m = mb0 + mb * 32 + l31;
      bf16_t* base; size_t stride;
      if (m >= M_CTX) { const int b = (m - M_CTX) >> 12, sq = (m - M_CTX) & 4095; base = ABTL + ((size_t)b * 256 + g * 64) * 8192 + type * 4096 + sq; stride = 8192; }
      else { const int b = m >> 8, sq = m & 255; base = ABTC + ((size_t)b * 256 + g * 64) * 512 + type * 256 + sq; stride = 512; }
#pragma unroll
      for (int nb = 0; nb < 2; ++nb)
#pragma unroll
        for (int i = 0; i < 16; ++i) base[(size_t)(nb * 32 + crow(i, h)) * stride] = f2bf(acc[nb][mb][i]);
    }
  }
};


typedef float f32x4v __attribute__((ext_vector_type(4)));
DI int g8_lds_byte(int r, int c) { const int st = (r >> 4) * 2 + (c >> 5), rr = r & 15, cc = c & 31, ob = rr * 64 + cc * 2; return st * 1024 + (ob ^ (((ob >> 9) & 1) << 5)); }
DI void g8_stage_rc(int b, int& R, int& C) { const int st = b / 1024, sb = b % 1024, swz = sb ^ (((sb >> 9) & 1) << 5); R = (st >> 1) * 16 + swz / 64; C = (st & 1) * 32 + (swz % 64) / 2; }
DI const char* uni_ptr(const void* p) { const unsigned long long v = (unsigned long long)p; const unsigned lo = __builtin_amdgcn_readfirstlane((unsigned)v), hi = __builtin_amdgcn_readfirstlane((unsigned)(v >> 32)); return (const char*)(((unsigned long long)hi << 32) | lo); }
template <class Epi>
DI void gemm8_tile(const bf16_t* __restrict__ A, const bf16_t* __restrict__ Bt, int K, int brow, int bcol, unsigned char* smem, const Epi& epi,
                   bool first = true, bool has_next = false, int nbrow = 0, int nbcol = 0) {
  constexpr int HTB = 16384;
  const int tid = ltid(), wid = tid >> 6, lane = tid & 63, wr = wid >> 2, wc = wid & 3, fr = lane & 15, fq = lane >> 4;
  int sr0, sc0, sr1, sc1;
  g8_stage_rc(tid * 16, sr0, sc0); g8_stage_rc(tid * 16 + 8192, sr1, sc1);
  const unsigned bo0 = (unsigned)(sr0 * K + sc0) * 2u;
  const int swz_ = (fr * 64 + fq * 16) ^ ((((fr * 64 + fq * 16) >> 9) & 1) << 5);
  const int aoff = wr * 8192 + swz_, boff = wc * 4096 + swz_;
#define G8_SA(b, h) (smem + ((b) * 2 + (h)) * HTB)
#define G8_SB(b, h) (smem + (4 + (b) * 2 + (h)) * HTB)
#define G8_STAGE(P, BASE, br, kt) do { const char* _g = uni_ptr((BASE) + (size_t)(br) * K + (size_t)(kt) * 64); \
    const char* _g2 = uni_ptr(_g + (size_t)128 * K); \
    __builtin_amdgcn_global_load_lds((const unsigned*)(_g + bo0), (unsigned*)((P) + tid * 16), 16, 0, 0); \
    __builtin_amdgcn_global_load_lds((const unsigned*)(_g2 + bo0), (unsigned*)((P) + tid * 16 + 8192), 16, 0, 0); } while (0)
#define G8_LDA(dst, b, h) _Pragma("unroll") for (int m = 0; m < 4; ++m) _Pragma("unroll") for (int k = 0; k < 2; ++k) \
    dst[m][k] = *(const bf16x8*)(G8_SA(b, h) + aoff + m * 2048 + k * 1024)
#define G8_LDB(dst, b, h) _Pragma("unroll") for (int n = 0; n < 2; ++n) _Pragma("unroll") for (int k = 0; k < 2; ++k) \
    dst[n][k] = *(const bf16x8*)(G8_SB(b, h) + boff + n * 2048 + k * 1024)
#define G8_MMA(ai, bj, At_, Bx_) do { __builtin_amdgcn_s_setprio(1); \
    _Pragma("unroll") for (int m = 0; m < 4; ++m) _Pragma("unroll") for (int n = 0; n < 2; ++n) _Pragma("unroll") for (int k = 0; k < 2; ++k) \
      acc[ai][bj][m][n] = __builtin_amdgcn_mfma_f32_16x16x32_bf16(Bx_[n][k], At_[m][k], acc[ai][bj][m][n], 0, 0, 0); \
    __builtin_amdgcn_s_setprio(0); } while (0)
#define G8_WAIT_V(n) asm volatile("s_waitcnt vmcnt(" #n ")" ::: "memory")
#define G8_WAIT_L(n) asm volatile("s_waitcnt lgkmcnt(" #n ")" ::: "memory")
#define G8_BAR __builtin_amdgcn_s_barrier()
#define G8_SCHED __builtin_amdgcn_sched_barrier(0)
  f32x4v acc[2][2][4][2];
#pragma unroll
  for (int a = 0; a < 2; ++a)
#pragma unroll
    for (int b = 0; b < 2; ++b)
#pragma unroll
      for (int m = 0; m < 4; ++m)
#pragma unroll
        for (int n = 0; n < 2; ++n) acc[a][b][m][n] = (f32x4v){0.f, 0.f, 0.f, 0.f};
  bf16x8 At[4][2], B0[2][2], B1[2][2];
  const int nt = K / 64;
  if (first) {
    G8_WAIT_V(0);
    __syncthreads();
    G8_STAGE(G8_SB(0, 0), Bt, bcol, 0); G8_STAGE(G8_SA(0, 0), A, brow, 0);
    G8_STAGE(G8_SB(0, 1), Bt, bcol + 128, 0); G8_STAGE(G8_SA(0, 1), A, brow + 128, 0);
  }
  if (wr == 1) G8_BAR;
  G8_WAIT_V(4); G8_BAR;
  G8_STAGE(G8_SB(1, 0), Bt, bcol, 1); G8_STAGE(G8_SA(1, 0), A, brow, 1); G8_STAGE(G8_SB(1, 1), Bt, bcol + 128, 1);
  G8_WAIT_V(6); G8_BAR;
  for (int t = 0; t < nt - 2; t += 2) {
    G8_LDB(B0, 0, 0); G8_SCHED; G8_LDA(At, 0, 0); G8_STAGE(G8_SA(1, 1), A, brow + 128, t + 1);
    G8_WAIT_L(8); G8_BAR; G8_WAIT_L(0); G8_MMA(0, 0, At, B0); G8_BAR; G8_SCHED;
    G8_LDB(B1, 0, 1); G8_STAGE(G8_SB(0, 0), Bt, bcol, t + 2);
    G8_BAR; G8_WAIT_L(0); G8_MMA(0, 1, At, B1); G8_BAR;
    G8_LDA(At, 0, 1); G8_STAGE(G8_SA(0, 0), A, brow, t + 2);
    G8_BAR; G8_WAIT_L(0); G8_MMA(1, 0, At, B0); G8_BAR; G8_SCHED;
    G8_STAGE(G8_SB(0, 1), Bt, bcol + 128, t + 2);
    G8_WAIT_V(6); G8_BAR; G8_MMA(1, 1, At, B1); G8_BAR;
    G8_LDB(B0, 1, 0); G8_SCHED; G8_LDA(At, 1, 0); G8_STAGE(G8_SA(0, 1), A, brow + 128, t + 2);
    G8_WAIT_L(8); G8_BAR; G8_WAIT_L(0); G8_MMA(0, 0, At, B0); G8_BAR; G8_SCHED;
    G8_LDB(B1, 1, 1); G8_STAGE(G8_SB(1, 0), Bt, bcol, t + 3);
    G8_BAR; G8_WAIT_L(0); G8_MMA(0, 1, At, B1); G8_BAR;
    G8_LDA(At, 1, 1); G8_STAGE(G8_SA(1, 0), A, brow, t + 3);
    G8_BAR; G8_WAIT_L(0); G8_MMA(1, 0, At, B0); G8_BAR; G8_SCHED;
    G8_STAGE(G8_SB(1, 1), Bt, bcol + 128, t + 3);
    G8_WAIT_V(6); G8_BAR; G8_MMA(1, 1, At, B1); G8_BAR;
  }
  { G8_LDB(B0, 0, 0); G8_LDA(At, 0, 0); G8_STAGE(G8_SA(1, 1), A, brow + 128, nt - 1);
    G8_BAR; G8_WAIT_L(0); G8_MMA(0, 0, At, B0); G8_BAR;
    G8_LDB(B1, 0, 1); G8_BAR; G8_WAIT_L(0); G8_MMA(0, 1, At, B1); G8_BAR;
    G8_LDA(At, 0, 1); G8_WAIT_V(4); G8_BAR; G8_WAIT_L(0); G8_MMA(1, 0, At, B0); G8_MMA(1, 1, At, B1); G8_BAR; }
  { G8_LDB(B0, 1, 0); G8_LDA(At, 1, 0); G8_WAIT_V(2); G8_BAR; G8_WAIT_L(0); G8_MMA(0, 0, At, B0); G8_BAR;
    G8_LDB(B1, 1, 1); G8_WAIT_V(0); G8_BAR; G8_WAIT_L(0); G8_MMA(0, 1, At, B1); G8_BAR;
    G8_LDA(At, 1, 1); G8_BAR; G8_WAIT_L(0); G8_MMA(1, 0, At, B0); G8_MMA(1, 1, At, B1); G8_BAR; }
  if (wr == 0) G8_BAR;
  if (has_next) {
    G8_STAGE(G8_SB(0, 0), Bt, nbcol, 0); G8_STAGE(G8_SA(0, 0), A, nbrow, 0);
    G8_STAGE(G8_SB(0, 1), Bt, nbcol + 128, 0); G8_STAGE(G8_SA(0, 1), A, nbrow + 128, 0);
  }
  epi(acc, brow, bcol);
}
struct Epi8Bf16 {
  bf16_t* C; int ldc; float scale; int ncols;
  DI void operator()(const f32x4v (&acc)[2][2][4][2], int brow, int bcol) const {
    const int tid_ = ltid(), wid_ = tid_ >> 6, wr = wid_ >> 2, wc = wid_ & 3, fr = tid_ & 15, fq = (tid_ & 63) >> 4;
#pragma unroll
    for (int ai = 0; ai < 2; ++ai)
#pragma unroll
      for (int m = 0; m < 4; ++m) {
        bf16_t* row = C + (size_t)(brow + ai * 128 + wr * 64 + m * 16 + fr) * ldc;
#pragma unroll
        for (int bj = 0; bj < 2; ++bj)
#pragma unroll
          for (int n = 0; n < 2; ++n) {
            const int col = bcol + bj * 128 + wc * 32 + n * 16 + 4 * fq;
            if (col < ncols) {
              const f32x4v v = acc[ai][bj][m][n];
              u32x2 w; w[0] = pack2(v[0] * scale, v[1] * scale); w[1] = pack2(v[2] * scale, v[3] * scale);
              *(u32x2*)(row + col) = w;
            }
          }
      }
  }
};
struct Epi8GateUp {
  bf16_t* C;
  DI void operator()(const f32x4v (&acc)[2][2][4][2], int brow, int bcol) const {
    const int tid_ = ltid(), wid_ = tid_ >> 6, wr = wid_ >> 2, wc = wid_ & 3, fr = tid_ & 15, fq = (tid_ & 63) >> 4;
#pragma unroll
    for (int ai = 0; ai < 2; ++ai)
#pragma unroll
      for (int m = 0; m < 4; ++m) {
        bf16_t* row = C + (size_t)(brow + ai * 128 + wr * 64 + m * 16 + fr) * DFF;
#pragma unroll
        for (int bj = 0; bj < 2; ++bj) {
          const int col = ((bcol + bj * 128 + wc * 32) >> 1) + 4 * fq;
          const f32x4v g = acc[ai][bj][m][0], u = acc[ai][bj][m][1];
          u32x2 w; w[0] = pack2(silu_f(g[0]) * u[0], silu_f(g[1]) * u[1]); w[1] = pack2(silu_f(g[2]) * u[2], silu_f(g[3]) * u[3]);
          *(u32x2*)(row + col) = w;
        }
      }
  }
};
struct Epi8Win {
  bf16_t* Z; float* out; int l;
  DI void operator()(const f32x4v (&acc)[2][2][4][2], int brow, int bcol) const {
    const int tid_ = ltid(), wid_ = tid_ >> 6, wr = wid_ >> 2, wc = wid_ & 3, fr = tid_ & 15, fq = (tid_ & 63) >> 4;
#pragma unroll
    for (int ai = 0; ai < 2; ++ai)
#pragma unroll
      for (int m = 0; m < 4; ++m) {
        const int mrow = brow + ai * 128 + wr * 64 + m * 16 + fr;
        bf16_t* row = Z + (size_t)mrow * DIN;
#pragma unroll
        for (int bj = 0; bj < 2; ++bj)
#pragma unroll
          for (int n = 0; n < 2; ++n) {
            const int col = bcol + bj * 128 + wc * 32 + n * 16 + 4 * fq;
            if (col < DIN) {
              const f32x4v v = acc[ai][bj][m][n];
              u32x2 w; w[0] = pack2(v[0], v[1]); w[1] = pack2(v[2], v[3]);
              *(u32x2*)(row + col) = w;
              if (mrow < M_CTX) {
                const int b = mrow >> 8, sq = mrow & 255;
                const size_t tok = (size_t)((b * 4 + l) * 256 + sq);
                float* dst = nullptr;
                if (col >= ZKS && col < ZVS) dst = out + O_SK + tok * 128 + (col - ZKS);
                else if (col >= ZVS && col < ZF) dst = out + O_SV + tok * 128 + (col - ZVS);
                else if (col >= ZKR) dst = out + O_KR + tok * 32 + (col - ZKR);
                if (dst) *(float4*)dst = make_float4(v[0], v[1], v[2], v[3]);
              }
            }
          }
      }
  }
};

DI void mod_item(const Params& p, int it, unsigned char* smem) {
  float* sc = (float*)smem;
  float* red = sc + 5 * 1024;
  const int tid = vtid(), lane = tid & 63, wid = tid >> 6;
  const int l = it / 144, n = (it % 144) * 64 + lane;
  __syncthreads();
  for (int e = tid; e < 5 * 1024; e += VT) {
    const int i = e >> 10, k = e & 1023;
    const float v = i == 0 ? p.c_ctx[k] : p.c[(i - 1) * 1024 + k];
    sc[e] = v / (1.f + expf(-v));
  }
  __syncthreads();
  float a0 = 0, a1 = 0, a2 = 0, a3 = 0, a4 = 0;
  const float* w = p.w_mod + ((size_t)l * 1024 + wid * 256) * 9216 + n;
#pragma unroll 32
  for (int k = 0; k < 256; ++k) {
    const float wv = w[(size_t)k * 9216];
    const int kk = wid * 256 + k;
    a0 += sc[kk] * wv; a1 += sc[1024 + kk] * wv; a2 += sc[2048 + kk] * wv; a3 += sc[3072 + kk] * wv; a4 += sc[4096 + kk] * wv;
  }
  red[(wid * 5 + 0) * 64 + lane] = a0; red[(wid * 5 + 1) * 64 + lane] = a1; red[(wid * 5 + 2) * 64 + lane] = a2;
  red[(wid * 5 + 3) * 64 + lane] = a3; red[(wid * 5 + 4) * 64 + lane] = a4;
  __syncthreads();
  for (int e = tid; e < 320; e += VT) {
    const int i = e >> 6, cl = e & 63;
    float s = 0.f;
    for (int w4 = 0; w4 < 4; ++w4) s += red[(w4 * 5 + i) * 64 + cl];
    const int col = (it % 144) * 64 + cl;
    p.MOD[(size_t)(l * 5 + i) * 9216 + col] = s + p.b_mod[(size_t)l * 9216 + col];
  }
}

DI void phase_init(const Params& p, unsigned char* smem) {
  const int nb = gridDim.x, bid = lbid(), tid = ltid();
  for (int pr = bid; pr < 288; pr += nb) mod_item(p, 2 * pr + vhalf(), smem + vhalf() * HALF_BYTES);
  for (int it = 576 + bid; it < 1602; it += nb) {
    if (it < 1600) {
      const int r0 = (it - 576) * 4;
      for (int e = tid; e < 4 * 512; e += NT) {
        const int r = r0 + (e >> 9), k8 = (e & 511) * 8;
        unsigned w[4];
#pragma unroll
        for (int j = 0; j < 4; ++j) {
          float v[2];
#pragma unroll
          for (int q = 0; q < 2; ++q) {
            const int k = k8 + 2 * j + q;
            const int kk = k <= 2048 ? k : k - 2048;
            const int idx = (r * kk) & 4095;
            const float ang = (float)idx * (1.0f / 2048.0f);
            v[q] = k <= 2048 ? cospif(ang) : -sinpif(ang);
          }
          w[j] = pack2(v[0], v[1]);
        }
        *(uint4*)(p.TWL + (size_t)r * 4096 + k8) = make_uint4(w[0], w[1], w[2], w[3]);
      }
    } else if (it == 1600) {
      for (int e = tid; e < 256 * 512; e += NT) {
        const int r = e >> 9, k = e & 511;
        const int idx = (r * (k & 255)) & 255;
        const float ang = (float)idx * (1.0f / 128.0f);
        p.TWC[e] = f2bf(k < 256 ? cospif(ang) : -sinpif(ang));
      }
    } else {
      for (int e = tid; e < 64 * 16; e += NT) {
        const int pos = e >> 4, j = e & 15;
        const float inv = powf(10000.0f, -(float)(2 * j) / 32.0f);
        const float ang = (float)pos * inv;
        p.ROPE_S[e * 2] = cosf(ang); p.ROPE_S[e * 2 + 1] = sinf(ang);
      }
      for (int e = tid; e < 128 * 64; e += NT) {
        const int n = e >> 6, c = e & 63;
        const float ang = (float)((c * (n & 63)) & 63) * (1.f / 32.f);
        p.DFTW[e] = f2bf(n < 64 ? cospif(ang) : sinpif(ang));
      }
      for (int e = tid; e < 64 * 8; e += NT) {
        const int pos = e >> 3, j = e & 7;
        const float inv = powf(10000.0f, -(float)(2 * j) / 16.0f);
        const float ang = (float)pos * inv;
        p.ROPE_M[e * 2] = cosf(ang); p.ROPE_M[e * 2 + 1] = sinf(ang);
      }
    }
  }
}

DI void conv_tile(const float* __restrict__ src, int N, bf16_t* __restrict__ dst, int K, int kt, int nt, int mode, unsigned char* smem) {
  float* ts = (float*)smem;
  const int tid = vtid();
  __syncthreads();
#pragma unroll
  for (int i = 0; i < 4; ++i) {
    const int r = (tid >> 4) + 16 * i, c4 = (tid & 15) * 4;
    const float4 v = *(const float4*)(src + (size_t)(kt * 64 + r) * N + nt * 64 + c4);
    ts[r * 65 + c4] = v.x; ts[r * 65 + c4 + 1] = v.y; ts[r * 65 + c4 + 2] = v.z; ts[r * 65 + c4 + 3] = v.w;
  }
  __syncthreads();
  const int nl = tid >> 2, ks = (tid & 3) * 16;
  const int n = nt * 64 + nl;
  int drow = n;
  if (mode == 1) drow = (n >> 4) * 32 + (n & 15);
  else if (mode == 2) drow = (n >> 4) * 32 + 16 + (n & 15);
  unsigned w[8];
#pragma unroll
  for (int j = 0; j < 8; ++j) w[j] = pack2(ts[(ks + 2 * j) * 65 + nl], ts[(ks + 2 * j + 1) * 65 + nl]);
  bf16_t* d = dst + (size_t)drow * K + kt * 64 + ks;
  *(uint4*)d = make_uint4(w[0], w[1], w[2], w[3]);
  *(uint4*)(d + 8) = make_uint4(w[4], w[5], w[6], w[7]);
}
DI void convert_layer(const Params& p, int l, unsigned char* smem) {
  smem += vhalf() * HALF_BYTES;
  for (int t = 2 * lbid() + vhalf(); t < 5080; t += 2 * gridDim.x) {
    if (t < 2816) {
      const int q = t / 704, r = t % 704, i = q >> 1, which = q & 1;
      const float* src = (which ? p.w_up : p.w_gate) + (size_t)(l * 2 + i) * 1024 * DFF;
      conv_tile(src, DFF, p.WGU + (size_t)i * 5632 * 1024, 1024, r / 44, r % 44, 1 + which, smem);
    } else if (t < 4224) {
      const int q = (t - 2816) / 704, r = (t - 2816) % 704;
      conv_tile(p.w_down + (size_t)(l * 2 + q) * DFF * 1024, 1024, p.WD + (size_t)q * 1024 * DFF, DFF, r / 16, r % 16, 0, smem);
    } else if (t < 4784) {
      const int r = t - 4224;
      conv_tile(p.w_in + (size_t)l * 1024 * DIN, DIN, p.WIN, 1024, r / 35, r % 35, 0, smem);
    } else if (t < 5040) {
      const int r = t - 4784;
      conv_tile(p.w_out + (size_t)l * 1024 * 1024, 1024, p.WOUT, 1024, r / 16, r % 16, 0, smem);
    } else if (t < 5064) {
      const int r = t - 5040;
      conv_tile(p.w_qb + (size_t)l * 256 * 384, 384, p.WQB, 256, r / 6, r % 6, 0, smem);
    } else {
      const int r = t - 5064;
      conv_tile(p.w_kvb + (size_t)l * 128 * 512, 512, p.WKVB, 128, r / 8, r % 8, 0, smem);
    }
  }
}

struct EwArgs {
  const void *xin_ctx, *xin_lat; void *xout_ctx, *xout_lat;
  int in_f32, out_f32;
  const float* F; int lu, gate_idx, gpost_idx; float res_w;
  int do_norm, ln, sc_idx, sh_idx, gpre_idx;
  int r_lo, r_hi, vb, nvb;
};
DI float4 ld4_bf16(const bf16_t* p) { const u32x2 v = *(const u32x2*)p; return make_float4(__uint_as_float(v[0] << 16), __uint_as_float(v[0] & 0xffff0000u), __uint_as_float(v[1] << 16), __uint_as_float(v[1] & 0xffff0000u)); }
DI void phase_ew(const Params& p, const EwArgs& a) {
  const int lane = ltid() & 63, gw = a.vb * NW + (ltid() >> 6), nwv = a.nvb * NW;
  const bool upd = a.F != nullptr;
  const int rpw = (a.r_hi - a.r_lo + nwv - 1) / nwv;
  const int r0 = a.r_lo + gw * rpw, r1 = r0 + rpw < a.r_hi ? r0 + rpw : a.r_hi;
  float4 g[4], q[4], s4[4], t4[4], u4[4];
  int cur_mi = -1;
  for (int r = r0; r < r1; ++r) {
    const int mi = r < M_CTX ? 0 : 1 + ((r - M_CTX) >> 12);
    if (mi != cur_mi) {
      cur_mi = mi;
      const float* __restrict__ gate = p.MOD + (size_t)(a.lu * 5 + mi) * 9216 + a.gate_idx * 1024;
      const float* __restrict__ gpo = p.g_norm + (size_t)(a.lu * 6 + a.gpost_idx) * 1024;
      const float* __restrict__ sc = p.MOD + (size_t)(a.ln * 5 + mi) * 9216 + a.sc_idx * 1024;
      const float* __restrict__ sh = p.MOD + (size_t)(a.ln * 5 + mi) * 9216 + a.sh_idx * 1024;
      const float* __restrict__ gpr = p.g_norm + (size_t)(a.ln * 6 + a.gpre_idx) * 1024;
#pragma unroll
      for (int j = 0; j < 4; ++j) {
        const int c = lane * 4 + 256 * j;
        if (upd) { g[j] = *(const float4*)(gate + c); q[j] = *(const float4*)(gpo + c); }
        if (a.do_norm) { s4[j] = *(const float4*)(sc + c); t4[j] = *(const float4*)(sh + c); u4[j] = *(const float4*)(gpr + c); }
      }
    }
    const size_t ro = r < M_CTX ? (size_t)r * DM : (size_t)(r - M_CTX) * DM;
    const void* xb = r < M_CTX ? a.xin_ctx : a.xin_lat;
    float4 x[4], f[4];
#pragma unroll
    for (int j = 0; j < 4; ++j) {
      const int c = lane * 4 + 256 * j;
      x[j] = a.in_f32 ? *(const float4*)((const float*)xb + ro + c) : ld4_bf16((const bf16_t*)xb + ro + c);
      if (upd) f[j] = ld4_bf16((const bf16_t*)a.F + (size_t)r * DM + c);
    }
    if (upd) {
      float ss = 0.f;
#pragma unroll
      for (int j = 0; j < 4; ++j) ss += f[j].x * f[j].x + f[j].y * f[j].y + f[j].z * f[j].z + f[j].w * f[j].w;
      ss = wave_sum(ss);
      const float rs = rsqrtf(ss * (1.f / 1024.f) + EPS) * a.res_w;
      void* ob = r < M_CTX ? a.xout_ctx : a.xout_lat;
#pragma unroll
      for (int j = 0; j < 4; ++j) {
        const int c = lane * 4 + 256 * j;
        x[j].x += g[j].x * (f[j].x * rs * q[j].x); x[j].y += g[j].y * (f[j].y * rs * q[j].y);
        x[j].z += g[j].z * (f[j].z * rs * q[j].z); x[j].w += g[j].w * (f[j].w * rs * q[j].w);
        if (a.out_f32) *(float4*)((float*)ob + ro + c) = x[j];
        else { u32x2 w; w[0] = pack2(x[j].x, x[j].y); w[1] = pack2(x[j].z, x[j].w); *(u32x2*)((bf16_t*)ob + ro + c) = w; }
      }
    }
    if (a.do_norm) {
      float ss = 0.f;
#pragma unroll
      for (int j = 0; j < 4; ++j) ss += x[j].x * x[j].x + x[j].y * x[j].y + x[j].z * x[j].z + x[j].w * x[j].w;
      ss = wave_sum(ss);
      const float rs = rsqrtf(ss * (1.f / 1024.f) + EPS);
      bf16_t* hr = p.H + (size_t)r * DM;
#pragma unroll
      for (int j = 0; j < 4; ++j) {
        u32x2 w;
        w[0] = pack2(x[j].x * rs * u4[j].x * (1.f + s4[j].x) + t4[j].x, x[j].y * rs * u4[j].y * (1.f + s4[j].y) + t4[j].y);
        w[1] = pack2(x[j].z * rs * u4[j].z * (1.f + s4[j].z) + t4[j].z, x[j].w * rs * u4[j].w * (1.f + s4[j].w) + t4[j].w);
        *(u32x2*)(hr + lane * 4 + 256 * j) = w;
      }
    }
  }
}

DI void prep_item(const Params& p, int l, int it, unsigned char* smem) {
  const int tid = ltid(), lane = tid & 63, wid = tid >> 6;
  const int r0 = it * 32;
  if (r0 >= M_TOT) {
    for (int e = tid; e < 32 * 128; e += NT) {
      const int rr = e >> 7, cc = e & 127, idx = r0 - M_TOT + rr, b = idx >> 8, j = idx & 255;
      const size_t src = ((size_t)(b * 4 + l) * 256 + j) * 128 + cc;
      const size_t dst = (size_t)(r0 + rr) * 128 + cc;
      p.KS[dst] = f2bf(p.cache_swa_k[src]);
      p.VS[dst] = f2bf(p.cache_swa_v[src]);
      p.CKV[dst] = f2bf(p.cache_mla_ckv[src]);
    }
    for (int e = tid; e < 32 * 32; e += NT) {
      const int rr = e >> 5, cc = e & 31, idx = r0 - M_TOT + rr, b = idx >> 8, j = idx & 255;
      p.KR[(size_t)(r0 + rr) * 32 + cc] = f2bf(p.cache_mla_krope[((size_t)(b * 4 + l) * 256 + j) * 32 + cc]);
    }
    return;
  }
  const bool lat = r0 >= M_CTX;
  const bf16_t* __restrict__ Zr = p.Z; bf16_t* __restrict__ QSr = p.QS; bf16_t* __restrict__ KSr = p.KS; bf16_t* __restrict__ VSr = p.VS; const float* __restrict__ RSr = p.ROPE_S;
#pragma unroll 4
  for (int e = tid; e < 32 * 128; e += NT) {
    const int rr = e >> 7, rem = e & 127, head = rem >> 5, half = (rem >> 4) & 1, j = rem & 15;
    const int r = r0 + rr;
    const bf16_t* __restrict__ z = Zr + (size_t)r * DIN;
    const int d1 = head * 64 + half * 32 + j, d2 = d1 + 16;
    float x1 = bf2f(z[ZQS + d1]), x2 = bf2f(z[ZQS + d2]);
    float cs = 1.f, sn = 0.f;
    if (lat) { const int t = (r - M_CTX) & 4095; const int pos = half ? (t & 63) : (t >> 6); cs = RSr[(pos * 16 + j) * 2]; sn = RSr[(pos * 16 + j) * 2 + 1]; }
    QSr[(size_t)r * 256 + d1] = f2bf((x1 * cs - x2 * sn) * 0.125f);
    QSr[(size_t)r * 256 + d2] = f2bf((x2 * cs + x1 * sn) * 0.125f);
    if (head < 2) {
      x1 = bf2f(z[ZKS + d1]); x2 = bf2f(z[ZKS + d2]);
      KSr[(size_t)r * 128 + d1] = f2bf(x1 * cs - x2 * sn);
      KSr[(size_t)r * 128 + d2] = f2bf(x2 * cs + x1 * sn);
      VSr[(size_t)r * 128 + d1] = z[ZVS + d1];
      VSr[(size_t)r * 128 + d2] = z[ZVS + d2];
    }
  }
  for (int e = tid; e < 32 * 16; e += NT) {
    const int rr = e >> 4, half = (e >> 3) & 1, j = e & 7, r = r0 + rr;
    const bf16_t* z = p.Z + (size_t)r * DIN + ZKR;
    const int d1 = half * 16 + j, d2 = d1 + 8;
    const float x1 = bf2f(z[d1]), x2 = bf2f(z[d2]);
    float cs = 1.f, sn = 0.f;
    if (lat) { const int t = (r - M_CTX) & 4095; const int pos = half ? (t & 63) : (t >> 6); cs = p.ROPE_M[(pos * 8 + j) * 2]; sn = p.ROPE_M[(pos * 8 + j) * 2 + 1]; }
    p.KR[(size_t)r * 32 + d1] = f2bf(x1 * cs - x2 * sn);
    p.KR[(size_t)r * 32 + d2] = f2bf(x2 * cs + x1 * sn);
  }
#pragma unroll
  for (int rr0 = 0; rr0 < 32; rr0 += NW) {
    const int rr = rr0 + wid;
    const int r = r0 + rr;
    const bf16_t* __restrict__ z = Zr + (size_t)r * DIN;
    {
      const float a = bf2f(z[ZKVA + lane]), b = bf2f(z[ZKVA + 64 + lane]);
      const float rs = rsqrtf(wave_sum(a * a + b * b) * (1.f / 128.f) + EPS);
      const float o0 = a * rs * p.mla_g_kv[l * 128 + lane], o1 = b * rs * p.mla_g_kv[l * 128 + 64 + lane];
      p.CKV[(size_t)r * 128 + lane] = f2bf(o0); p.CKV[(size_t)r * 128 + 64 + lane] = f2bf(o1);
      if (!lat) {
        const int b_ = r >> 8, s = r & 255;
        float* dst = p.out + O_CKV + ((size_t)(b_ * 4 + l) * 256 + s) * 128;
        dst[lane] = o0; dst[64 + lane] = o1;
      }
    }
    {
      float v[4]; float ss = 0.f;
#pragma unroll
      for (int j = 0; j < 4; ++j) { v[j] = bf2f(z[ZQA + lane + 64 * j]); ss += v[j] * v[j]; }
      const float rs = rsqrtf(wave_sum(ss) * (1.f / 256.f) + EPS);
#pragma unroll
      for (int j = 0; j < 4; ++j) p.QLAT[(size_t)r * 256 + lane + 64 * j] = f2bf(v[j] * rs * p.mla_g_q[l * 256 + lane + 64 * j]);
    }
  }
}

DI void gla_cum(const Params& p, int l, int head, int dir, int row0, int rstep, float* sa, float* qt, f32x16& cum, float& last) {
  const int tid = vtid(), dk = tid & 63, quarter = tid >> 6;
  __syncthreads();
  for (int e = tid; e < 64 * 16; e += VT) {
    const int i = e >> 4, rr = e & 15;
    sa[e] = bf2f(p.Z[(size_t)(row0 + i * rstep) * DIN + ZAF + dir * 16 + rr]);
  }
  __syncthreads();
  float wg[16];
  const float* W = p.gla_w_gate + ((size_t)(l * 2 + dir) * 16) * 256 + head * 64 + dk;
#pragma unroll
  for (int rr = 0; rr < 16; ++rr) wg[rr] = W[rr * 256];
  const float bg = p.gla_b_gate[(l * 2 + dir) * 256 + head * 64 + dk];
  float run = 0.f;
#pragma unroll
  for (int ii = 0; ii < 16; ++ii) {
    const int i = quarter * 16 + ii;
    float lg = bg;
#pragma unroll
    for (int rr = 0; rr < 16; ++rr) lg += sa[i * 16 + rr] * wg[rr];
    const float ls = fminf(lg, 0.f) - __logf(1.f + __expf(-fabsf(lg)));
    run += ls * (1.f / 16.f);
    cum[ii] = run;
  }
  qt[quarter * 64 + dk] = run;
  __syncthreads();
  float offs = 0.f, tot = 0.f;
#pragma unroll
  for (int q = 0; q < 4; ++q) { const float v = qt[q * 64 + dk]; tot += v; if (q < quarter) offs += v; }
#pragma unroll
  for (int ii = 0; ii < 16; ++ii) cum[ii] += offs;
  last = tot;
}

DI void gla_seq_info(int sq_global, int& grp, int& b, int& head, int& dir, int& S, int& base) {
  if (sq_global < 32) { grp = 1; b = sq_global >> 3; head = (sq_global >> 1) & 3; dir = sq_global & 1; S = 4096; base = M_CTX + b * 4096; }
  else { const int s = sq_global - 32; grp = 0; b = s >> 3; head = (s >> 1) & 3; dir = s & 1; S = 256; base = b * 256; }
}

DI void gla_pass_a(const Params& p, int l, int ci, unsigned char* smem) {
  float* sa = (float*)smem;
  float* qt = sa + 1024;
  bf16_t* kdT = (bf16_t*)(qt + 256);
  bf16_t* vT = kdT + 64 * PITCH;
  const int tid = vtid(), lane = tid & 63, wid = tid >> 6, dk = tid & 63, quarter = tid >> 6, l31 = lane & 31, h = lane >> 5;
  int sqg, c;
  if (ci < 2048) { sqg = ci >> 6; c = ci & 63; } else { sqg = 32 + ((ci - 2048) >> 2); c = (ci - 2048) & 3; }
  int grp, b, head, dir, S, base;
  gla_seq_info(sqg, grp, b, head, dir, S, base);
  const int row0 = dir ? base + S - 1 - 64 * c : base + 64 * c, rstep = dir ? -1 : 1;
  f32x16 kraw, vraw;
#pragma unroll
  for (int ii = 0; ii < 16; ++ii) {
    const bf16_t* __restrict__ z = p.Z + (size_t)(row0 + (quarter * 16 + ii) * rstep) * DIN;
    kraw[ii] = bf2f(z[ZKG + head * 64 + dk]);
    vraw[ii] = bf2f(z[ZVG + head * 64 + dk]);
  }
  f32x16 cum; float last;
  gla_cum(p, l, head, dir, row0, rstep, sa, qt, cum, last);
  unsigned kw[8], vw[8];
#pragma unroll
  for (int j = 0; j < 8; ++j) {
    kw[j] = pack2(kraw[2 * j] * __expf(last - cum[2 * j]), kraw[2 * j + 1] * __expf(last - cum[2 * j + 1]));
    vw[j] = pack2(vraw[2 * j], vraw[2 * j + 1]);
  }
  *(uint4*)(kdT + dk * PITCH + quarter * 16) = make_uint4(kw[0], kw[1], kw[2], kw[3]);
  *(uint4*)(kdT + dk * PITCH + quarter * 16 + 8) = make_uint4(kw[4], kw[5], kw[6], kw[7]);
  *(uint4*)(vT + dk * PITCH + quarter * 16) = make_uint4(vw[0], vw[1], vw[2], vw[3]);
  *(uint4*)(vT + dk * PITCH + quarter * 16 + 8) = make_uint4(vw[4], vw[5], vw[6], vw[7]);
  if (quarter == 0) p.GLA_DL[(size_t)ci * 64 + dk] = expf(last);
  __syncthreads();
  const int wr = wid >> 1, wc = wid & 1;
  f32x16 acc;
#pragma unroll
  for (int i = 0; i < 16; ++i) acc[i] = 0.f;
#pragma unroll
  for (int ks = 0; ks < 4; ++ks) {
    const bf16x8 a = *(const bf16x8*)(kdT + (wr * 32 + l31) * PITCH + ks * 16 + h * 8);
    const bf16x8 bb = *(const bf16x8*)(vT + (wc * 32 + l31) * PITCH + ks * 16 + h * 8);
    acc = MFMA32(a, bb, acc);
  }
  float* Bc = p.GLA_B + (size_t)ci * 4096;
#pragma unroll
  for (int i = 0; i < 16; ++i) Bc[(wr * 32 + crow(i, h)) * 64 + wc * 32 + l31] = acc[i];
}

typedef float f32x8 __attribute__((ext_vector_type(8)));
DI void gla_pass_b(const Params& p, int l, int sqg, int part) {
  const int tid = ltid(), dv = part * 16 + (tid & 15), dk0 = (tid >> 4) * 2;
  int grp, b, head, dir, S, base;
  gla_seq_info(sqg, grp, b, head, dir, S, base);
  const int nch = S >> 6;
  const int ci0 = grp ? sqg * 64 : 2048 + (sqg - 32) * 4;
  float s0v = 0.f, s1v = 0.f;
  if (grp) {
    const float* __restrict__ s0 = p.state_gla + ((((size_t)b * 4 + l) * 2 + dir) * 4 + head) * 4096;
    s0v = s0[dk0 * 64 + dv]; s1v = s0[(dk0 + 1) * 64 + dv];
  }
  const float* __restrict__ GB = p.GLA_B; const float* __restrict__ GD = p.GLA_DL; bf16_t* __restrict__ GS = p.GLA_S;
  float rb0[16], rb1[16], rd0[16], rd1[16];
#pragma unroll
  for (int q = 0; q < 16; ++q) {
    const int cq = q < nch ? q : nch - 1;
    const float* Bc = GB + (size_t)(ci0 + cq) * 4096 + dk0 * 64 + dv; const float* dl = GD + (size_t)(ci0 + cq) * 64 + dk0;
    rb0[q] = Bc[0]; rb1[q] = Bc[64]; rd0[q] = dl[0]; rd1[q] = dl[1];
  }
  for (int c0 = 0; c0 < nch; c0 += 16) {
#pragma unroll
    for (int q = 0; q < 16; ++q) {
      const int c = c0 + q;
      if (c < nch) {
        *(unsigned*)(GS + (size_t)(ci0 + c) * 4096 + dv * 64 + dk0) = pack2(s0v, s1v);
        s0v = rd0[q] * s0v + rb0[q]; s1v = rd1[q] * s1v + rb1[q];
      }
      const int cn = c + 16 < nch ? c + 16 : nch - 1;
      const float* Bc = GB + (size_t)(ci0 + cn) * 4096 + dk0 * 64 + dv; const float* dl = GD + (size_t)(ci0 + cn) * 64 + dk0;
      rb0[q] = Bc[0]; rb1[q] = Bc[64]; rd0[q] = dl[0]; rd1[q] = dl[1];
    }
  }
  if (!grp) {
    float* so = p.out + O_ST + ((((size_t)b * 4 + l) * 2 + dir) * 4 + head) * 4096;
    so[dk0 * 64 + dv] = s0v; so[(dk0 + 1) * 64 + dv] = s1v;
  }
}

DI void gla_pass_c(const Params& p, int l, int item, unsigned char* smem) {
  float* sa = (float*)smem;
  float* qt = sa + 1024;
  bf16_t* qd = (bf16_t*)(qt + 256);
  bf16_t* ki = qd + 64 * PITCH;
  bf16_t* vT = ki + 64 * PITCH;
  bf16_t* stT = vT + 64 * PITCH;
  float* osum = (float*)(stT + 64 * PITCH);
  const int tid = vtid(), lane = tid & 63, wid = tid >> 6, dk = tid & 63, quarter = tid >> 6, l31 = lane & 31, h = lane >> 5;
  int grp, b, head, c, S, base, nch;
  if (item < 1024) { grp = 1; b = item >> 8; head = (item >> 6) & 3; c = item & 63; S = 4096; base = M_CTX + b * 4096; nch = 64; }
  else { const int it = item - 1024; grp = 0; b = it >> 4; head = (it >> 2) & 3; c = it & 3; S = 256; base = b * 256; nch = 4; }
  const int wd = wid >> 1, wp = wid & 1;
  const int tk = tid >> 2, q4 = tid & 3, frow = base + 64 * c + tk;
  const u32x4 rg0 = *(const u32x4*)(p.Z + (size_t)frow * DIN + ZRG + head * 64 + q4 * 16);
  const u32x4 rg1 = *(const u32x4*)(p.Z + (size_t)frow * DIN + ZRG + head * 64 + q4 * 16 + 8);
  for (int dir = 0; dir < 2; ++dir) {
    const int cs = dir ? nch - 1 - c : c;
    const int sq = b * 8 + head * 2 + dir;
    const size_t ci = grp ? (size_t)sq * 64 + cs : 2048 + (size_t)sq * 4 + cs;
    const int row0 = dir ? base + S - 1 - 64 * cs : base + 64 * cs, rstep = dir ? -1 : 1;
    f32x16 qraw, kraw, vraw;
#pragma unroll
    for (int ii = 0; ii < 16; ++ii) {
      const bf16_t* __restrict__ z = p.Z + (size_t)(row0 + (quarter * 16 + ii) * rstep) * DIN;
      qraw[ii] = bf2f(z[ZQG + head * 64 + dk]);
      kraw[ii] = bf2f(z[ZKG + head * 64 + dk]);
      vraw[ii] = bf2f(z[ZVG + head * 64 + dk]);
    }
    u32x4 st0, st1;
    {
      const bf16_t* Sg = p.GLA_S + ci * 4096;
      st0 = *(const u32x4*)(Sg + (tid >> 3) * 64 + (tid & 7) * 8);
      st1 = *(const u32x4*)(Sg + (32 + (tid >> 3)) * 64 + (tid & 7) * 8);
    }
    f32x16 cum; float last;
    gla_cum(p, l, head, dir, row0, rstep, sa, qt, cum, last);
    unsigned vw[8];
#pragma unroll
    for (int ii = 0; ii < 16; ++ii) {
      const int i = quarter * 16 + ii;
      const float e = __expf(cum[ii]);
      qd[i * PITCH + dk] = f2bf(qraw[ii] * 0.125f * e);
      ki[i * PITCH + dk] = f2bf(kraw[ii] * __expf(-cum[ii]));
    }
#pragma unroll
    for (int j = 0; j < 8; ++j) vw[j] = pack2(vraw[2 * j], vraw[2 * j + 1]);
    *(uint4*)(vT + dk * PITCH + quarter * 16) = make_uint4(vw[0], vw[1], vw[2], vw[3]);
    *(uint4*)(vT + dk * PITCH + quarter * 16 + 8) = make_uint4(vw[4], vw[5], vw[6], vw[7]);
    *(u32x4*)(stT + (tid >> 3) * PITCH + (tid & 7) * 8) = st0;
    *(u32x4*)(stT + (32 + (tid >> 3)) * PITCH + (tid & 7) * 8) = st1;
    __syncthreads();
    f32x16 acco;
#pragma unroll
    for (int i = 0; i < 16; ++i) acco[i] = 0.f;
#pragma unroll
    for (int ks = 0; ks < 4; ++ks) {
      const bf16x8 a = *(const bf16x8*)(stT + (wd * 32 + l31) * PITCH + ks * 16 + h * 8);
      const bf16x8 bb = *(const bf16x8*)(qd + (wp * 32 + l31) * PITCH + ks * 16 + h * 8);
      acco = MFMA32(a, bb, acco);
    }
    for (int jb = 0; jb <= wp; ++jb) {
      f32x16 att;
#pragma unroll
      for (int i = 0; i < 16; ++i) att[i] = 0.f;
#pragma unroll
      for (int ks = 0; ks < 4; ++ks) {
        const bf16x8 a = *(const bf16x8*)(ki + (jb * 32 + l31) * PITCH + ks * 16 + h * 8);
        const bf16x8 bb = *(const bf16x8*)(qd + (wp * 32 + l31) * PITCH + ks * 16 + h * 8);
        att = MFMA32(a, bb, att);
      }
      const int ipos = wp * 32 + l31;
#pragma unroll
      for (int i = 0; i < 16; ++i) if (jb * 32 + crow(i, h) > ipos) att[i] = 0.f;
#pragma unroll
      for (int s = 0; s < 2; ++s) {
        union { bf16x8 v; unsigned u[4]; } pf;
#pragma unroll
        for (int j = 0; j < 4; ++j) pf.u[j] = pack2(att[8 * s + 2 * j], att[8 * s + 2 * j + 1]);
        union { bf16x8 v; bf16x4 hlf[2]; } vf;
        vf.hlf[0] = *(const bf16x4*)(vT + (wd * 32 + l31) * PITCH + jb * 32 + 16 * s + 4 * h);
        vf.hlf[1] = *(const bf16x4*)(vT + (wd * 32 + l31) * PITCH + jb * 32 + 16 * s + 8 + 4 * h);
        acco = MFMA32(vf.v, pf.v, acco);
      }
    }
    {
      const int i = wp * 32 + l31, tl = dir ? 63 - i : i;
#pragma unroll
      for (int r = 0; r < 16; ++r) {
        float* o = osum + tl * 65 + wd * 32 + crow(r, h);
        if (dir) *o += acco[r]; else *o = acco[r];
      }
    }
  }
  __syncthreads();
  {
    float v[16]; float ss = 0.f;
#pragma unroll
    for (int j = 0; j < 16; ++j) { v[j] = osum[tk * 65 + q4 * 16 + j]; ss += v[j] * v[j]; }
    ss += shx(ss, 1); ss += shx(ss, 2);
    const float rs = rsqrtf(ss * (1.f / 64.f) + EPS);
    const float* __restrict__ gp = p.gla_g_out + l * 64 + q4 * 16;
    unsigned w[8];
#pragma unroll
    for (int j = 0; j < 8; ++j) {
      const unsigned ru = j < 4 ? rg0[j & 3] : rg1[j & 3];
      const float r0 = __uint_as_float(ru << 16), r1 = __uint_as_float(ru & 0xffff0000u);
      w[j] = pack2(v[2 * j] * rs * gp[2 * j] * silu_f(r0), v[2 * j + 1] * rs * gp[2 * j + 1] * silu_f(r1));
    }
    bf16_t* dst = p.MIX + (size_t)frow * 1024 + head * 64 + q4 * 16;
    *(u32x4*)dst = (u32x4){w[0], w[1], w[2], w[3]};
    *(u32x4*)(dst + 8) = (u32x4){w[4], w[5], w[6], w[7]};
  }
}

struct AttnJob {
  const bf16_t* Q; int ldq;
  const bf16_t* K1; int ldk1;
  const bf16_t* K2; int ldk2;
  const bf16_t* V; int ldv;
  int ctx_row0, nctx;
  int loc_row0, loc_pos0, nloc;
  int qrow0, qpos0;
  int window;
  float scale; int has_sink; float sink;
  bf16_t* O; int ldo;
};
template <int DQ>
DI void attn_block(const AttnJob& jb, unsigned char* smem) {
  constexpr int NKS = DQ / 16, KP = DQ + 8, NCH = DQ / 8;
  constexpr int BUFE = 64 * KP + 64 * PITCH;
  bf16_t* sbuf = (bf16_t*)smem;
  const int tid = ltid(), lane = tid & 63, wid = tid >> 6, l31 = lane & 31, h = lane >> 5;
  const int qr = jb.qrow0 + wid * 32 + l31;
  bf16x8 qf[NKS];
#pragma unroll
  for (int ks = 0; ks < NKS; ++ks) {
    const u32x4 raw = *(const u32x4*)(jb.Q + (size_t)qr * jb.ldq + ks * 16 + h * 8);
    const float qs = jb.scale * 1.4426950408889634f;
    u32x4 sc;
#pragma unroll
    for (int j = 0; j < 4; ++j) sc[j] = pack2(__uint_as_float(raw[j] << 16) * qs, __uint_as_float(raw[j] & 0xffff0000u) * qs);
    qf[ks] = __builtin_bit_cast(bf16x8, sc);
  }
  const int qpos = jb.qpos0 + wid * 32 + l31;
  f32x16 o[2];
#pragma unroll
  for (int d = 0; d < 2; ++d)
#pragma unroll
    for (int i = 0; i < 16; ++i) o[d][i] = 0.f;
  float m = -1e30f, lsum = 0.f;
  const int nt = jb.nctx + jb.nloc;
  const int kk0 = tid / NCH, kd0 = tid % NCH;
  const bool k1v = (NCH > 8) && (tid + NT < 64 * NCH);
  const int kk1 = k1v ? (tid + NT) / NCH : 0, kd1 = k1v ? (tid + NT) % NCH : 0;
  const int vk0 = tid & 63, vd0 = tid >> 6;
  u32x4 ka0, ka1 = {0u, 0u, 0u, 0u}, va0, kb0, kb1 = {0u, 0u, 0u, 0u}, vb0, kc0, kc1 = {0u, 0u, 0u, 0u}, vc0;
#define ATT_KLD(key, dc, krow) ((dc) < 8 ? *(const u32x4*)(jb.K1 + (size_t)((krow) + (key)) * jb.ldk1 + (dc) * 8) \
                                       : *(const u32x4*)(jb.K2 + (size_t)((krow) + (key)) * jb.ldk2 + ((dc) - 8) * 8))
#define ATT_LOAD(tt, K0_, K1_, V0_) { const int tc_ = (tt) < nt ? (tt) : nt - 1; \
    const int kr_ = tc_ < jb.nctx ? jb.ctx_row0 + 64 * tc_ : jb.loc_row0 + jb.loc_pos0 + 64 * (tc_ - jb.nctx); \
    K0_ = ATT_KLD(kk0, kd0, kr_); if (k1v) K1_ = ATT_KLD(kk1, kd1, kr_); \
    V0_ = *(const u32x4*)(jb.V + (size_t)(kr_ + vk0) * jb.ldv + vd0 * 8); }
#define ATT_VST(dst, v, dc) { _Pragma("unroll") for (int j = 0; j < 4; ++j) { \
      (dst)[((dc) * 8 + 2 * j) * PITCH + vk0] = (bf16_t)((v)[j] & 0xffffu); (dst)[((dc) * 8 + 2 * j + 1) * PITCH + vk0] = (bf16_t)((v)[j] >> 16); } }
#define ATT_FILL(buf, K0_, K1_, V0_) { bf16_t* sKw = sbuf + (buf) * BUFE; bf16_t* sVw = sKw + 64 * KP; \
    *(u32x4*)(sKw + kk0 * KP + kd0 * 8) = K0_; if (k1v) *(u32x4*)(sKw + kk1 * KP + kd1 * 8) = K1_; ATT_VST(sVw, V0_, vd0); }
  ATT_LOAD(0, ka0, ka1, va0); ATT_LOAD(1, kb0, kb1, vb0); ATT_LOAD(2, kc0, kc1, vc0);
  __syncthreads();
  ATT_FILL(0, ka0, ka1, va0); ATT_LOAD(3, ka0, ka1, va0);
  ATT_FILL(1, kb0, kb1, vb0); ATT_LOAD(4, kb0, kb1, vb0);
  __syncthreads();
#define ATT_QK(dst, buf) { const bf16_t* sKq = sbuf + (buf) * BUFE; _Pragma("unroll") for (int kb = 0; kb < 2; ++kb) { \
      _Pragma("unroll") for (int i = 0; i < 16; ++i) dst[kb][i] = 0.f; \
      _Pragma("unroll") for (int ks = 0; ks < NKS; ++ks) { \
        const bf16x8 a = *(const bf16x8*)(sKq + (kb * 32 + l31) * KP + ks * 16 + h * 8); dst[kb] = MFMA32(a, qf[ks], dst[kb]); } } }
  f32x16 sn[2];
  ATT_QK(sn, 0);
  auto body = [&](const int t, const int bm, u32x4& kr0, u32x4& kr1, u32x4& vr0) __attribute__((always_inline)) {
    int kpos0; bool masked;
    if (t < jb.nctx) { kpos0 = 0; masked = false; }
    else { kpos0 = jb.loc_pos0 + 64 * (t - jb.nctx); masked = jb.window > 0; }
    ATT_FILL((bm + 2) % 3, kr0, kr1, vr0);
    ATT_LOAD(t + 5, kr0, kr1, vr0);
    const bf16_t* sVt = sbuf + bm * BUFE + 64 * KP;
    f32x16 st[2];
    st[0] = sn[0]; st[1] = sn[1];
    ATT_QK(sn, (bm + 1) % 3);
    float mx = -1e30f;
#pragma unroll
    for (int kb = 0; kb < 2; ++kb)
#pragma unroll
      for (int i = 0; i < 16; ++i) {
        float s = st[kb][i];
        if (masked) {
          const int kp = kpos0 + kb * 32 + crow(i, h);
          const int d = qpos - kp;
          if (d > jb.window || d < -jb.window) s = -1e30f;
        }
        st[kb][i] = s;
        mx = fmaxf(mx, s);
      }
    mx = fmaxf(mx, shx(mx, 32));
    const float mn = fmaxf(m, mx);
    const bool grow = __builtin_amdgcn_ballot_w64(mn > m) != 0ull;
    float ps = 0.f;
#pragma unroll
    for (int kb = 0; kb < 2; ++kb)
#pragma unroll
      for (int i = 0; i < 16; ++i) { const float pv = __builtin_amdgcn_exp2f(st[kb][i] - mn); st[kb][i] = pv; ps += pv; }
    if (grow) {
      const float alpha = __builtin_amdgcn_exp2f(m - mn);
      lsum *= alpha;
#pragma unroll
      for (int d = 0; d < 2; ++d)
#pragma unroll
        for (int i = 0; i < 16; ++i) o[d][i] *= alpha;
    }
    m = mn;
    lsum += ps;
#pragma unroll
    for (int kb = 0; kb < 2; ++kb)
#pragma unroll
      for (int s = 0; s < 2; ++s) {
        union { bf16x8 v; unsigned u[4]; } pf;
#pragma unroll
        for (int j = 0; j < 4; ++j) pf.u[j] = pack2(st[kb][8 * s + 2 * j], st[kb][8 * s + 2 * j + 1]);
#pragma unroll
        for (int d = 0; d < 2; ++d) {
          union { bf16x8 v; bf16x4 hlf[2]; } vf;
          vf.hlf[0] = *(const bf16x4*)(sVt + (d * 32 + l31) * PITCH + kb * 32 + 16 * s + 4 * h);
          vf.hlf[1] = *(const bf16x4*)(sVt + (d * 32 + l31) * PITCH + kb * 32 + 16 * s + 8 + 4 * h);
          o[d] = MFMA32(vf.v, pf.v, o[d]);
        }
      }
    __syncthreads();
  };
  for (int t = 0; t < nt; t += 3) {
    body(t, 0, kc0, kc1, vc0);
    if (t + 1 < nt) body(t + 1, 1, ka0, ka1, va0);
    if (t + 2 < nt) body(t + 2, 2, kb0, kb1, vb0);
  }
  lsum += shx(lsum, 32);
  float inv;
  if (jb.has_sink) {
    const float sk2 = jb.sink * 1.4426950408889634f;
    const float mf = fmaxf(m, sk2);
    const float corr = __builtin_amdgcn_exp2f(m - mf);
    inv = corr / (lsum * corr + __builtin_amdgcn_exp2f(sk2 - mf));
  } else inv = 1.f / lsum;
  bf16_t* orow = jb.O + (size_t)qr * jb.ldo;
#pragma unroll
  for (int d = 0; d < 2; ++d)
#pragma unroll
    for (int g = 0; g < 4; ++g) {
      uint2 w;
      w.x = pack2(o[d][4 * g] * inv, o[d][4 * g + 1] * inv);
      w.y = pack2(o[d][4 * g + 2] * inv, o[d][4 * g + 3] * inv);
      *(uint2*)(orow + d * 32 + 8 * g + 4 * h) = w;
    }
}

DI void mla_item(const Params& p, int l, int grp, int it, unsigned char* smem) {
  AttnJob j;
  int b, head, qb;
  if (grp) { b = it >> 6; head = (it >> 4) & 3; qb = it & 15; } else { b = it >> 2; head = it & 3; qb = 0; }
  const int base = grp ? M_CTX + b * 4096 : b * 256;
  j.Q = p.QM + head * 96; j.ldq = 384;
  j.K1 = p.KV + head * 128; j.ldk1 = 512; j.K2 = p.KR; j.ldk2 = 32; j.V = p.KV + head * 128 + 64; j.ldv = 512;
  j.ctx_row0 = M_TOT + b * 256; j.nctx = grp ? 4 : 0;
  j.loc_row0 = base; j.loc_pos0 = 0; j.nloc = grp ? 64 : 4;
  j.qrow0 = base + qb * 256; j.qpos0 = qb * 256; j.window = 0;
  j.scale = 0.10206207261596577f; j.has_sink = 0; j.sink = 0.f;
  j.O = p.MIX + 768 + head * 64; j.ldo = 1024;
  attn_block<96>(j, smem);
}
DI void swa_item(const Params& p, int l, int grp, int it, unsigned char* smem) {
  AttnJob j;
  int b, hq, qb;
  if (grp) { b = it >> 6; hq = (it >> 4) & 3; qb = it & 15; } else { b = it >> 2; hq = it & 3; qb = 0; }
  const int base = grp ? M_CTX + b * 4096 : b * 256;
  const int g = hq >> 1;
  j.Q = p.QS + hq * 64; j.ldq = 256;
  j.K1 = p.KS + g * 64; j.ldk1 = 128; j.K2 = p.KS; j.ldk2 = 128; j.V = p.VS + g * 64; j.ldv = 128;
  j.ctx_row0 = M_TOT + b * 256; j.nctx = grp ? 4 : 0;
  if (grp) {
    const int lo = qb > 0 ? qb * 256 - 128 : 0, hi = qb < 15 ? qb * 256 + 384 : 4096;
    j.loc_pos0 = lo; j.nloc = (hi - lo) >> 6; j.window = 128;
  } else { j.loc_pos0 = 0; j.nloc = 4; j.window = 0; }
  j.loc_row0 = base;
  j.qrow0 = base + qb * 256; j.qpos0 = qb * 256;
  j.scale = 1.0f;
  j.has_sink = 1; j.sink = p.swa_sink[l * 4 + hq];
  j.O = p.MIX + 256 + hq * 64; j.ldo = 1024;
  attn_block<64>(j, smem);
}

DI bool tile_swz(int i, int nN, int T, int& tm, int& tn) {
  const int bid = lbid(), slots = gridDim.x >> 3;
  const int L = (i * 8 + (bid & 7)) * slots + (bid >> 3);
  if (L >= T) return false;
  const int pw = 8 * nN, pnl = L / pw, rem = L - pnl * pw;
  tn = rem >> 3; tm = pnl * 8 + (rem & 7);
  return true;
}
DI void phase_gemm_gu(const Params& p, int i, unsigned char* smem) {
  Epi8GateUp epi{p.ACT};
  const bf16_t* W = p.WGU + (size_t)i * 5632 * 1024;
  int tm, tn, nm = 0, nn = 0; bool has = tile_swz(0, 22, 80 * 22, tm, tn), first = true;
  for (int i2 = 0; has; ++i2) {
    const bool hn = tile_swz(i2 + 1, 22, 80 * 22, nm, nn);
    gemm8_tile(p.H, W, 1024, tm * 256, tn * 256, smem, epi, first, hn, nm * 256, nn * 256);
    first = false; tm = nm; tn = nn; has = hn;
  }
}
DI void phase_gemm_down(const Params& p, int i, unsigned char* smem, int round) {
  Epi8Bf16 epi{(bf16_t*)p.F, 1024, 1.f, 1024};
  const bf16_t* W = p.WD + (size_t)i * 1024 * DFF;
  int tm, tn;
  if (tile_swz(round, 4, 80 * 4, tm, tn)) gemm8_tile(p.ACT, W, DFF, tm * 256, tn * 256, smem, epi);
}
DI void phase_gemm_win(const Params& p, int l, unsigned char* smem) {
  Epi8Win epi{p.Z, p.out, l};
  int tm, tn, nm = 0, nn = 0; bool has = tile_swz(0, 9, 80 * 9, tm, tn), first = true;
  for (int i2 = 0; has; ++i2) {
    const bool hn = tile_swz(i2 + 1, 9, 80 * 9, nm, nn);
    gemm8_tile(p.H, p.WIN, 1024, tm * 256, tn * 256, smem, epi, first, hn, nm * 256, nn * 256);
    first = false; tm = nm; tn = nn; has = hn;
  }
}
DI void phase_gemm_wout(const Params& p, unsigned char* smem) {
  Epi8Bf16 epi{(bf16_t*)p.F, 1024, 1.f, 1024};
  { int tm, tn; const int nit = (80 * 4 + gridDim.x - 1) / gridDim.x + 8; for (int i2 = 0; i2 < nit; ++i2) if (tile_swz(i2, 4, 80 * 4, tm, tn)) gemm8_tile(p.MIX, p.WOUT, 1024, tm * 256, tn * 256, smem, epi); }
}
DI void phase_prep(const Params& p, int l, unsigned char* smem, unsigned* ctr) {
  volatile int* s_item = (volatile int*)(smem + S_ITEM_OFF);
  for (;;) {
    __syncthreads();
    if (ltid() == 0) *s_item = (int)atomicAdd(ctr, 1u);
    __syncthreads();
    const int t = *s_item;
    if (t >= 2272) break;
    if (t < 672) prep_item(p, l, t, smem);
    else if (t < 992) {
      const int u = t - 672, g = u & 3, tm = u >> 2;
      EpiDft e{p.ABTL, p.ABTC, g};
      gemm_tile<2>(p.Z + ZF + g * 64, DIN, p.DFTW, 64, 64, tm * 256, 0, smem, e);
    } else gla_pass_a(p, l, 2 * (t - 992) + vhalf(), smem + vhalf() * HALF_BYTES);
  }
}
DI void fft_fold_item(const Params& p, int it) {
  const int tid = ltid(), row0 = it * 8;
  const bf16_t* __restrict__ SRC = p.ABTL; bf16_t* __restrict__ DST = p.ABTF;
#pragma unroll 2
  for (int e = tid; e < 8 * 512; e += NT) {
    const int rr = e >> 9, k0 = (e & 511) * 8;
    const bf16_t* __restrict__ src = SRC + (size_t)(row0 + rr) * 8192;
    float v[8];
#pragma unroll
    for (int j = 0; j < 8; ++j) {
      const int k = k0 + j;
      if (k0 <= 2040 || k == 2048) {
        const int km = (k == 0 || k == 2048) ? k : 4096 - k;
        const float a = bf2f(src[k]), b = bf2f(src[km]);
        v[j] = (k == 0 || k == 2048) ? a : a + b;
      } else {
        const int kk = k - 2048;
        v[j] = bf2f(src[4096 + kk]) - bf2f(src[8192 - kk]);
      }
    }
    u32x4 w; w[0] = pack2(v[0], v[1]); w[1] = pack2(v[2], v[3]); w[2] = pack2(v[4], v[5]); w[3] = pack2(v[6], v[7]);
    *(u32x4*)(DST + (size_t)(row0 + rr) * 4096 + k0) = w;
  }
}
DI void phase_qkv(const Params& p, int l, unsigned char* smem, unsigned* ctr) {
  EpiQm eq{p.QM, p.ROPE_M};
  EpiBf16 ekv{p.KV, 512, 1.f, 512};
  volatile int* s_item = (volatile int*)(smem + S_ITEM_OFF);
  for (;;) {
    __syncthreads();
    if (ltid() == 0) *s_item = (int)atomicAdd(ctr, 1u);
    __syncthreads();
    const int t = *s_item;
    if (t >= 1344) break;
    if (t < 128 || t >= 832) { const int u = t < 128 ? t : 128 + (t - 832); gla_pass_b(p, l, u >> 2, u & 3); }
    else if (t < 256) fft_fold_item(p, t - 128);
    else if (t < 496) { const int u = t - 256, tm = u / 3, tn = u % 3; gemm_tile<2>(p.QLAT, 256, p.WQB, 256, 256, tm * 256, tn * 128, smem, eq); }
    else { const int u = t - 496, tm = u >> 2, tn = u & 3; gemm_tile<2>(p.CKV, 128, p.WKVB, 128, 128, tm * 256, tn * 128, smem, ekv); }
  }
}
DI void phase_mixers(const Params& p, int l, unsigned char* smem, unsigned* ctr, unsigned long long* tc) {
  volatile int* s_item = (volatile int*)(smem + S_ITEM_OFF);
  const int x = lbid() & 7;
  for (;;) {
    __syncthreads();
    if (ltid() == 0) *s_item = (int)atomicAdd(ctr + x, 1u);
    __syncthreads();
    const int u = *s_item;
    if (u >= 172) break;
    volatile unsigned long long* tl = (volatile unsigned long long*)(smem + S_ITEM_OFF + 16);
    if (PROBE_SPIN >= 9 && ltid() == 0) tl[0] = __builtin_amdgcn_s_memrealtime();
    if (u < 8) {
      const int tm = x + 8 * (u >> 2), b = u & 3;
      Epi8Bf16 e{p.MIX + (size_t)(M_CTX + b * 4096) * 1024 + 512, 1024, 1.f / 512.f, 256};
      gemm8_tile(p.TWL, p.ABTF + (size_t)b * 256 * 4096, 4096, tm * 256, 0, smem, e);
    } else if (u < 40) { const int v = u - 8; mla_item(p, l, 1, (x + 8 * (v >> 4)) * 16 + (v & 15), smem); }
    else if (u < 72) { const int v = u - 40; swa_item(p, l, 1, (x + 8 * (v >> 4)) * 16 + (v & 15), smem); }
    else if (u < 136) gla_pass_c(p, l, 2 * (x * 64 + (u - 72)) + vhalf(), smem + vhalf() * HALF_BYTES);
    else if (u < 144) mla_item(p, l, 0, x * 8 + (u - 136), smem);
    else if (u < 152) swa_item(p, l, 0, x * 8 + (u - 144), smem);
    else if (u < 156) {
      const int w = x * 4 + (u - 152), b = w >> 1, tn = w & 1;
      EpiBf16 e{p.MIX + (size_t)(b * 256) * 1024 + 512, 1024, 1.f / 128.f, 256};
      gemm_tile<2>(p.TWC, 512, p.ABTC + (size_t)b * 256 * 512, 512, 512, 0, tn * 128, smem, e);
    } else gla_pass_c(p, l, 1024 + 2 * (x * 16 + (u - 156)) + vhalf(), smem + vhalf() * HALF_BYTES);
    if (PROBE_SPIN >= 9 && ltid() == 0) { const int cat = u < 8 ? 11 : u < 40 ? 9 : u < 72 ? 12 : u < 136 ? 10 : 13; if (cat == PROBE_SPIN) tl[1] += __builtin_amdgcn_s_memrealtime() - tl[0]; }
  }
}

#ifndef PROBE_DBL
#define PROBE_DBL 0
#endif
#define DBL(bit) (((PROBE_DBL) >> (bit)) & 1)
#ifndef ONLY_J
#define ONLY_J -1
#endif
#define EN(x) (ONLY_J < 0 || ONLY_J == (x))
constexpr int PPL = 14, N_PHASES = 2 + 4 * PPL;
constexpr int R_SPLIT = 16384;
#define MKP KP4 kq = kp; asm volatile("" : "+s"(kq)); const Params p = make_params(kq)
DI EwArgs ew_args(const Params& p, int kind, int l, int r_lo, int r_hi, int vb, int nvb) {
  float* Xc = p.X; float* Xl = Xc + (size_t)M_CTX * DM;
  EwArgs a{};
  a.r_lo = r_lo; a.r_hi = r_hi; a.vb = vb; a.nvb = nvb;
  a.xin_ctx = Xc; a.xin_lat = Xl; a.xout_ctx = Xc; a.xout_lat = Xl; a.in_f32 = 1; a.out_f32 = 1; a.F = p.F;
  if (kind == 0) { a.xin_ctx = p.x_prompt; a.xin_lat = p.x_sample; a.in_f32 = 1; a.F = nullptr; a.do_norm = 1; a.ln = 0; a.sc_idx = 1; a.sh_idx = 0; a.gpre_idx = 0; }
  else if (kind == 1) { if (l == 0) { a.xin_ctx = p.x_prompt; a.xin_lat = p.x_sample; a.in_f32 = 1; } a.lu = l; a.gate_idx = 2; a.gpost_idx = 1; a.res_w = 0.5f; a.do_norm = 1; a.ln = l; a.sc_idx = 4; a.sh_idx = 3; a.gpre_idx = 2; }
  else if (kind == 2) { a.lu = l; a.gate_idx = 5; a.gpost_idx = 3; a.res_w = 1.0f; a.do_norm = 1; a.ln = l; a.sc_idx = 7; a.sh_idx = 6; a.gpre_idx = 4; }
  else { a.lu = l; a.gate_idx = 8; a.gpost_idx = 5; a.res_w = 0.5f;
    if (l < 3) { a.do_norm = 1; a.ln = l + 1; a.sc_idx = 1; a.sh_idx = 0; a.gpre_idx = 0; }
    else { a.do_norm = 0; a.out_f32 = 1; a.xout_ctx = p.out + O_YP; a.xout_lat = p.out + O_YS; } }
  return a;
}
DI void run_phase(KP4 kp, int ph, unsigned char* smem, unsigned long long* tc) {
  MKP;
  if (ph == 0) { phase_init(p, smem); return; }
  const int bid = lbid(), nb = gridDim.x;
  const bool g2 = (bid & 7) < 2;
  const int vb2 = (bid >> 3) * 6 + ((bid & 7) - 2), nvb2 = (nb >> 3) * 6;
  int ew_kind = -1, ew_l = 0, ew_lo = 0, ew_hi = M_TOT, ew_vb = bid, ew_nvb = nb;
  if (ph == N_PHASES - 1) { ew_kind = 3; ew_l = 3; ew_lo = R_SPLIT; }
  else {
    const int l = (ph - 1) / PPL, j = (ph - 1) % PPL;
    switch (j) {
      case 0: convert_layer(p, l, smem);
        if (l == 0) { ew_kind = 0; } else { ew_kind = 3; ew_l = l - 1; ew_lo = R_SPLIT; } break;
      case 1: case 11: phase_gemm_gu(p, j == 11 ? 1 : 0, smem); break;
      case 2: case 3: case 12: case 13: {
        const int i = j >= 12 ? 1 : 0, round = j & 1;
        if (round == 0 || g2) phase_gemm_down(p, i, smem, round);
        else { ew_kind = i ? 3 : 1; ew_l = l; ew_hi = R_SPLIT; ew_vb = vb2; ew_nvb = nvb2; }
      } break;
      case 4: ew_kind = 1; ew_l = l; ew_lo = R_SPLIT; break;
      case 5: phase_gemm_win(p, l, smem); break;
      case 6: phase_prep(p, l, smem, (unsigned*)(GAS unsigned*)(kq->ws + OFF_BAR) + 3610 + l); break;
      case 7: phase_qkv(p, l, smem, (unsigned*)(GAS unsigned*)(kq->ws + OFF_BAR) + 3670 + l); break;
      case 8: phase_mixers(p, l, smem, (unsigned*)(GAS unsigned*)(kq->ws + OFF_BAR) + 3620 + l * 8, tc); break;
      case 9: phase_gemm_wout(p, smem); break;
      case 10: ew_kind = 2; ew_l = l; break;
    }
  }
  if (ew_kind >= 0) { const EwArgs a = ew_args(p, ew_kind, ew_l, ew_lo, ew_hi, ew_vb, ew_nvb); phase_ew(p, a); }
}

__global__ void __launch_bounds__(NT, 2) fwd_kernel(PArg pa, int ph_lo, int ph_hi) {
  extern __shared__ __attribute__((aligned(16))) unsigned char smem[];
  KP4 kp = (KP4)__builtin_amdgcn_kernarg_segment_ptr();
#if MULTI_LAUNCH
  unsigned long long tdummy = 0; for (int ph = ph_lo; ph < ph_hi; ++ph) run_phase(kp, ph, smem, &tdummy);
#else
  cg::grid_group grid = cg::this_grid();
  __shared__ uint4 xb_words;
  if (ltid() == 0) { xb_words = make_uint4(0u, 0u, 0u, 0u); if (PROBE_SPIN >= 9) ((volatile unsigned long long*)(smem + S_ITEM_OFF + 16))[1] = 0ull; }
  __syncthreads();
  const XcdBarrier xb = xcd_barrier_post((unsigned*)(pa.ws + OFF_BAR), (volatile LAS unsigned*)&xb_words);
#ifndef PROBE_SPIN
#define PROBE_SPIN 0
#endif
  unsigned long long tacc = 0;
  for (int ph = ph_lo; ph < ph_hi; ++ph) {
    const unsigned long long t0 = PROBE_SPIN ? __builtin_amdgcn_s_memrealtime() : 0ull;
    run_phase(kp, ph, smem, &tacc);
    if (ph + 1 < ph_hi) { if (ph == ph_lo) grid.sync(); else xcd_barrier(xb); }
    if (PROBE_SPIN) {
      const int j = (ph - 1) % PPL;
      const bool lay = ph >= 1 && ph < N_PHASES - 1;
      bool hit = false;
      if (PROBE_SPIN == 1) hit = lay && (j == 1 || j == 11);
      if (PROBE_SPIN == 2) hit = lay && (j == 2 || j == 3 || j == 12 || j == 13);
      if (PROBE_SPIN == 3) hit = ph == 0;
      if (PROBE_SPIN == 4) hit = lay && j == 6;
      if (PROBE_SPIN == 5) hit = lay && j == 8;
      if (PROBE_SPIN == 6) hit = lay && j == 7;
      if (PROBE_SPIN == 7) hit = lay && (j == 5 || j == 9);
      if (PROBE_SPIN == 8) hit = (lay && (j == 0 || j == 4 || j == 10)) || ph == N_PHASES - 1;
      if (hit) tacc += __builtin_amdgcn_s_memrealtime() - t0;
    }
  }
  if (PROBE_SPIN && blockIdx.x == 0 && threadIdx.x == 0) {
    if (PROBE_SPIN >= 9) tacc = ((volatile unsigned long long*)(smem + S_ITEM_OFF + 16))[1];
    const unsigned long long te = __builtin_amdgcn_s_memrealtime();
    while (__builtin_amdgcn_s_memrealtime() - te < tacc * 4ull) __builtin_amdgcn_s_sleep(8);
  }
#endif
}

extern "C" void kernel_launch(void* const* d_in, const int* in_sizes, int n_in, void* d_out, int out_size, void* d_ws, size_t ws_size,
                              hipStream_t stream) {
  PArg p{};
  for (int i = 0; i < 25; ++i) p.in[i] = (const float*)d_in[i];
  p.out = (float*)d_out;
  p.ws = (unsigned char*)d_ws;
  if (WS_NEED > ws_size) { fprintf(stderr, "workspace too small: need %zu have %zu\n", (size_t)WS_NEED, ws_size); return; }
#if MULTI_LAUNCH
  for (int ph = 0; ph < N_PHASES; ++ph) hipLaunchKernelGGL(fwd_kernel, dim3(256), dim3(NT), LDS_TOTAL, stream, p, ph, ph + 1);
#else
  static int grid_blocks = 0;
  if (!grid_blocks) {
    int dev = 0, cus = 0, per_cu = 0;
    (void)hipGetDevice(&dev);
    (void)hipDeviceGetAttribute(&cus, hipDeviceAttributeMultiprocessorCount, dev);
    if (hipFuncSetAttribute((const void*)fwd_kernel, hipFuncAttributeMaxDynamicSharedMemorySize, LDS_TOTAL) != hipSuccess) { fprintf(stderr, "hipFuncSetAttribute failed\n"); grid_blocks = -1; return; }
    (void)hipOccupancyMaxActiveBlocksPerMultiprocessor(&per_cu, fwd_kernel, NT, LDS_TOTAL);
    if (per_cu < 1) fprintf(stderr, "note: occupancy query reports %d blocks per CU\n", per_cu);
    (void)hipGetLastError();
    grid_blocks = cus;
  }
  if (grid_blocks < 0) return;
  (void)hipMemsetAsync((unsigned char*)d_ws + OFF_BAR, 0, 16384, stream);
  int lo = 0, hi = N_PHASES;
  void* args[] = {&p, &lo, &hi};
  hipError_t e = hipLaunchCooperativeKernel((void*)fwd_kernel, dim3(grid_blocks), dim3(NT), args, LDS_TOTAL, stream);
  if (e != hipSuccess) fprintf(stderr, "cooperative launch failed: %s (grid %d)\n", hipGetErrorString(e), grid_blocks);
#endif
}
```

```cpp
#include <hip/hip_runtime.h>
#include <hip/hip_cooperative_groups.h>
#include <cstdio>
#include <cstdint>
namespace cg = cooperative_groups;

#ifndef PROBE_SPIN
#define PROBE_SPIN 0
#endif
#ifndef MULTI_LAUNCH
#define MULTI_LAUNCH 0
#endif

#define DI __device__ __forceinline__
typedef unsigned short bf16_t;
typedef short bf16x8 __attribute__((ext_vector_type(8)));
typedef short bf16x4 __attribute__((ext_vector_type(4)));
typedef float f32x16 __attribute__((ext_vector_type(16)));
typedef unsigned u32x4 __attribute__((ext_vector_type(4)));
typedef unsigned u32x2 __attribute__((ext_vector_type(2)));
#define MFMA32(a, b, c) __builtin_amdgcn_mfma_f32_32x32x16_bf16((a), (b), (c), 0, 0, 0)

constexpr int NT = 512, NW = NT / 64, VT = 256, VW = 4;
constexpr int HALF_BYTES = 61440, S_ITEM_OFF = 131072, LDS_TOTAL = 131072 + 64;
constexpr int DM = 1024, M_CTX = 4096, M_LAT = 16384, M_TOT = 20480, M_EXT = 21504;
constexpr int DFF = 2816, DIN = 2240;
constexpr float EPS = 1e-6f;
constexpr int SMEM_BYTES = 60 * 1024;
constexpr int PITCH = 72;
constexpr int ZQG = 0, ZKG = 256, ZVG = 512, ZRG = 768, ZAF = 1024, ZQS = 1056, ZKS = 1312, ZVS = 1440, ZF = 1568, ZQA = 1824, ZKVA = 2080, ZKR = 2208;
constexpr size_t O_YP = 0, O_YS = 4194304, O_ST = 20971520, O_SK = 23068672, O_SV = 25165824, O_CKV = 27262976, O_KR = 29360128;

struct Params {
  const float *x_prompt, *x_sample, *c, *state_gla, *cache_swa_k, *cache_swa_v, *cache_mla_ckv, *cache_mla_krope, *c_ctx,
      *w_mod, *b_mod, *g_norm, *w_gate, *w_up, *w_down, *w_in, *gla_w_gate, *gla_b_gate, *gla_g_out, *swa_sink, *mla_g_q,
      *mla_g_kv, *w_qb, *w_kvb, *w_out;
  float* out;
  float *X, *F, *MOD, *ROPE_S, *ROPE_M, *GLA_B, *GLA_DL;
  bf16_t *H, *TWL, *TWC, *WGU, *WD, *WIN, *WOUT, *WQB, *WKVB, *ACT, *Z, *QS, *KS, *VS, *CKV, *QLAT, *KR, *QM, *KV, *ABTL,
      *ABTC, *GLA_S, *MIX, *DFTW, *ABTF;
};

constexpr size_t al256(size_t x) { return (x + 255) & ~(size_t)255; }
constexpr size_t OFF_X = 0;
constexpr size_t OFF_H = OFF_X + al256((size_t)M_TOT * DM * 4);
constexpr size_t OFF_MOD = OFF_H + al256((size_t)M_TOT * DM * 2);
constexpr size_t OFF_ROPE_S = OFF_MOD + al256((size_t)4 * 5 * 9216 * 4);
constexpr size_t OFF_ROPE_M = OFF_ROPE_S + al256(64 * 16 * 2 * 4);
constexpr size_t OFF_TWL = OFF_ROPE_M + al256(64 * 8 * 2 * 4);
constexpr size_t OFF_TWC = OFF_TWL + al256((size_t)4096 * 8192 * 2);
constexpr size_t OFF_WGU = OFF_TWC + al256((size_t)256 * 512 * 2);
constexpr size_t OFF_WD = OFF_WGU + al256((size_t)2 * 5632 * 1024 * 2);
constexpr size_t OFF_WIN = OFF_WD + al256((size_t)2 * 1024 * DFF * 2);
constexpr size_t OFF_WOUT = OFF_WIN + al256((size_t)2304 * 1024 * 2);
constexpr size_t OFF_WQB = OFF_WOUT + al256((size_t)1024 * 1024 * 2);
constexpr size_t OFF_WKVB = OFF_WQB + al256((size_t)384 * 256 * 2);
constexpr size_t OFF_Z = OFF_WKVB + al256((size_t)512 * 128 * 2);
constexpr size_t OFF_QS = OFF_Z + al256((size_t)M_TOT * DIN * 2);
constexpr size_t OFF_KS = OFF_QS + al256((size_t)M_TOT * 256 * 2);
constexpr size_t OFF_VS = OFF_KS + al256((size_t)M_EXT * 128 * 2);
constexpr size_t OFF_CKV = OFF_VS + al256((size_t)M_EXT * 128 * 2);
constexpr size_t OFF_QLAT = OFF_CKV + al256((size_t)M_EXT * 128 * 2);
constexpr size_t OFF_KR = OFF_QLAT + al256((size_t)M_TOT * 256 * 2);
constexpr size_t OFF_QM = OFF_KR + al256((size_t)M_EXT * 32 * 2);
constexpr size_t OFF_KV = OFF_QM + al256((size_t)M_TOT * 384 * 2);
constexpr size_t OFF_ABTL = OFF_KV + al256((size_t)M_EXT * 512 * 2);
constexpr size_t OFF_ABTC = OFF_ABTL + al256((size_t)4 * 256 * 8192 * 2);
constexpr size_t OFF_GLA_B = OFF_ABTC + al256((size_t)16 * 256 * 512 * 2);
constexpr size_t OFF_GLA_DL = OFF_GLA_B + al256((size_t)2560 * 4096 * 4);
constexpr size_t OFF_GLA_S = OFF_GLA_DL + al256((size_t)2560 * 64 * 4);
constexpr size_t OFF_MIX = OFF_GLA_S + al256((size_t)2560 * 4096 * 2);
constexpr size_t OFF_BAR = OFF_MIX + al256((size_t)M_TOT * 1024 * 2);
constexpr size_t OFF_DFTW = OFF_BAR + al256(16384);
constexpr size_t OFF_ABTF = OFF_DFTW + al256(128 * 64 * 2);
constexpr size_t OFF_END0 = OFF_ABTF + al256((size_t)4 * 256 * 4096 * 2);
constexpr size_t OFF_ACTEND = OFF_QS + al256((size_t)M_TOT * DFF * 2);
constexpr size_t WS_NEED = OFF_END0 > OFF_ACTEND ? OFF_END0 : OFF_ACTEND;
struct PArg { const float* in[25]; float* out; unsigned char* ws; };
#define GAS __attribute__((address_space(1)))
struct PArgG { GAS const float* in[25]; GAS float* out; GAS unsigned char* ws; };
typedef const __attribute__((address_space(4))) PArgG* KP4;
DI Params make_params(KP4 ap) {
  Params p;
  p.x_prompt = (const float*)ap->in[0];
  p.x_sample = (const float*)ap->in[1];
  p.c = (const float*)ap->in[2];
  p.state_gla = (const float*)ap->in[3];
  p.cache_swa_k = (const float*)ap->in[4];
  p.cache_swa_v = (const float*)ap->in[5];
  p.cache_mla_ckv = (const float*)ap->in[6];
  p.cache_mla_krope = (const float*)ap->in[7];
  p.c_ctx = (const float*)ap->in[8];
  p.w_mod = (const float*)ap->in[9];
  p.b_mod = (const float*)ap->in[10];
  p.g_norm = (const float*)ap->in[11];
  p.w_gate = (const float*)ap->in[12];
  p.w_up = (const float*)ap->in[13];
  p.w_down = (const float*)ap->in[14];
  p.w_in = (const float*)ap->in[15];
  p.gla_w_gate = (const float*)ap->in[16];
  p.gla_b_gate = (const float*)ap->in[17];
  p.gla_g_out = (const float*)ap->in[18];
  p.swa_sink = (const float*)ap->in[19];
  p.mla_g_q = (const float*)ap->in[20];
  p.mla_g_kv = (const float*)ap->in[21];
  p.w_qb = (const float*)ap->in[22];
  p.w_kvb = (const float*)ap->in[23];
  p.w_out = (const float*)ap->in[24];
  p.out = (float*)ap->out;
  p.X = (float*)(GAS float*)(ap->ws + OFF_X);
  p.H = (bf16_t*)(GAS bf16_t*)(ap->ws + OFF_H);
  p.MOD = (float*)(GAS float*)(ap->ws + OFF_MOD);
  p.ROPE_S = (float*)(GAS float*)(ap->ws + OFF_ROPE_S);
  p.ROPE_M = (float*)(GAS float*)(ap->ws + OFF_ROPE_M);
  p.TWL = (bf16_t*)(GAS bf16_t*)(ap->ws + OFF_TWL);
  p.TWC = (bf16_t*)(GAS bf16_t*)(ap->ws + OFF_TWC);
  p.WGU = (bf16_t*)(GAS bf16_t*)(ap->ws + OFF_WGU);
  p.WD = (bf16_t*)(GAS bf16_t*)(ap->ws + OFF_WD);
  p.WIN = (bf16_t*)(GAS bf16_t*)(ap->ws + OFF_WIN);
  p.WOUT = (bf16_t*)(GAS bf16_t*)(ap->ws + OFF_WOUT);
  p.WQB = (bf16_t*)(GAS bf16_t*)(ap->ws + OFF_WQB);
  p.WKVB = (bf16_t*)(GAS bf16_t*)(ap->ws + OFF_WKVB);
  p.Z = (bf16_t*)(GAS bf16_t*)(ap->ws + OFF_Z);
  p.QS = (bf16_t*)(GAS bf16_t*)(ap->ws + OFF_QS);
  p.KS = (bf16_t*)(GAS bf16_t*)(ap->ws + OFF_KS);
  p.VS = (bf16_t*)(GAS bf16_t*)(ap->ws + OFF_VS);
  p.CKV = (bf16_t*)(GAS bf16_t*)(ap->ws + OFF_CKV);
  p.QLAT = (bf16_t*)(GAS bf16_t*)(ap->ws + OFF_QLAT);
  p.KR = (bf16_t*)(GAS bf16_t*)(ap->ws + OFF_KR);
  p.QM = (bf16_t*)(GAS bf16_t*)(ap->ws + OFF_QM);
  p.KV = (bf16_t*)(GAS bf16_t*)(ap->ws + OFF_KV);
  p.ABTL = (bf16_t*)(GAS bf16_t*)(ap->ws + OFF_ABTL);
  p.ABTC = (bf16_t*)(GAS bf16_t*)(ap->ws + OFF_ABTC);
  p.GLA_B = (float*)(GAS float*)(ap->ws + OFF_GLA_B);
  p.GLA_DL = (float*)(GAS float*)(ap->ws + OFF_GLA_DL);
  p.GLA_S = (bf16_t*)(GAS bf16_t*)(ap->ws + OFF_GLA_S);
  p.MIX = (bf16_t*)(GAS bf16_t*)(ap->ws + OFF_MIX);
  p.DFTW = (bf16_t*)(GAS bf16_t*)(ap->ws + OFF_DFTW);
  p.ABTF = (bf16_t*)(GAS bf16_t*)(ap->ws + OFF_ABTF);
  p.F = (float*)(GAS float*)(ap->ws + OFF_Z);
  p.ACT = (bf16_t*)(GAS bf16_t*)(ap->ws + OFF_QS);
  return p;
}

DI int ltid() { int t = __builtin_amdgcn_workitem_id_x(); asm volatile("" : "+v"(t)); return t; }
DI int vtid() { return ltid() & 255; }
DI int vhalf() { return ltid() >> 8; }
DI int lbid() { int t = __builtin_amdgcn_workgroup_id_x(); asm volatile("" : "+s"(t)); return t; }
typedef float f32x2_t __attribute__((ext_vector_type(2)));
typedef __bf16 bf16x2_t __attribute__((ext_vector_type(2)));
DI bf16_t f2bf(float x) { return __builtin_bit_cast(bf16_t, (__bf16)x); }
DI float bf2f(bf16_t b) { return __uint_as_float(((unsigned)b) << 16); }
DI unsigned pack2(float a, float b) { f32x2_t v = {a, b}; return __builtin_bit_cast(unsigned, __builtin_convertvector(v, bf16x2_t)); }
DI float shx(float v, int o) { const int ln = ltid() & 63; return __int_as_float(__builtin_amdgcn_ds_bpermute((ln ^ o) << 2, __float_as_int(v))); }
DI float wave_sum(float v) {
#pragma unroll
  for (int o = 32; o > 0; o >>= 1) v += shx(v, o);
  return v;
}
DI float silu_f(float x) { return x * __builtin_amdgcn_rcpf(1.f + __builtin_amdgcn_exp2f(-1.4426950408889634f * x)); }
DI int crow(int r, int h) { return (r & 3) + 8 * (r >> 2) + 4 * h; }


#define XB_TMO      128
#define XB_XCNT(j)  (256  + 64 * (j))
#define XB_XSUB(j)  (1280 + 64 * (j))
#define XB_XGEN(j)  (2304 + 64 * (j))
#define XB_TOP      3328
#define XB_TOPGEN   3392
#define XCD_BAR_WORDS 3456
#define XB_SPIN_CAP (1u << 22)
#define LAS __attribute__((address_space(3)))
DI unsigned xb_ld(unsigned* p) { return __hip_atomic_load(p, __ATOMIC_RELAXED, __HIP_MEMORY_SCOPE_AGENT); }
DI unsigned xb_add(unsigned* p, unsigned v) { return __hip_atomic_fetch_add(p, v, __ATOMIC_RELAXED, __HIP_MEMORY_SCOPE_AGENT); }
DI unsigned xb_xcc_id() { return (unsigned)__builtin_amdgcn_s_getreg((3 << 11) | 20) & 0xFu; }
#define XB_SPIN(cond, bar) do { unsigned _sp = 0; while (cond) { __builtin_amdgcn_s_sleep(1); \
    if ((++_sp & 255u) == 0u) { if (xb_ld(&(bar)[XB_TMO])) break; if (_sp > XB_SPIN_CAP) { atomicAdd(&(bar)[XB_TMO], 1u); break; } } } } while (0)
struct XcdBarrier { unsigned* bar; unsigned x; volatile LAS unsigned* st; };
DI XcdBarrier xcd_barrier_post(unsigned* bar, volatile LAS unsigned* st) {
  XcdBarrier b; b.bar = bar; b.x = xb_xcc_id(); b.st = st;
  if (ltid() == 0) (void)xb_add(&bar[XB_XCNT(b.x)], 1u);
  return b;
}
DI void xcd_barrier_complete(unsigned* bar, unsigned x, unsigned& nloc, unsigned& nx) {
  const unsigned G = gridDim.x * gridDim.y * gridDim.z;
  unsigned sum, cnt, mine, sp = 0u;
  for (;;) {
    sum = 0u; cnt = 0u; mine = 0u;
#pragma unroll
    for (unsigned j = 0; j < 16; ++j) { const unsigned c = xb_ld(&bar[XB_XCNT(j)]); sum += c; cnt += (c > 0u) ? 1u : 0u; mine = (j == x) ? c : mine; }
    if (sum == G) break;
    __builtin_amdgcn_s_sleep(1);
    if ((++sp & 255u) == 0u) { if (xb_ld(&bar[XB_TMO])) break; if (sp > XB_SPIN_CAP) { atomicAdd(&bar[XB_TMO], 1u); break; } }
  }
  nloc = mine > 0u ? mine : 1u; nx = cnt > 0u ? cnt : 1u;
}
DI void xcd_barrier(const XcdBarrier& b) {
  asm volatile("s_waitcnt vmcnt(0)" ::: "memory");
  __syncthreads();
  if (ltid() == 0) {
    unsigned* bar = b.bar;
    __builtin_amdgcn_s_waitcnt(0);
    unsigned nloc = b.st[0], nx = b.st[1];
    if (nloc == 0u) { xcd_barrier_complete(bar, b.x, nloc, nx); b.st[0] = nloc; b.st[1] = nx; }
    const unsigned old = xb_add(&bar[XB_XSUB(b.x)], 1u);
    const unsigned gen = old / nloc;
    if (old + 1u == (gen + 1u) * nloc) {
      __builtin_amdgcn_fence(__ATOMIC_RELEASE, "agent");
      asm volatile("s_waitcnt vmcnt(0)" ::: "memory");
      const unsigned og = xb_add(&bar[XB_TOP], 1u);
      const unsigned tg = og / nx;
      if (og + 1u == (tg + 1u) * nx) xb_add(&bar[XB_TOPGEN], 1u);
      else XB_SPIN(xb_ld(&bar[XB_TOPGEN]) == tg, bar);
      __builtin_amdgcn_fence(__ATOMIC_ACQUIRE, "agent");
      xb_add(&bar[XB_XGEN(b.x)], 1u);
      asm volatile("s_waitcnt vmcnt(0)" ::: "memory");
    } else {
      XB_SPIN(xb_ld(&bar[XB_XGEN(b.x)]) == gen, bar);
      __builtin_amdgcn_fence(__ATOMIC_ACQUIRE, "agent");
      asm volatile("s_waitcnt vmcnt(0)" ::: "memory");
    }
  }
  __syncthreads();
}

template <int MB, class Epi>
DI void gemm_tile(const bf16_t* __restrict__ A, int lda, const bf16_t* __restrict__ Bt, int ldb, int K, int m0, int n0,
                  unsigned char* smem, const Epi& epi) {
  constexpr int BMR = 128 * MB, NA = 2 * MB;
  bf16_t* sA = (bf16_t*)smem;
  bf16_t* sB = sA + BMR * PITCH;
  const int tid = ltid(), lane = tid & 63, wid = tid >> 6, wm = wid >> 1, wn = wid & 1, l31 = lane & 31, h = lane >> 5;
  f32x16 acc[2][MB];
#pragma unroll
  for (int a = 0; a < 2; ++a)
#pragma unroll
    for (int b = 0; b < MB; ++b)
#pragma unroll
      for (int i = 0; i < 16; ++i) acc[a][b][i] = 0.f;
  const int lrow = tid >> 3, lkc = tid & 7;
  const bf16_t* Ap = A + (size_t)(m0 + lrow) * lda + lkc * 8;
  const bf16_t* Bp = Bt + (size_t)(n0 + lrow) * ldb + lkc * 8;
  const size_t sa32 = (size_t)64 * lda, sb32 = (size_t)64 * ldb;
  bf16_t* wA = sA + lrow * PITCH + lkc * 8;
  bf16_t* wB = sB + lrow * PITCH + lkc * 8;
  u32x4 ra[NA], rb[2];
#pragma unroll
  for (int i = 0; i < NA; ++i) ra[i] = *(const u32x4*)(Ap + i * sa32);
#pragma unroll
  for (int i = 0; i < 2; ++i) rb[i] = *(const u32x4*)(Bp + i * sb32);
  for (int k0 = 0; k0 < K; k0 += 64) {
    __syncthreads();
#pragma unroll
    for (int i = 0; i < NA; ++i) *(u32x4*)(wA + i * 64 * PITCH) = ra[i];
#pragma unroll
    for (int i = 0; i < 2; ++i) *(u32x4*)(wB + i * 64 * PITCH) = rb[i];
    __syncthreads();
    {
      const int kn = (k0 + 64 < K) ? k0 + 64 : k0;
#pragma unroll
      for (int i = 0; i < NA; ++i) ra[i] = *(const u32x4*)(Ap + kn + i * sa32);
#pragma unroll
      for (int i = 0; i < 2; ++i) rb[i] = *(const u32x4*)(Bp + kn + i * sb32);
    }
#pragma unroll
    for (int ks = 0; ks < 4; ++ks) {
      bf16x8 af[MB], bfr[2];
#pragma unroll
      for (int b = 0; b < MB; ++b) af[b] = *(const bf16x8*)(sA + (wm * 32 * MB + b * 32 + l31) * PITCH + ks * 16 + h * 8);
#pragma unroll
      for (int b = 0; b < 2; ++b) bfr[b] = *(const bf16x8*)(sB + (wn * 64 + b * 32 + l31) * PITCH + ks * 16 + h * 8);

#pragma unroll
      for (int nb = 0; nb < 2; ++nb)
#pragma unroll
        for (int mb = 0; mb < MB; ++mb) acc[nb][mb] = MFMA32(bfr[nb], af[mb], acc[nb][mb]);

    }
  }
  epi(acc, m0 + wm * 32 * MB, n0 + wn * 64, l31, h);
}

struct EpiF32 {
  float* C; int ldc;
  template <int MB> DI void operator()(const f32x16 (&acc)[2][MB], int mb0, int nb0, int l31, int h) const {
#pragma unroll
    for (int nb = 0; nb < 2; ++nb)
#pragma unroll
      for (int mb = 0; mb < MB; ++mb) {
        float* row = C + (size_t)(mb0 + mb * 32 + l31) * ldc + nb0 + nb * 32 + 4 * h;
#pragma unroll
        for (int g = 0; g < 4; ++g)
          *(float4*)(row + 8 * g) = make_float4(acc[nb][mb][4 * g], acc[nb][mb][4 * g + 1], acc[nb][mb][4 * g + 2], acc[nb][mb][4 * g + 3]);
      }
  }
};
struct EpiBf16 {
  bf16_t* C; int ldc; float scale; int ncols;
  template <int MB> DI void operator()(const f32x16 (&acc)[2][MB], int mb0, int nb0, int l31, int h) const {
#pragma unroll
    for (int nb = 0; nb < 2; ++nb)
#pragma unroll
      for (int mb = 0; mb < MB; ++mb) {
        const int col0 = nb0 + nb * 32 + 4 * h;
        bf16_t* row = C + (size_t)(mb0 + mb * 32 + l31) * ldc + col0;
#pragma unroll
        for (int g = 0; g < 4; ++g) {
          if (col0 + 8 * g < ncols) {
            uint2 w;
            w.x = pack2(acc[nb][mb][4 * g] * scale, acc[nb][mb][4 * g + 1] * scale);
            w.y = pack2(acc[nb][mb][4 * g + 2] * scale, acc[nb][mb][4 * g + 3] * scale);
            *(uint2*)(row + 8 * g) = w;
          }
        }
      }
  }
};
struct EpiGateUp {
  bf16_t* C;
  template <int MB> DI void operator()(const f32x16 (&acc)[2][MB], int mb0, int nb0, int l31, int h) const {
#pragma unroll
    for (int mb = 0; mb < MB; ++mb) {
      bf16_t* row = C + (size_t)(mb0 + mb * 32 + l31) * DFF + (nb0 >> 1) + 4 * h;
#pragma unroll
      for (int g = 0; g < 4; ++g) {
        float v[4];
#pragma unroll
        for (int i = 0; i < 4; ++i) v[i] = silu_f(acc[0][mb][4 * g + i]) * acc[1][mb][4 * g + i];
        uint2 w; w.x = pack2(v[0], v[1]); w.y = pack2(v[2], v[3]);
        *(uint2*)(row + 8 * g) = w;
      }
    }
  }
};
struct EpiWin {
  bf16_t* Z; float* out; int l;
  template <int MB> DI void operator()(const f32x16 (&acc)[2][MB], int mb0, int nb0, int l31, int h) const {
#pragma unroll
    for (int nb = 0; nb < 2; ++nb)
#pragma unroll
      for (int mb = 0; mb < MB; ++mb) {
        const int m = mb0 + mb * 32 + l31;
        const int col0 = nb0 + nb * 32 + 4 * h;
        bf16_t* row = Z + (size_t)m * DIN + col0;
#pragma unroll
        for (int g = 0; g < 4; ++g) {
          const int col = col0 + 8 * g;
          if (col < DIN) {
            uint2 w;
            w.x = pack2(acc[nb][mb][4 * g], acc[nb][mb][4 * g + 1]);
            w.y = pack2(acc[nb][mb][4 * g + 2], acc[nb][mb][4 * g + 3]);
            *(uint2*)(row + 8 * g) = w;
            if (m < M_CTX) {
              const int b = m >> 8, s = m & 255;
              const size_t tok = (size_t)((b * 4 + l) * 256 + s);
              float* dst = nullptr;
              if (col >= ZKS && col < ZVS) dst = out + O_SK + tok * 128 + (col - ZKS);
              else if (col >= ZVS && col < ZF) dst = out + O_SV + tok * 128 + (col - ZVS);
              else if (col >= ZKR) dst = out + O_KR + tok * 32 + (col - ZKR);
              if (dst) *(float4*)dst = make_float4(acc[nb][mb][4 * g], acc[nb][mb][4 * g + 1], acc[nb][mb][4 * g + 2], acc[nb][mb][4 * g + 3]);
            }
          }
        }
      }
  }
};
struct EpiQm {
  bf16_t* C; const float* rope_m;
  template <int MB> DI void operator()(const f32x16 (&acc)[2][MB], int mb0, int nb0, int l31, int h) const {
#pragma unroll
    for (int nb = 0; nb < 2; ++nb) {
      const int cb = nb0 + nb * 32;
      const bool isrope = ((cb >> 5) % 3) == 2;
#pragma unroll
      for (int mb = 0; mb < MB; ++mb) {
        const int m = mb0 + mb * 32 + l31;
        float v[16];
#pragma unroll
        for (int i = 0; i < 16; ++i) v[i] = acc[nb][mb][i];
        if (isrope && m >= M_CTX) {
          const int t = (m - M_CTX) & 4095;
          const int prow = t >> 6, pcol = t & 63;
#pragma unroll
          for (int half = 0; half < 2; ++half) {
            const int pos = half ? pcol : prow;
#pragma unroll
            for (int i = 0; i < 4; ++i) {
              const int j = 4 * h + i;
              const float cs = rope_m[(pos * 8 + j) * 2], sn = rope_m[(pos * 8 + j) * 2 + 1];
              const float x1 = v[8 * half + i], x2 = v[8 * half + 4 + i];
              v[8 * half + i] = x1 * cs - x2 * sn;
              v[8 * half + 4 + i] = x2 * cs + x1 * sn;
            }
          }
        }
        bf16_t* row = C + (size_t)m * 384 + cb + 4 * h;
#pragma unroll
        for (int g = 0; g < 4; ++g) {
          uint2 w; w.x = pack2(v[4 * g], v[4 * g + 1]); w.y = pack2(v[4 * g + 2], v[4 * g + 3]);
          *(uint2*)(row + 8 * g) = w;
        }
      }
    }
  }
};

struct EpiDft {
  bf16_t* ABTL; bf16_t* ABTC; int g;
  template <int MB> DI void operator()(const f32x16 (&acc)[2][MB], int mb0, int nb0, int l31, int h) const {
    const int type = nb0 >> 6;
#pragma unroll
    for (int mb = 0; mb < MB; ++mb) {
      const int m = mb0 + mb * 32 + l31;
      bf16_t* base; size_t stride;
      if (m >= M_CTX) { const int b = (m - M_CTX) >> 12, sq = (m - M_CTX) & 4095; base = ABTL + ((size_t)b * 256 + g * 64) * 8192 + type * 4096 + sq; stride = 8192; }
      else { const int b = m >> 8, sq = m & 255; base = ABTC + ((size_t)b * 256 + g * 64) * 512 + type * 256 + sq; stride = 512; }
#pragma unroll
      for (int nb = 0; nb < 2; ++nb)
#pragma unroll
        for (int i = 0; i < 16; ++i) base[(size_t)(nb * 32 + crow(i, h)) * stride] = f2bf(acc[nb][mb][i]);
    }
  }
};


typedef float f32x4v __attribute__((ext_vector_type(4)));
DI int g8_lds_byte(int r, int c) { const int st = (r >> 4) * 2 + (c >> 5), rr = r & 15, cc = c & 31, ob = rr * 64 + cc * 2; return st * 1024 + (ob ^ (((ob >> 9) & 1) << 5)); }
DI void g8_stage_rc(int b, int& R, int& C) { const int st = b / 1024, sb = b % 1024, swz = sb ^ (((sb >> 9) & 1) << 5); R = (st >> 1) * 16 + swz / 64; C = (st & 1) * 32 + (swz % 64) / 2; }
DI const char* uni_ptr(const void* p) { const unsigned long long v = (unsigned long long)p; const unsigned lo = __builtin_amdgcn_readfirstlane((unsigned)v), hi = __builtin_amdgcn_readfirstlane((unsigned)(v >> 32)); return (const char*)(((unsigned long long)hi << 32) | lo); }
template <class Epi>
DI void gemm8_tile(const bf16_t* __restrict__ A, const bf16_t* __restrict__ Bt, int K, int brow, int bcol, unsigned char* smem, const Epi& epi,
                   bool first = true, bool has_next = false, int nbrow = 0, int nbcol = 0) {
  constexpr int HTB = 16384;
  const int tid = ltid(), wid = tid >> 6, lane = tid & 63, wr = wid >> 2, wc = wid & 3, fr = lane & 15, fq = lane >> 4;
  int sr0, sc0, sr1, sc1;
  g8_stage_rc(tid * 16, sr0, sc0); g8_stage_rc(tid * 16 + 8192, sr1, sc1);
  const unsigned bo0 = (unsigned)(sr0 * K + sc0) * 2u;
  const int swz_ = (fr * 64 + fq * 16) ^ ((((fr * 64 + fq * 16) >> 9) & 1) << 5);
  const int aoff = wr * 8192 + swz_, boff = wc * 4096 + swz_;
#define G8_SA(b, h) (smem + ((b) * 2 + (h)) * HTB)
#define G8_SB(b, h) (smem + (4 + (b) * 2 + (h)) * HTB)
#define G8_STAGE(P, BASE, br, kt) do { const char* _g = uni_ptr((BASE) + (size_t)(br) * K + (size_t)(kt) * 64); \
    const char* _g2 = uni_ptr(_g + (size_t)128 * K); \
    __builtin_amdgcn_global_load_lds((const unsigned*)(_g + bo0), (unsigned*)((P) + tid * 16), 16, 0, 0); \
    __builtin_amdgcn_global_load_lds((const unsigned*)(_g2 + bo0), (unsigned*)((P) + tid * 16 + 8192), 16, 0, 0); } while (0)
#define G8_LDA(dst, b, h) _Pragma("unroll") for (int m = 0; m < 4; ++m) _Pragma("unroll") for (int k = 0; k < 2; ++k) \
    dst[m][k] = *(const bf16x8*)(G8_SA(b, h) + aoff + m * 2048 + k * 1024)
#define G8_LDB(dst, b, h) _Pragma("unroll") for (int n = 0; n < 2; ++n) _Pragma("unroll") for (int k = 0; k < 2; ++k) \
    dst[n][k] = *(const bf16x8*)(G8_SB(b, h) + boff + n * 2048 + k * 1024)
#define G8_MMA(ai, bj, At_, Bx_) do { __builtin_amdgcn_s_setprio(1); \
    _Pragma("unroll") for (int m = 0; m < 4; ++m) _Pragma("unroll") for (int n = 0; n < 2; ++n) _Pragma("unroll") for (int k = 0; k < 2; ++k) \
      acc[ai][bj][m][n] = __builtin_amdgcn_mfma_f32_16x16x32_bf16(Bx_[n][k], At_[m][k], acc[ai][bj][m][n], 0, 0, 0); \
    __builtin_amdgcn_s_setprio(0); } while (0)
#define G8_WAIT_V(n) asm volatile("s_waitcnt vmcnt(" #n ")" ::: "memory")
#define G8_WAIT_L(n) asm volatile("s_waitcnt lgkmcnt(" #n ")" ::: "memory")
#define G8_BAR __builtin_amdgcn_s_barrier()
#define G8_SCHED __builtin_amdgcn_sched_barrier(0)
  f32x4v acc[2][2][4][2];
#pragma unroll
  for (int a = 0; a < 2; ++a)
#pragma unroll
    for (int b = 0; b < 2; ++b)
#pragma unroll
      for (int m = 0; m < 4; ++m)
#pragma unroll
        for (int n = 0; n < 2; ++n) acc[a][b][m][n] = (f32x4v){0.f, 0.f, 0.f, 0.f};
  bf16x8 At[4][2], B0[2][2], B1[2][2];
  const int nt = K / 64;
  if (first) {
    G8_WAIT_V(0);
    __syncthreads();
    G8_STAGE(G8_SB(0, 0), Bt, bcol, 0); G8_STAGE(G8_SA(0, 0), A, brow, 0);
    G8_STAGE(G8_SB(0, 1), Bt, bcol + 128, 0); G8_STAGE(G8_SA(0, 1), A, brow + 128, 0);
  }
  if (wr == 1) G8_BAR;
  G8_WAIT_V(4); G8_BAR;
  G8_STAGE(G8_SB(1, 0), Bt, bcol, 1); G8_STAGE(G8_SA(1, 0), A, brow, 1); G8_STAGE(G8_SB(1, 1), Bt, bcol + 128, 1);
  G8_WAIT_V(6); G8_BAR;
  for (int t = 0; t < nt - 2; t += 2) {
    G8_LDB(B0, 0, 0); G8_SCHED; G8_LDA(At, 0, 0); G8_STAGE(G8_SA(1, 1), A, brow + 128, t + 1);
    G8_WAIT_L(8); G8_BAR; G8_WAIT_L(0); G8_MMA(0, 0, At, B0); G8_BAR; G8_SCHED;
    G8_LDB(B1, 0, 1); G8_STAGE(G8_SB(0, 0), Bt, bcol, t + 2);
    G8_BAR; G8_WAIT_L(0); G8_MMA(0, 1, At, B1); G8_BAR;
    G8_LDA(At, 0, 1); G8_STAGE(G8_SA(0, 0), A, brow, t + 2);
    G8_BAR; G8_WAIT_L(0); G8_MMA(1, 0, At, B0); G8_BAR; G8_SCHED;
    G8_STAGE(G8_SB(0, 1), Bt, bcol + 128, t + 2);
    G8_WAIT_V(6); G8_BAR; G8_MMA(1, 1, At, B1); G8_BAR;
    G8_LDB(B0, 1, 0); G8_SCHED; G8_LDA(At, 1, 0); G8_STAGE(G8_SA(0, 1), A, brow + 128, t + 2);
    G8_WAIT_L(8); G8_BAR; G8_WAIT_L(0); G8_MMA(0, 0, At, B0); G8_BAR; G8_SCHED;
    G8_LDB(B1, 1, 1); G8_STAGE(G8_SB(1, 0), Bt, bcol, t + 3);
    G8_BAR; G8_WAIT_L(0); G8_MMA(0, 1, At, B1); G8_BAR;
    G8_LDA(At, 1, 1); G8_STAGE(G8_SA(1, 0), A, brow, t + 3);
    G8_BAR; G8_WAIT_L(0); G8_MMA(1, 0, At, B0); G8_BAR; G8_SCHED;
    G8_STAGE(G8_SB(1, 1), Bt, bcol + 128, t + 3);
    G8_WAIT_V(6); G8_BAR; G8_MMA(1, 1, At, B1); G8_BAR;
  }
  { G8_LDB(B0, 0, 0); G8_LDA(At, 0, 0); G8_STAGE(G8_SA(1, 1), A, brow + 128, nt - 1);
    G8_BAR; G8_WAIT_L(0); G8_MMA(0, 0, At, B0); G8_BAR;
    G8_LDB(B1, 0, 1); G8_BAR; G8_WAIT_L(0); G8_MMA(0, 1, At, B1); G8_BAR;
    G8_LDA(At, 0, 1); G8_WAIT_V(4); G8_BAR; G8_WAIT_L(0); G8_MMA(1, 0, At, B0); G8_MMA(1, 1, At, B1); G8_BAR; }
  { G8_LDB(B0, 1, 0); G8_LDA(At, 1, 0); G8_WAIT_V(2); G8_BAR; G8_WAIT_L(0); G8_MMA(0, 0, At, B0); G8_BAR;
    G8_LDB(B1, 1, 1); G8_WAIT_V(0); G8_BAR; G8_WAIT_L(0); G8_MMA(0, 1, At, B1); G8_BAR;
    G8_LDA(At, 1, 1); G8_BAR; G8_WAIT_L(0); G8_MMA(1, 0, At, B0); G8_MMA(1, 1, At, B1); G8_BAR; }
  if (wr == 0) G8_BAR;
  if (has_next) {
    G8_STAGE(G8_SB(0, 0), Bt, nbcol, 0); G8_STAGE(G8_SA(0, 0), A, nbrow, 0);
    G8_STAGE(G8_SB(0, 1), Bt, nbcol + 128, 0); G8_STAGE(G8_SA(0, 1), A, nbrow + 128, 0);
  }
  epi(acc, brow, bcol);
}
struct Epi8Bf16 {
  bf16_t* C; int ldc; float scale; int ncols;
  DI void operator()(const f32x4v (&acc)[2][2][4][2], int brow, int bcol) const {
    const int tid_ = ltid(), wid_ = tid_ >> 6, wr = wid_ >> 2, wc = wid_ & 3, fr = tid_ & 15, fq = (tid_ & 63) >> 4;
#pragma unroll
    for (int ai = 0; ai < 2; ++ai)
#pragma unroll
      for (int m = 0; m < 4; ++m) {
        bf16_t* row = C + (size_t)(brow + ai * 128 + wr * 64 + m * 16 + fr) * ldc;
#pragma unroll
        for (int bj = 0; bj < 2; ++bj)
#pragma unroll
          for (int n = 0; n < 2; ++n) {
            const int col = bcol + bj * 128 + wc * 32 + n * 16 + 4 * fq;
            if (col < ncols) {
              const f32x4v v = acc[ai][bj][m][n];
              u32x2 w; w[0] = pack2(v[0] * scale, v[1] * scale); w[1] = pack2(v[2] * scale, v[3] * scale);
              *(u32x2*)(row + col) = w;
            }
          }
      }
  }
};
struct Epi8GateUp {
  bf16_t* C;
  DI void operator()(const f32x4v (&acc)[2][2][4][2], int brow, int bcol) const {
    const int tid_ = ltid(), wid_ = tid_ >> 6, wr = wid_ >> 2, wc = wid_ & 3, fr = tid_ & 15, fq = (tid_ & 63) >> 4;
#pragma unroll
    for (int ai = 0; ai < 2; ++ai)
#pragma unroll
      for (int m = 0; m < 4; ++m) {
        bf16_t* row = C + (size_t)(brow + ai * 128 + wr * 64 + m * 16 + fr) * DFF;
#pragma unroll
        for (int bj = 0; bj < 2; ++bj) {
          const int col = ((bcol + bj * 128 + wc * 32) >> 1) + 4 * fq;
          const f32x4v g = acc[ai][bj][m][0], u = acc[ai][bj][m][1];
          u32x2 w; w[0] = pack2(silu_f(g[0]) * u[0], silu_f(g[1]) * u[1]); w[1] = pack2(silu_f(g[2]) * u[2], silu_f(g[3]) * u[3]);
          *(u32x2*)(row + col) = w;
        }
      }
  }
};
struct Epi8Win {
  bf16_t* Z; float* out; int l;
  DI void operator()(const f32x4v (&acc)[2][2][4][2], int brow, int bcol) const {
    const int tid_ = ltid(), wid_ = tid_ >> 6, wr = wid_ >> 2, wc = wid_ & 3, fr = tid_ & 15, fq = (tid_ & 63) >> 4;
#pragma unroll
    for (int ai = 0; ai < 2; ++ai)
#pragma unroll
      for (int m = 0; m < 4; ++m) {
        const int mrow = brow + ai * 128 + wr * 64 + m * 16 + fr;
        bf16_t* row = Z + (size_t)mrow * DIN;
#pragma unroll
        for (int bj = 0; bj < 2; ++bj)
#pragma unroll
          for (int n = 0; n < 2; ++n) {
            const int col = bcol + bj * 128 + wc * 32 + n * 16 + 4 * fq;
            if (col < DIN) {
              const f32x4v v = acc[ai][bj][m][n];
              u32x2 w; w[0] = pack2(v[0], v[1]); w[1] = pack2(v[2], v[3]);
              *(u32x2*)(row + col) = w;
              if (mrow < M_CTX) {
                const int b = mrow >> 8, sq = mrow & 255;
                const size_t tok = (size_t)((b * 4 + l) * 256 + sq);
                float* dst = nullptr;
                if (col >= ZKS && col < ZVS) dst = out + O_SK + tok * 128 + (col - ZKS);
                else if (col >= ZVS && col < ZF) dst = out + O_SV + tok * 128 + (col - ZVS);
                else if (col >= ZKR) dst = out + O_KR + tok * 32 + (col - ZKR);
                if (dst) *(float4*)dst = make_float4(v[0], v[1], v[2], v[3]);
              }
            }
          }
      }
  }
};

DI void mod_item(const Params& p, int it, unsigned char* smem) {
  float* sc = (float*)smem;
  float* red = sc + 5 * 1024;
  const int tid = vtid(), lane = tid & 63, wid = tid >> 6;
  const int l = it / 144, n = (it % 144) * 64 + lane;
  __syncthreads();
  for (int e = tid; e < 5 * 1024; e += VT) {
    const int i = e >> 10, k = e & 1023;
    const float v = i == 0 ? p.c_ctx[k] : p.c[(i - 1) * 1024 + k];
    sc[e] = v / (1.f + expf(-v));
  }
  __syncthreads();
  float a0 = 0, a1 = 0, a2 = 0, a3 = 0, a4 = 0;
  const float* w = p.w_mod + ((size_t)l * 1024 + wid * 256) * 9216 + n;
#pragma unroll 32
  for (int k = 0; k < 256; ++k) {
    const float wv = w[(size_t)k * 9216];
    const int kk = wid * 256 + k;
    a0 += sc[kk] * wv; a1 += sc[1024 + kk] * wv; a2 += sc[2048 + kk] * wv; a3 += sc[3072 + kk] * wv; a4 += sc[4096 + kk] * wv;
  }
  red[(wid * 5 + 0) * 64 + lane] = a0; red[(wid * 5 + 1) * 64 + lane] = a1; red[(wid * 5 + 2) * 64 + lane] = a2;
  red[(wid * 5 + 3) * 64 + lane] = a3; red[(wid * 5 + 4) * 64 + lane] = a4;
  __syncthreads();
  for (int e = tid; e < 320; e += VT) {
    const int i = e >> 6, cl = e & 63;
    float s = 0.f;
    for (int w4 = 0; w4 < 4; ++w4) s += red[(w4 * 5 + i) * 64 + cl];
    const int col = (it % 144) * 64 + cl;
    p.MOD[(size_t)(l * 5 + i) * 9216 + col] = s + p.b_mod[(size_t)l * 9216 + col];
  }
}

DI void phase_init(const Params& p, unsigned char* smem) {
  const int nb = gridDim.x, bid = lbid(), tid = ltid();
  for (int pr = bid; pr < 288; pr += nb) mod_item(p, 2 * pr + vhalf(), smem + vhalf() * HALF_BYTES);
  for (int it = 576 + bid; it < 1602; it += nb) {
    if (it < 1600) {
      const int r0 = (it - 576) * 4;
      for (int e = tid; e < 4 * 512; e += NT) {
        const int r = r0 + (e >> 9), k8 = (e & 511) * 8;
        unsigned w[4];
#pragma unroll
        for (int j = 0; j < 4; ++j) {
          float v[2];
#pragma unroll
          for (int q = 0; q < 2; ++q) {
            const int k = k8 + 2 * j + q;
            const int kk = k <= 2048 ? k : k - 2048;
            const int idx = (r * kk) & 4095;
            const float ang = (float)idx * (1.0f / 2048.0f);
            v[q] = k <= 2048 ? cospif(ang) : -sinpif(ang);
          }
          w[j] = pack2(v[0], v[1]);
        }
        *(uint4*)(p.TWL + (size_t)r * 4096 + k8) = make_uint4(w[0], w[1], w[2], w[3]);
      }
    } else if (it == 1600) {
      for (int e = tid; e < 256 * 512; e += NT) {
        const int r = e >> 9, k = e & 511;
        const int idx = (r * (k & 255)) & 255;
        const float ang = (float)idx * (1.0f / 128.0f);
        p.TWC[e] = f2bf(k < 256 ? cospif(ang) : -sinpif(ang));
      }
    } else {
      for (int e = tid; e < 64 * 16; e += NT) {
        const int pos = e >> 4, j = e & 15;
        const float inv = powf(10000.0f, -(float)(2 * j) / 32.0f);
        const float ang = (float)pos * inv;
        p.ROPE_S[e * 2] = cosf(ang); p.ROPE_S[e * 2 + 1] = sinf(ang);
      }
      for (int e = tid; e < 128 * 64; e += NT) {
        const int n = e >> 6, c = e & 63;
        const float ang = (float)((c * (n & 63)) & 63) * (1.f / 32.f);
        p.DFTW[e] = f2bf(n < 64 ? cospif(ang) : sinpif(ang));
      }
      for (int e = tid; e < 64 * 8; e += NT) {
        const int pos = e >> 3, j = e & 7;
        const float inv = powf(10000.0f, -(float)(2 * j) / 16.0f);
        const float ang = (float)pos * inv;
        p.ROPE_M[e * 2] = cosf(ang); p.ROPE_M[e * 2 + 1] = sinf(ang);
      }
    }
  }
}

DI void conv_tile(const float* __restrict__ src, int N, bf16_t* __restrict__ dst, int K, int kt, int nt, int mode, unsigned char* smem) {
  float* ts = (float*)smem;
  const int tid = vtid();
  __syncthreads();
#pragma unroll
  for (int i = 0; i < 4; ++i) {
    const int r = (tid >> 4) + 16 * i, c4 = (tid & 15) * 4;
    const float4 v = *(const float4*)(src + (size_t)(kt * 64 + r) * N + nt * 64 + c4);
    ts[r * 65 + c4] = v.x; ts[r * 65 + c4 + 1] = v.y; ts[r * 65 + c4 + 2] = v.z; ts[r * 65 + c4 + 3] = v.w;
  }
  __syncthreads();
  const int nl = tid >> 2, ks = (tid & 3) * 16;
  const int n = nt * 64 + nl;
  int drow = n;
  if (mode == 1) drow = (n >> 4) * 32 + (n & 15);
  else if (mode == 2) drow = (n >> 4) * 32 + 16 + (n & 15);
  unsigned w[8];
#pragma unroll
  for (int j = 0; j < 8; ++j) w[j] = pack2(ts[(ks + 2 * j) * 65 + nl], ts[(ks + 2 * j + 1) * 65 + nl]);
  bf16_t* d = dst + (size_t)drow * K + kt * 64 + ks;
  *(uint4*)d = make_uint4(w[0], w[1], w[2], w[3]);
  *(uint4*)(d + 8) = make_uint4(w[4], w[5], w[6], w[7]);
}
DI void convert_layer(const Params& p, int l, unsigned char* smem) {
  smem += vhalf() * HALF_BYTES;
  for (int t = 2 * lbid() + vhalf(); t < 5080; t += 2 * gridDim.x) {
    if (t < 2816) {
      const int q = t / 704, r = t % 704, i = q >> 1, which = q & 1;
      const float* src = (which ? p.w_up : p.w_gate) + (size_t)(l * 2 + i) * 1024 * DFF;
      conv_tile(src, DFF, p.WGU + (size_t)i * 5632 * 1024, 1024, r / 44, r % 44, 1 + which, smem);
    } else if (t < 4224) {
      const int q = (t - 2816) / 704, r = (t - 2816) % 704;
      conv_tile(p.w_down + (size_t)(l * 2 + q) * DFF * 1024, 1024, p.WD + (size_t)q * 1024 * DFF, DFF, r / 16, r % 16, 0, smem);
    } else if (t < 4784) {
      const int r = t - 4224;
      conv_tile(p.w_in + (size_t)l * 1024 * DIN, DIN, p.WIN, 1024, r / 35, r % 35, 0, smem);
    } else if (t < 5040) {
      const int r = t - 4784;
      conv_tile(p.w_out + (size_t)l * 1024 * 1024, 1024, p.WOUT, 1024, r / 16, r % 16, 0, smem);
    } else if (t < 5064) {
      const int r = t - 5040;
      conv_tile(p.w_qb + (size_t)l * 256 * 384, 384, p.WQB, 256, r / 6, r % 6, 0, smem);
    } else {
      const int r = t - 5064;
      conv_tile(p.w_kvb + (size_t)l * 128 * 512, 512, p.WKVB, 128, r / 8, r % 8, 0, smem);
    }
  }
}

struct EwArgs {
  const void *xin_ctx, *xin_lat; void *xout_ctx, *xout_lat;
  int in_f32, out_f32;
  const float* F; int lu, gate_idx, gpost_idx; float res_w;
  int do_norm, ln, sc_idx, sh_idx, gpre_idx;
  int r_lo, r_hi, vb, nvb;
};
DI float4 ld4_bf16(const bf16_t* p) { const u32x2 v = *(const u32x2*)p; return make_float4(__uint_as_float(v[0] << 16), __uint_as_float(v[0] & 0xffff0000u), __uint_as_float(v[1] << 16), __uint_as_float(v[1] & 0xffff0000u)); }
DI void phase_ew(const Params& p, const EwArgs& a) {
  const int lane = ltid() & 63, gw = a.vb * NW + (ltid() >> 6), nwv = a.nvb * NW;
  const bool upd = a.F != nullptr;
  const int rpw = (a.r_hi - a.r_lo + nwv - 1) / nwv;
  const int r0 = a.r_lo + gw * rpw, r1 = r0 + rpw < a.r_hi ? r0 + rpw : a.r_hi;
  float4 g[4], q[4], s4[4], t4[4], u4[4];
  int cur_mi = -1;
  for (int r = r0; r < r1; ++r) {
    const int mi = r < M_CTX ? 0 : 1 + ((r - M_CTX) >> 12);
    if (mi != cur_mi) {
      cur_mi = mi;
      const float* __restrict__ gate = p.MOD + (size_t)(a.lu * 5 + mi) * 9216 + a.gate_idx * 1024;
      const float* __restrict__ gpo = p.g_norm + (size_t)(a.lu * 6 + a.gpost_idx) * 1024;
      const float* __restrict__ sc = p.MOD + (size_t)(a.ln * 5 + mi) * 9216 + a.sc_idx * 1024;
      const float* __restrict__ sh = p.MOD + (size_t)(a.ln * 5 + mi) * 9216 + a.sh_idx * 1024;
      const float* __restrict__ gpr = p.g_norm + (size_t)(a.ln * 6 + a.gpre_idx) * 1024;
#pragma unroll
      for (int j = 0; j < 4; ++j) {
        const int c = lane * 4 + 256 * j;
        if (upd) { g[j] = *(const float4*)(gate + c); q[j] = *(const float4*)(gpo + c); }
        if (a.do_norm) { s4[j] = *(const float4*)(sc + c); t4[j] = *(const float4*)(sh + c); u4[j] = *(const float4*)(gpr + c); }
      }
    }
    const size_t ro = r < M_CTX ? (size_t)r * DM : (size_t)(r - M_CTX) * DM;
    const void* xb = r < M_CTX ? a.xin_ctx : a.xin_lat;
    float4 x[4], f[4];
#pragma unroll
    for (int j = 0; j < 4; ++j) {
      const int c = lane * 4 + 256 * j;
      x[j] = a.in_f32 ? *(const float4*)((const float*)xb + ro + c) : ld4_bf16((const bf16_t*)xb + ro + c);
      if (upd) f[j] = ld4_bf16((const bf16_t*)a.F + (size_t)r * DM + c);
    }
    if (upd) {
      float ss = 0.f;
#pragma unroll
      for (int j = 0; j < 4; ++j) ss += f[j].x * f[j].x + f[j].y * f[j].y + f[j].z * f[j].z + f[j].w * f[j].w;
      ss = wave_sum(ss);
      const float rs = rsqrtf(ss * (1.f / 1024.f) + EPS) * a.res_w;
      void* ob = r < M_CTX ? a.xout_ctx : a.xout_lat;
#pragma unroll
      for (int j = 0; j < 4; ++j) {
        const int c = lane * 4 + 256 * j;
        x[j].x += g[j].x * (f[j].x * rs * q[j].x); x[j].y += g[j].y * (f[j].y * rs * q[j].y);
        x[j].z += g[j].z * (f[j].z * rs * q[j].z); x[j].w += g[j].w * (f[j].w * rs * q[j].w);
        if (a.out_f32) *(float4*)((float*)ob + ro + c) = x[j];
        else { u32x2 w; w[0] = pack2(x[j].x, x[j].y); w[1] = pack2(x[j].z, x[j].w); *(u32x2*)((bf16_t*)ob + ro + c) = w; }
      }
    }
    if (a.do_norm) {
      float ss = 0.f;
#pragma unroll
      for (int j = 0; j < 4; ++j) ss += x[j].x * x[j].x + x[j].y * x[j].y + x[j].z * x[j].z + x[j].w * x[j].w;
      ss = wave_sum(ss);
      const float rs = rsqrtf(ss * (1.f / 1024.f) + EPS);
      bf16_t* hr = p.H + (size_t)r * DM;
#pragma unroll
      for (int j = 0; j < 4; ++j) {
        u32x2 w;
        w[0] = pack2(x[j].x * rs * u4[j].x * (1.f + s4[j].x) + t4[j].x, x[j].y * rs * u4[j].y * (1.f + s4[j].y) + t4[j].y);
        w[1] = pack2(x[j].z * rs * u4[j].z * (1.f + s4[j].z) + t4[j].z, x[j].w * rs * u4[j].w * (1.f + s4[j].w) + t4[j].w);
        *(u32x2*)(hr + lane * 4 + 256 * j) = w;
      }
    }
  }
}

DI void prep_item(const Params& p, int l, int it, unsigned char* smem) {
  const int tid = ltid(), lane = tid & 63, wid = tid >> 6;
  const int r0 = it * 64;
  if (r0 >= M_TOT) {
    for (int e = tid; e < 64 * 128; e += NT) {
      const int rr = e >> 7, cc = e & 127, idx = r0 - M_TOT + rr, b = idx >> 8, j = idx & 255;
      const size_t src = ((size_t)(b * 4 + l) * 256 + j) * 128 + cc;
      const size_t dst = (size_t)(r0 + rr) * 128 + cc;
      p.KS[dst] = f2bf(p.cache_swa_k[src]);
      p.VS[dst] = f2bf(p.cache_swa_v[src]);
      p.CKV[dst] = f2bf(p.cache_mla_ckv[src]);
    }
    for (int e = tid; e < 64 * 32; e += NT) {
      const int rr = e >> 5, cc = e & 31, idx = r0 - M_TOT + rr, b = idx >> 8, j = idx & 255;
      p.KR[(size_t)(r0 + rr) * 32 + cc] = f2bf(p.cache_mla_krope[((size_t)(b * 4 + l) * 256 + j) * 32 + cc]);
    }
    return;
  }
  const bool lat = r0 >= M_CTX;
  const bf16_t* __restrict__ Zr = p.Z; bf16_t* __restrict__ QSr = p.QS; bf16_t* __restrict__ KSr = p.KS; bf16_t* __restrict__ VSr = p.VS; const float* __restrict__ RSr = p.ROPE_S;
#pragma unroll 4
  for (int e = tid; e < 64 * 128; e += NT) {
    const int rr = e >> 7, rem = e & 127, head = rem >> 5, half = (rem >> 4) & 1, j = rem & 15;
    const int r = r0 + rr;
    const bf16_t* __restrict__ z = Zr + (size_t)r * DIN;
    const int d1 = head * 64 + half * 32 + j, d2 = d1 + 16;
    float x1 = bf2f(z[ZQS + d1]), x2 = bf2f(z[ZQS + d2]);
    float cs = 1.f, sn = 0.f;
    if (lat) { const int t = (r - M_CTX) & 4095; const int pos = half ? (t & 63) : (t >> 6); cs = RSr[(pos * 16 + j) * 2]; sn = RSr[(pos * 16 + j) * 2 + 1]; }
    QSr[(size_t)r * 256 + d1] = f2bf((x1 * cs - x2 * sn) * 0.125f);
    QSr[(size_t)r * 256 + d2] = f2bf((x2 * cs + x1 * sn) * 0.125f);
    if (head < 2) {
      x1 = bf2f(z[ZKS + d1]); x2 = bf2f(z[ZKS + d2]);
      KSr[(size_t)r * 128 + d1] = f2bf(x1 * cs - x2 * sn);
      KSr[(size_t)r * 128 + d2] = f2bf(x2 * cs + x1 * sn);
      VSr[(size_t)r * 128 + d1] = z[ZVS + d1];
      VSr[(size_t)r * 128 + d2] = z[ZVS + d2];
    }
  }
  for (int e = tid; e < 64 * 16; e += NT) {
    const int rr = e >> 4, half = (e >> 3) & 1, j = e & 7, r = r0 + rr;
    const bf16_t* z = p.Z + (size_t)r * DIN + ZKR;
    const int d1 = half * 16 + j, d2 = d1 + 8;
    const float x1 = bf2f(z[d1]), x2 = bf2f(z[d2]);
    float cs = 1.f, sn = 0.f;
    if (lat) { const int t = (r - M_CTX) & 4095; const int pos = half ? (t & 63) : (t >> 6); cs = p.ROPE_M[(pos * 8 + j) * 2]; sn = p.ROPE_M[(pos * 8 + j) * 2 + 1]; }
    p.KR[(size_t)r * 32 + d1] = f2bf(x1 * cs - x2 * sn);
    p.KR[(size_t)r * 32 + d2] = f2bf(x2 * cs + x1 * sn);
  }
#pragma unroll
  for (int rr0 = 0; rr0 < 64; rr0 += NW) {
    const int rr = rr0 + wid;
    const int r = r0 + rr;
    const bf16_t* __restrict__ z = Zr + (size_t)r * DIN;
    {
      const float a = bf2f(z[ZKVA + lane]), b = bf2f(z[ZKVA + 64 + lane]);
      const float rs = rsqrtf(wave_sum(a * a + b * b) * (1.f / 128.f) + EPS);
      const float o0 = a * rs * p.mla_g_kv[l * 128 + lane], o1 = b * rs * p.mla_g_kv[l * 128 + 64 + lane];
      p.CKV[(size_t)r * 128 + lane] = f2bf(o0); p.CKV[(size_t)r * 128 + 64 + lane] = f2bf(o1);
      if (!lat) {
        const int b_ = r >> 8, s = r & 255;
        float* dst = p.out + O_CKV + ((size_t)(b_ * 4 + l) * 256 + s) * 128;
        dst[lane] = o0; dst[64 + lane] = o1;
      }
    }
    {
      float v[4]; float ss = 0.f;
#pragma unroll
      for (int j = 0; j < 4; ++j) { v[j] = bf2f(z[ZQA + lane + 64 * j]); ss += v[j] * v[j]; }
      const float rs = rsqrtf(wave_sum(ss) * (1.f / 256.f) + EPS);
#pragma unroll
      for (int j = 0; j < 4; ++j) p.QLAT[(size_t)r * 256 + lane + 64 * j] = f2bf(v[j] * rs * p.mla_g_q[l * 256 + lane + 64 * j]);
    }
  }
}

DI void gla_cum(const Params& p, int l, int head, int dir, int row0, int rstep, float* sa, float* qt, f32x16& cum, float& last) {
  const int tid = vtid(), dk = tid & 63, quarter = tid >> 6;
  __syncthreads();
  for (int e = tid; e < 64 * 16; e += VT) {
    const int i = e >> 4, rr = e & 15;
    sa[e] = bf2f(p.Z[(size_t)(row0 + i * rstep) * DIN + ZAF + dir * 16 + rr]);
  }
  __syncthreads();
  float wg[16];
  const float* W = p.gla_w_gate + ((size_t)(l * 2 + dir) * 16) * 256 + head * 64 + dk;
#pragma unroll
  for (int rr = 0; rr < 16; ++rr) wg[rr] = W[rr * 256];
  const float bg = p.gla_b_gate[(l * 2 + dir) * 256 + head * 64 + dk];
  float run = 0.f;
#pragma unroll
  for (int ii = 0; ii < 16; ++ii) {
    const int i = quarter * 16 + ii;
    float lg = bg;
#pragma unroll
    for (int rr = 0; rr < 16; ++rr) lg += sa[i * 16 + rr] * wg[rr];
    const float ls = fminf(lg, 0.f) - __logf(1.f + __expf(-fabsf(lg)));
    run += ls * (1.f / 16.f);
    cum[ii] = run;
  }
  qt[quarter * 64 + dk] = run;
  __syncthreads();
  float offs = 0.f, tot = 0.f;
#pragma unroll
  for (int q = 0; q < 4; ++q) { const float v = qt[q * 64 + dk]; tot += v; if (q < quarter) offs += v; }
#pragma unroll
  for (int ii = 0; ii < 16; ++ii) cum[ii] += offs;
  last = tot;
}

DI void gla_seq_info(int sq_global, int& grp, int& b, int& head, int& dir, int& S, int& base) {
  if (sq_global < 32) { grp = 1; b = sq_global >> 3; head = (sq_global >> 1) & 3; dir = sq_global & 1; S = 4096; base = M_CTX + b * 4096; }
  else { const int s = sq_global - 32; grp = 0; b = s >> 3; head = (s >> 1) & 3; dir = s & 1; S = 256; base = b * 256; }
}

DI void gla_pass_a(const Params& p, int l, int ci, unsigned char* smem) {
  float* sa = (float*)smem;
  float* qt = sa + 1024;
  bf16_t* kdT = (bf16_t*)(qt + 256);
  bf16_t* vT = kdT + 64 * PITCH;
  const int tid = vtid(), lane = tid & 63, wid = tid >> 6, dk = tid & 63, quarter = tid >> 6, l31 = lane & 31, h = lane >> 5;
  int sqg, c;
  if (ci < 2048) { sqg = ci >> 6; c = ci & 63; } else { sqg = 32 + ((ci - 2048) >> 2); c = (ci - 2048) & 3; }
  int grp, b, head, dir, S, base;
  gla_seq_info(sqg, grp, b, head, dir, S, base);
  const int row0 = dir ? base + S - 1 - 64 * c : base + 64 * c, rstep = dir ? -1 : 1;
  f32x16 kraw, vraw;
#pragma unroll
  for (int ii = 0; ii < 16; ++ii) {
    const bf16_t* __restrict__ z = p.Z + (size_t)(row0 + (quarter * 16 + ii) * rstep) * DIN;
    kraw[ii] = bf2f(z[ZKG + head * 64 + dk]);
    vraw[ii] = bf2f(z[ZVG + head * 64 + dk]);
  }
  f32x16 cum; float last;
  gla_cum(p, l, head, dir, row0, rstep, sa, qt, cum, last);
  unsigned kw[8], vw[8];
#pragma unroll
  for (int j = 0; j < 8; ++j) {
    kw[j] = pack2(kraw[2 * j] * __expf(last - cum[2 * j]), kraw[2 * j + 1] * __expf(last - cum[2 * j + 1]));
    vw[j] = pack2(vraw[2 * j], vraw[2 * j + 1]);
  }
  *(uint4*)(kdT + dk * PITCH + quarter * 16) = make_uint4(kw[0], kw[1], kw[2], kw[3]);
  *(uint4*)(kdT + dk * PITCH + quarter * 16 + 8) = make_uint4(kw[4], kw[5], kw[6], kw[7]);
  *(uint4*)(vT + dk * PITCH + quarter * 16) = make_uint4(vw[0], vw[1], vw[2], vw[3]);
  *(uint4*)(vT + dk * PITCH + quarter * 16 + 8) = make_uint4(vw[4], vw[5], vw[6], vw[7]);
  if (quarter == 0) p.GLA_DL[(size_t)ci * 64 + dk] = expf(last);
  __syncthreads();
  const int wr = wid >> 1, wc = wid & 1;
  f32x16 acc;
#pragma unroll
  for (int i = 0; i < 16; ++i) acc[i] = 0.f;
#pragma unroll
  for (int ks = 0; ks < 4; ++ks) {
    const bf16x8 a = *(const bf16x8*)(kdT + (wr * 32 + l31) * PITCH + ks * 16 + h * 8);
    const bf16x8 bb = *(const bf16x8*)(vT + (wc * 32 + l31) * PITCH + ks * 16 + h * 8);
    acc = MFMA32(a, bb, acc);
  }
  float* Bc = p.GLA_B + (size_t)ci * 4096;
#pragma unroll
  for (int i = 0; i < 16; ++i) Bc[(wr * 32 + crow(i, h)) * 64 + wc * 32 + l31] = acc[i];
}

typedef float f32x8 __attribute__((ext_vector_type(8)));
DI void gla_pass_b(const Params& p, int l, int sqg, int part) {
  const int tid = ltid(), dv = part * 16 + (tid & 15), dk0 = (tid >> 4) * 2;
  int grp, b, head, dir, S, base;
  gla_seq_info(sqg, grp, b, head, dir, S, base);
  const int nch = S >> 6;
  const int ci0 = grp ? sqg * 64 : 2048 + (sqg - 32) * 4;
  float s0v = 0.f, s1v = 0.f;
  if (grp) {
    const float* __restrict__ s0 = p.state_gla + ((((size_t)b * 4 + l) * 2 + dir) * 4 + head) * 4096;
    s0v = s0[dk0 * 64 + dv]; s1v = s0[(dk0 + 1) * 64 + dv];
  }
  const float* __restrict__ GB = p.GLA_B; const float* __restrict__ GD = p.GLA_DL; bf16_t* __restrict__ GS = p.GLA_S;
  float rb0[16], rb1[16], rd0[16], rd1[16];
#pragma unroll
  for (int q = 0; q < 16; ++q) {
    const int cq = q < nch ? q : nch - 1;
    const float* Bc = GB + (size_t)(ci0 + cq) * 4096 + dk0 * 64 + dv; const float* dl = GD + (size_t)(ci0 + cq) * 64 + dk0;
    rb0[q] = Bc[0]; rb1[q] = Bc[64]; rd0[q] = dl[0]; rd1[q] = dl[1];
  }
  for (int c0 = 0; c0 < nch; c0 += 16) {
#pragma unroll
    for (int q = 0; q < 16; ++q) {
      const int c = c0 + q;
      if (c < nch) {
        *(unsigned*)(GS + (size_t)(ci0 + c) * 4096 + dv * 64 + dk0) = pack2(s0v, s1v);
        s0v = rd0[q] * s0v + rb0[q]; s1v = rd1[q] * s1v + rb1[q];
      }
      const int cn = c + 16 < nch ? c + 16 : nch - 1;
      const float* Bc = GB + (size_t)(ci0 + cn) * 4096 + dk0 * 64 + dv; const float* dl = GD + (size_t)(ci0 + cn) * 64 + dk0;
      rb0[q] = Bc[0]; rb1[q] = Bc[64]; rd0[q] = dl[0]; rd1[q] = dl[1];
    }
  }
  if (!grp) {
    float* so = p.out + O_ST + ((((size_t)b * 4 + l) * 2 + dir) * 4 + head) * 4096;
    so[dk0 * 64 + dv] = s0v; so[(dk0 + 1) * 64 + dv] = s1v;
  }
}

DI void gla_pass_c(const Params& p, int l, int item, unsigned char* smem) {
  float* sa = (float*)smem;
  float* qt = sa + 1024;
  bf16_t* qd = (bf16_t*)(qt + 256);
  bf16_t* ki = qd + 64 * PITCH;
  bf16_t* vT = ki + 64 * PITCH;
  bf16_t* stT = vT + 64 * PITCH;
  float* osum = (float*)(stT + 64 * PITCH);
  const int tid = vtid(), lane = tid & 63, wid = tid >> 6, dk = tid & 63, quarter = tid >> 6, l31 = lane & 31, h = lane >> 5;
  int grp, b, head, c, S, base, nch;
  if (item < 1024) { grp = 1; b = item >> 8; head = (item >> 6) & 3; c = item & 63; S = 4096; base = M_CTX + b * 4096; nch = 64; }
  else { const int it = item - 1024; grp = 0; b = it >> 4; head = (it >> 2) & 3; c = it & 3; S = 256; base = b * 256; nch = 4; }
  const int wd = wid >> 1, wp = wid & 1;
  const int tk = tid >> 2, q4 = tid & 3, frow = base + 64 * c + tk;
  const u32x4 rg0 = *(const u32x4*)(p.Z + (size_t)frow * DIN + ZRG + head * 64 + q4 * 16);
  const u32x4 rg1 = *(const u32x4*)(p.Z + (size_t)frow * DIN + ZRG + head * 64 + q4 * 16 + 8);
  for (int dir = 0; dir < 2; ++dir) {
    const int cs = dir ? nch - 1 - c : c;
    const int sq = b * 8 + head * 2 + dir;
    const size_t ci = grp ? (size_t)sq * 64 + cs : 2048 + (size_t)sq * 4 + cs;
    const int row0 = dir ? base + S - 1 - 64 * cs : base + 64 * cs, rstep = dir ? -1 : 1;
    f32x16 qraw, kraw, vraw;
#pragma unroll
    for (int ii = 0; ii < 16; ++ii) {
      const bf16_t* __restrict__ z = p.Z + (size_t)(row0 + (quarter * 16 + ii) * rstep) * DIN;
      qraw[ii] = bf2f(z[ZQG + head * 64 + dk]);
      kraw[ii] = bf2f(z[ZKG + head * 64 + dk]);
      vraw[ii] = bf2f(z[ZVG + head * 64 + dk]);
    }
    u32x4 st0, st1;
    {
      const bf16_t* Sg = p.GLA_S + ci * 4096;
      st0 = *(const u32x4*)(Sg + (tid >> 3) * 64 + (tid & 7) * 8);
      st1 = *(const u32x4*)(Sg + (32 + (tid >> 3)) * 64 + (tid & 7) * 8);
    }
    f32x16 cum; float last;
    gla_cum(p, l, head, dir, row0, rstep, sa, qt, cum, last);
    unsigned vw[8];
#pragma unroll
    for (int ii = 0; ii < 16; ++ii) {
      const int i = quarter * 16 + ii;
      const float e = __expf(cum[ii]);
      qd[i * PITCH + dk] = f2bf(qraw[ii] * 0.125f * e);
      ki[i * PITCH + dk] = f2bf(kraw[ii] * __expf(-cum[ii]));
    }
#pragma unroll
    for (int j = 0; j < 8; ++j) vw[j] = pack2(vraw[2 * j], vraw[2 * j + 1]);
    *(uint4*)(vT + dk * PITCH + quarter * 16) = make_uint4(vw[0], vw[1], vw[2], vw[3]);
    *(uint4*)(vT + dk * PITCH + quarter * 16 + 8) = make_uint4(vw[4], vw[5], vw[6], vw[7]);
    *(u32x4*)(stT + (tid >> 3) * PITCH + (tid & 7) * 8) = st0;
    *(u32x4*)(stT + (32 + (tid >> 3)) * PITCH + (tid & 7) * 8) = st1;
    __syncthreads();
    f32x16 acco;
#pragma unroll
    for (int i = 0; i < 16; ++i) acco[i] = 0.f;
#pragma unroll
    for (int ks = 0; ks < 4; ++ks) {
      const bf16x8 a = *(const bf16x8*)(stT + (wd * 32 + l31) * PITCH + ks * 16 + h * 8);
      const bf16x8 bb = *(const bf16x8*)(qd + (wp * 32 + l31) * PITCH + ks * 16 + h * 8);
      acco = MFMA32(a, bb, acco);
    }
    for (int jb = 0; jb <= wp; ++jb) {
      f32x16 att;
#pragma unroll
      for (int i = 0; i < 16; ++i) att[i] = 0.f;
#pragma unroll
      for (int ks = 0; ks < 4; ++ks) {
        const bf16x8 a = *(const bf16x8*)(ki + (jb * 32 + l31) * PITCH + ks * 16 + h * 8);
        const bf16x8 bb = *(const bf16x8*)(qd + (wp * 32 + l31) * PITCH + ks * 16 + h * 8);
        att = MFMA32(a, bb, att);
      }
      const int ipos = wp * 32 + l31;
#pragma unroll
      for (int i = 0; i < 16; ++i) if (jb * 32 + crow(i, h) > ipos) att[i] = 0.f;
#pragma unroll
      for (int s = 0; s < 2; ++s) {
        union { bf16x8 v; unsigned u[4]; } pf;
#pragma unroll
        for (int j = 0; j < 4; ++j) pf.u[j] = pack2(att[8 * s + 2 * j], att[8 * s + 2 * j + 1]);
        union { bf16x8 v; bf16x4 hlf[2]; } vf;
        vf.hlf[0] = *(const bf16x4*)(vT + (wd * 32 + l31) * PITCH + jb * 32 + 16 * s + 4 * h);
        vf.hlf[1] = *(const bf16x4*)(vT + (wd * 32 + l31) * PITCH + jb * 32 + 16 * s + 8 + 4 * h);
        acco = MFMA32(vf.v, pf.v, acco);
      }
    }
    {
      const int i = wp * 32 + l31, tl = dir ? 63 - i : i;
#pragma unroll
      for (int r = 0; r < 16; ++r) {
        float* o = osum + tl * 65 + wd * 32 + crow(r, h);
        if (dir) *o += acco[r]; else *o = acco[r];
      }
    }
  }
  __syncthreads();
  {
    float v[16]; float ss = 0.f;
#pragma unroll
    for (int j = 0; j < 16; ++j) { v[j] = osum[tk * 65 + q4 * 16 + j]; ss += v[j] * v[j]; }
    ss += shx(ss, 1); ss += shx(ss, 2);
    const float rs = rsqrtf(ss * (1.f / 64.f) + EPS);
    const float* __restrict__ gp = p.gla_g_out + l * 64 + q4 * 16;
    unsigned w[8];
#pragma unroll
    for (int j = 0; j < 8; ++j) {
      const unsigned ru = j < 4 ? rg0[j & 3] : rg1[j & 3];
      const float r0 = __uint_as_float(ru << 16), r1 = __uint_as_float(ru & 0xffff0000u);
      w[j] = pack2(v[2 * j] * rs * gp[2 * j] * silu_f(r0), v[2 * j + 1] * rs * gp[2 * j + 1] * silu_f(r1));
    }
    bf16_t* dst = p.MIX + (size_t)frow * 1024 + head * 64 + q4 * 16;
    *(u32x4*)dst = (u32x4){w[0], w[1], w[2], w[3]};
    *(u32x4*)(dst + 8) = (u32x4){w[4], w[5], w[6], w[7]};
  }
}

struct AttnJob {
  const bf16_t* Q; int ldq;
  const bf16_t* K1; int ldk1;
  const bf16_t* K2; int ldk2;
  const bf16_t* V; int ldv;
  int ctx_row0, nctx;
  int loc_row0, loc_pos0, nloc;
  int qrow0, qpos0;
  int window;
  float scale; int has_sink; float sink;
  bf16_t* O; int ldo;
};
template <int DQ>
DI void attn_block(const AttnJob& jb, unsigned char* smem) {
  constexpr int NKS = DQ / 16, KP = DQ + 8, NCH = DQ / 8;
  constexpr int BUFE = 64 * KP + 64 * PITCH;
  bf16_t* sbuf = (bf16_t*)smem;
  const int tid = ltid(), lane = tid & 63, wid = tid >> 6, l31 = lane & 31, h = lane >> 5;
  const int qr = jb.qrow0 + wid * 32 + l31;
  bf16x8 qf[NKS];
#pragma unroll
  for (int ks = 0; ks < NKS; ++ks) {
    const u32x4 raw = *(const u32x4*)(jb.Q + (size_t)qr * jb.ldq + ks * 16 + h * 8);
    const float qs = jb.scale * 1.4426950408889634f;
    u32x4 sc;
#pragma unroll
    for (int j = 0; j < 4; ++j) sc[j] = pack2(__uint_as_float(raw[j] << 16) * qs, __uint_as_float(raw[j] & 0xffff0000u) * qs);
    qf[ks] = __builtin_bit_cast(bf16x8, sc);
  }
  const int qpos = jb.qpos0 + wid * 32 + l31;
  f32x16 o[2];
#pragma unroll
  for (int d = 0; d < 2; ++d)
#pragma unroll
    for (int i = 0; i < 16; ++i) o[d][i] = 0.f;
  float m = -1e30f, lsum = 0.f;
  const int nt = jb.nctx + jb.nloc;
  const int kk0 = tid / NCH, kd0 = tid % NCH;
  const bool k1v = (NCH > 8) && (tid + NT < 64 * NCH);
  const int kk1 = k1v ? (tid + NT) / NCH : 0, kd1 = k1v ? (tid + NT) % NCH : 0;
  const int vk0 = tid & 63, vd0 = tid >> 6;
  u32x4 ka0, ka1 = {0u, 0u, 0u, 0u}, va0, kb0, kb1 = {0u, 0u, 0u, 0u}, vb0, kc0, kc1 = {0u, 0u, 0u, 0u}, vc0;
#define ATT_KLD(key, dc, krow) ((dc) < 8 ? *(const u32x4*)(jb.K1 + (size_t)((krow) + (key)) * jb.ldk1 + (dc) * 8) \
                                       : *(const u32x4*)(jb.K2 + (size_t)((krow) + (key)) * jb.ldk2 + ((dc) - 8) * 8))
#define ATT_LOAD(tt, K0_, K1_, V0_) { const int tc_ = (tt) < nt ? (tt) : nt - 1; \
    const int kr_ = tc_ < jb.nctx ? jb.ctx_row0 + 64 * tc_ : jb.loc_row0 + jb.loc_pos0 + 64 * (tc_ - jb.nctx); \
    K0_ = ATT_KLD(kk0, kd0, kr_); if (k1v) K1_ = ATT_KLD(kk1, kd1, kr_); \
    V0_ = *(const u32x4*)(jb.V + (size_t)(kr_ + vk0) * jb.ldv + vd0 * 8); }
#define ATT_VST(dst, v, dc) { _Pragma("unroll") for (int j = 0; j < 4; ++j) { \
      (dst)[((dc) * 8 + 2 * j) * PITCH + vk0] = (bf16_t)((v)[j] & 0xffffu); (dst)[((dc) * 8 + 2 * j + 1) * PITCH + vk0] = (bf16_t)((v)[j] >> 16); } }
#define ATT_FILL(buf, K0_, K1_, V0_) { bf16_t* sKw = sbuf + (buf) * BUFE; bf16_t* sVw = sKw + 64 * KP; \
    *(u32x4*)(sKw + kk0 * KP + kd0 * 8) = K0_; if (k1v) *(u32x4*)(sKw + kk1 * KP + kd1 * 8) = K1_; ATT_VST(sVw, V0_, vd0); }
  ATT_LOAD(0, ka0, ka1, va0); ATT_LOAD(1, kb0, kb1, vb0); ATT_LOAD(2, kc0, kc1, vc0);
  __syncthreads();
  ATT_FILL(0, ka0, ka1, va0); ATT_LOAD(3, ka0, ka1, va0);
  ATT_FILL(1, kb0, kb1, vb0); ATT_LOAD(4, kb0, kb1, vb0);
  __syncthreads();
#define ATT_QK(dst, buf) { const bf16_t* sKq = sbuf + (buf) * BUFE; _Pragma("unroll") for (int kb = 0; kb < 2; ++kb) { \
      _Pragma("unroll") for (int i = 0; i < 16; ++i) dst[kb][i] = 0.f; \
      _Pragma("unroll") for (int ks = 0; ks < NKS; ++ks) { \
        const bf16x8 a = *(const bf16x8*)(sKq + (kb * 32 + l31) * KP + ks * 16 + h * 8); dst[kb] = MFMA32(a, qf[ks], dst[kb]); } } }
  f32x16 sn[2];
  ATT_QK(sn, 0);
  auto body = [&](const int t, const int bm, u32x4& kr0, u32x4& kr1, u32x4& vr0) __attribute__((always_inline)) {
    int kpos0; bool masked;
    if (t < jb.nctx) { kpos0 = 0; masked = false; }
    else { kpos0 = jb.loc_pos0 + 64 * (t - jb.nctx); masked = jb.window > 0; }
    ATT_FILL((bm + 2) % 3, kr0, kr1, vr0);
    ATT_LOAD(t + 5, kr0, kr1, vr0);
    const bf16_t* sVt = sbuf + bm * BUFE + 64 * KP;
    f32x16 st[2];
    st[0] = sn[0]; st[1] = sn[1];
    ATT_QK(sn, (bm + 1) % 3);
    float mx = -1e30f;
#pragma unroll
    for (int kb = 0; kb < 2; ++kb)
#pragma unroll
      for (int i = 0; i < 16; ++i) {
        float s = st[kb][i];
        if (masked) {
          const int kp = kpos0 + kb * 32 + crow(i, h);
          const int d = qpos - kp;
          if (d > jb.window || d < -jb.window) s = -1e30f;
        }
        st[kb][i] = s;
        mx = fmaxf(mx, s);
      }
    mx = fmaxf(mx, shx(mx, 32));
    const float mn = fmaxf(m, mx);
    const bool grow = __builtin_amdgcn_ballot_w64(mn > m) != 0ull;
    float ps = 0.f;
#pragma unroll
    for (int kb = 0; kb < 2; ++kb)
#pragma unroll
      for (int i = 0; i < 16; ++i) { const float pv = __builtin_amdgcn_exp2f(st[kb][i] - mn); st[kb][i] = pv; ps += pv; }
    if (grow) {
      const float alpha = __builtin_amdgcn_exp2f(m - mn);
      lsum *= alpha;
#pragma unroll
      for (int d = 0; d < 2; ++d)
#pragma unroll
        for (int i = 0; i < 16; ++i) o[d][i] *= alpha;
    }
    m = mn;
    lsum += ps;
#pragma unroll
    for (int kb = 0; kb < 2; ++kb)
#pragma unroll
      for (int s = 0; s < 2; ++s) {
        union { bf16x8 v; unsigned u[4]; } pf;
#pragma unroll
        for (int j = 0; j < 4; ++j) pf.u[j] = pack2(st[kb][8 * s + 2 * j], st[kb][8 * s + 2 * j + 1]);
#pragma unroll
        for (int d = 0; d < 2; ++d) {
          union { bf16x8 v; bf16x4 hlf[2]; } vf;
          vf.hlf[0] = *(const bf16x4*)(sVt + (d * 32 + l31) * PITCH + kb * 32 + 16 * s + 4 * h);
          vf.hlf[1] = *(const bf16x4*)(sVt + (d * 32 + l31) * PITCH + kb * 32 + 16 * s + 8 + 4 * h);
          o[d] = MFMA32(vf.v, pf.v, o[d]);
        }
      }
    __syncthreads();
  };
  for (int t = 0; t < nt; t += 3) {
    body(t, 0, kc0, kc1, vc0);
    if (t + 1 < nt) body(t + 1, 1, ka0, ka1, va0);
    if (t + 2 < nt) body(t + 2, 2, kb0, kb1, vb0);
  }
  lsum += shx(lsum, 32);
  float inv;
  if (jb.has_sink) {
    const float sk2 = jb.sink * 1.4426950408889634f;
    const float mf = fmaxf(m, sk2);
    const float corr = __builtin_amdgcn_exp2f(m - mf);
    inv = corr / (lsum * corr + __builtin_amdgcn_exp2f(sk2 - mf));
  } else inv = 1.f / lsum;
  bf16_t* orow = jb.O + (size_t)qr * jb.ldo;
#pragma unroll
  for (int d = 0; d < 2; ++d)
#pragma unroll
    for (int g = 0; g < 4; ++g) {
      uint2 w;
      w.x = pack2(o[d][4 * g] * inv, o[d][4 * g + 1] * inv);
      w.y = pack2(o[d][4 * g + 2] * inv, o[d][4 * g + 3] * inv);
      *(uint2*)(orow + d * 32 + 8 * g + 4 * h) = w;
    }
}

DI void mla_item(const Params& p, int l, int grp, int it, unsigned char* smem) {
  AttnJob j;
  int b, head, qb;
  if (grp) { b = it >> 6; head = (it >> 4) & 3; qb = it & 15; } else { b = it >> 2; head = it & 3; qb = 0; }
  const int base = grp ? M_CTX + b * 4096 : b * 256;
  j.Q = p.QM + head * 96; j.ldq = 384;
  j.K1 = p.KV + head * 128; j.ldk1 = 512; j.K2 = p.KR; j.ldk2 = 32; j.V = p.KV + head * 128 + 64; j.ldv = 512;
  j.ctx_row0 = M_TOT + b * 256; j.nctx = grp ? 4 : 0;
  j.loc_row0 = base; j.loc_pos0 = 0; j.nloc = grp ? 64 : 4;
  j.qrow0 = base + qb * 256; j.qpos0 = qb * 256; j.window = 0;
  j.scale = 0.10206207261596577f; j.has_sink = 0; j.sink = 0.f;
  j.O = p.MIX + 768 + head * 64; j.ldo = 1024;
  attn_block<96>(j, smem);
}
DI void swa_item(const Params& p, int l, int grp, int it, unsigned char* smem) {
  AttnJob j;
  int b, hq, qb;
  if (grp) { b = it >> 6; hq = (it >> 4) & 3; qb = it & 15; } else { b = it >> 2; hq = it & 3; qb = 0; }
  const int base = grp ? M_CTX + b * 4096 : b * 256;
  const int g = hq >> 1;
  j.Q = p.QS + hq * 64; j.ldq = 256;
  j.K1 = p.KS + g * 64; j.ldk1 = 128; j.K2 = p.KS; j.ldk2 = 128; j.V = p.VS + g * 64; j.ldv = 128;
  j.ctx_row0 = M_TOT + b * 256; j.nctx = grp ? 4 : 0;
  if (grp) {
    const int lo = qb > 0 ? qb * 256 - 128 : 0, hi = qb < 15 ? qb * 256 + 384 : 4096;
    j.loc_pos0 = lo; j.nloc = (hi - lo) >> 6; j.window = 128;
  } else { j.loc_pos0 = 0; j.nloc = 4; j.window = 0; }
  j.loc_row0 = base;
  j.qrow0 = base + qb * 256; j.qpos0 = qb * 256;
  j.scale = 1.0f;
  j.has_sink = 1; j.sink = p.swa_sink[l * 4 + hq];
  j.O = p.MIX + 256 + hq * 64; j.ldo = 1024;
  attn_block<64>(j, smem);
}

DI bool tile_swz(int i, int nN, int T, int& tm, int& tn) {
  const int bid = lbid(), slots = gridDim.x >> 3;
  const int L = (i * 8 + (bid & 7)) * slots + (bid >> 3);
  if (L >= T) return false;
  const int pw = 8 * nN, pnl = L / pw, rem = L - pnl * pw;
  tn = rem >> 3; tm = pnl * 8 + (rem & 7);
  return true;
}
DI void phase_gemm_gu(const Params& p, int i, unsigned char* smem) {
  Epi8GateUp epi{p.ACT};
  const bf16_t* W = p.WGU + (size_t)i * 5632 * 1024;
  int tm, tn, nm = 0, nn = 0; bool has = tile_swz(0, 22, 80 * 22, tm, tn), first = true;
  for (int i2 = 0; has; ++i2) {
    const bool hn = tile_swz(i2 + 1, 22, 80 * 22, nm, nn);
    gemm8_tile(p.H, W, 1024, tm * 256, tn * 256, smem, epi, first, hn, nm * 256, nn * 256);
    first = false; tm = nm; tn = nn; has = hn;
  }
}
DI void phase_gemm_down(const Params& p, int i, unsigned char* smem, int round) {
  Epi8Bf16 epi{(bf16_t*)p.F, 1024, 1.f, 1024};
  const bf16_t* W = p.WD + (size_t)i * 1024 * DFF;
  int tm, tn;
  if (tile_swz(round, 4, 80 * 4, tm, tn)) gemm8_tile(p.ACT, W, DFF, tm * 256, tn * 256, smem, epi);
}
DI void phase_gemm_win(const Params& p, int l, unsigned char* smem) {
  Epi8Win epi{p.Z, p.out, l};
  int tm, tn, nm = 0, nn = 0; bool has = tile_swz(0, 9, 80 * 9, tm, tn), first = true;
  for (int i2 = 0; has; ++i2) {
    const bool hn = tile_swz(i2 + 1, 9, 80 * 9, nm, nn);
    gemm8_tile(p.H, p.WIN, 1024, tm * 256, tn * 256, smem, epi, first, hn, nm * 256, nn * 256);
    first = false; tm = nm; tn = nn; has = hn;
  }
}
DI void phase_gemm_wout(const Params& p, unsigned char* smem) {
  Epi8Bf16 epi{(bf16_t*)p.F, 1024, 1.f, 1024};
  { int tm, tn; const int nit = (80 * 4 + gridDim.x - 1) / gridDim.x + 8; for (int i2 = 0; i2 < nit; ++i2) if (tile_swz(i2, 4, 80 * 4, tm, tn)) gemm8_tile(p.MIX, p.WOUT, 1024, tm * 256, tn * 256, smem, epi); }
}
DI void phase_prep(const Params& p, int l, unsigned char* smem, unsigned* ctr) {
  volatile int* s_item = (volatile int*)(smem + S_ITEM_OFF);
  for (;;) {
    __syncthreads();
    if (ltid() == 0) *s_item = (int)atomicAdd(ctr, 1u);
    __syncthreads();
    const int t = *s_item;
    if (t >= 1296) break;
    if (t < 336) prep_item(p, l, t, smem);
    else if (t < 656) {
      const int u = t - 336, g = u & 3, tm = u >> 2;
      EpiDft e{p.ABTL, p.ABTC, g};
      gemm_tile<2>(p.Z + ZF + g * 64, DIN, p.DFTW, 64, 64, tm * 256, 0, smem, e);
    } else {
      const int q0 = 2 * (t - 656);
      for (int r = 0; r < 2; ++r) gla_pass_a(p, l, 2 * (q0 + r) + vhalf(), smem + vhalf() * HALF_BYTES);
    }
  }
}
DI void fft_fold_item(const Params& p, int it) {
  const int tid = ltid(), row0 = it * 8;
  const bf16_t* __restrict__ SRC = p.ABTL; bf16_t* __restrict__ DST = p.ABTF;
#pragma unroll 2
  for (int e = tid; e < 8 * 512; e += NT) {
    const int rr = e >> 9, k0 = (e & 511) * 8;
    const bf16_t* __restrict__ src = SRC + (size_t)(row0 + rr) * 8192;
    float v[8];
#pragma unroll
    for (int j = 0; j < 8; ++j) {
      const int k = k0 + j;
      if (k0 <= 2040 || k == 2048) {
        const int km = (k == 0 || k == 2048) ? k : 4096 - k;
        const float a = bf2f(src[k]), b = bf2f(src[km]);
        v[j] = (k == 0 || k == 2048) ? a : a + b;
      } else {
        const int kk = k - 2048;
        v[j] = bf2f(src[4096 + kk]) - bf2f(src[8192 - kk]);
      }
    }
    u32x4 w; w[0] = pack2(v[0], v[1]); w[1] = pack2(v[2], v[3]); w[2] = pack2(v[4], v[5]); w[3] = pack2(v[6], v[7]);
    *(u32x4*)(DST + (size_t)(row0 + rr) * 4096 + k0) = w;
  }
}
DI void phase_qkv(const Params& p, int l, unsigned char* smem, unsigned* ctr) {
  EpiQm eq{p.QM, p.ROPE_M};
  EpiBf16 ekv{p.KV, 512, 1.f, 512};
  volatile int* s_item = (volatile int*)(smem + S_ITEM_OFF);
  for (;;) {
    __syncthreads();
    if (ltid() == 0) *s_item = (int)atomicAdd(ctr, 1u);
    __syncthreads();
    const int t = *s_item;
    if (t >= 1344) break;
    if (t < 128 || t >= 832) { const int u = t < 128 ? t : 128 + (t - 832); gla_pass_b(p, l, u >> 2, u & 3); }
    else if (t < 256) fft_fold_item(p, t - 128);
    else if (t < 496) { const int u = t - 256, tm = u / 3, tn = u % 3; gemm_tile<2>(p.QLAT, 256, p.WQB, 256, 256, tm * 256, tn * 128, smem, eq); }
    else { const int u = t - 496, tm = u >> 2, tn = u & 3; gemm_tile<2>(p.CKV, 128, p.WKVB, 128, 128, tm * 256, tn * 128, smem, ekv); }
  }
}
DI void phase_mixers(const Params& p, int l, unsigned char* smem, unsigned* ctr, unsigned long long* tc) {
  volatile int* s_item = (volatile int*)(smem + S_ITEM_OFF);
  const int x = lbid() & 7;
  for (;;) {
    __syncthreads();
    if (ltid() == 0) *s_item = (int)atomicAdd(ctr + x, 1u);
    __syncthreads();
    const int u = *s_item;
    if (u >= 172) break;
    volatile unsigned long long* tl = (volatile unsigned long long*)(smem + S_ITEM_OFF + 16);
    if (PROBE_SPIN >= 9 && ltid() == 0) tl[0] = __builtin_amdgcn_s_memrealtime();
    if (u < 8) {
      const int tm = x + 8 * (u >> 2), b = u & 3;
      Epi8Bf16 e{p.MIX + (size_t)(M_CTX + b * 4096) * 1024 + 512, 1024, 1.f / 512.f, 256};
      gemm8_tile(p.TWL, p.ABTF + (size_t)b * 256 * 4096, 4096, tm * 256, 0, smem, e);
    } else if (u < 40) { const int v = u - 8; mla_item(p, l, 1, (x + 8 * (v >> 4)) * 16 + (v & 15), smem); }
    else if (u < 72) { const int v = u - 40; swa_item(p, l, 1, (x + 8 * (v >> 4)) * 16 + (v & 15), smem); }
    else if (u < 136) gla_pass_c(p, l, 2 * (x * 64 + (u - 72)) + vhalf(), smem + vhalf() * HALF_BYTES);
    else if (u < 144) mla_item(p, l, 0, x * 8 + (u - 136), smem);
    else if (u < 152) swa_item(p, l, 0, x * 8 + (u - 144), smem);
    else if (u < 156) {
      const int w = x * 4 + (u - 152), b = w >> 1, tn = w & 1;
      EpiBf16 e{p.MIX + (size_t)(b * 256) * 1024 + 512, 1024, 1.f / 128.f, 256};
      gemm_tile<2>(p.TWC, 512, p.ABTC + (size_t)b * 256 * 512, 512, 512, 0, tn * 128, smem, e);
    } else gla_pass_c(p, l, 1024 + 2 * (x * 16 + (u - 156)) + vhalf(), smem + vhalf() * HALF_BYTES);
    if (PROBE_SPIN >= 9 && ltid() == 0) { const int cat = u < 8 ? 11 : u < 40 ? 9 : u < 72 ? 12 : u < 136 ? 10 : 13; if (cat == PROBE_SPIN) tl[1] += __builtin_amdgcn_s_memrealtime() - tl[0]; }
  }
}

#ifndef PROBE_DBL
#define PROBE_DBL 0
#endif
#define DBL(bit) (((PROBE_DBL) >> (bit)) & 1)
#ifndef ONLY_J
#define ONLY_J -1
#endif
#define EN(x) (ONLY_J < 0 || ONLY_J == (x))
constexpr int PPL = 14, N_PHASES = 2 + 4 * PPL;
constexpr int R_SPLIT = 16384;
#define MKP KP4 kq = kp; asm volatile("" : "+s"(kq)); const Params p = make_params(kq)
DI EwArgs ew_args(const Params& p, int kind, int l, int r_lo, int r_hi, int vb, int nvb) {
  float* Xc = p.X; float* Xl = Xc + (size_t)M_CTX * DM;
  EwArgs a{};
  a.r_lo = r_lo; a.r_hi = r_hi; a.vb = vb; a.nvb = nvb;
  a.xin_ctx = Xc; a.xin_lat = Xl; a.xout_ctx = Xc; a.xout_lat = Xl; a.in_f32 = 1; a.out_f32 = 1; a.F = p.F;
  if (kind == 0) { a.xin_ctx = p.x_prompt; a.xin_lat = p.x_sample; a.in_f32 = 1; a.F = nullptr; a.do_norm = 1; a.ln = 0; a.sc_idx = 1; a.sh_idx = 0; a.gpre_idx = 0; }
  else if (kind == 1) { if (l == 0) { a.xin_ctx = p.x_prompt; a.xin_lat = p.x_sample; a.in_f32 = 1; } a.lu = l; a.gate_idx = 2; a.gpost_idx = 1; a.res_w = 0.5f; a.do_norm = 1; a.ln = l; a.sc_idx = 4; a.sh_idx = 3; a.gpre_idx = 2; }
  else if (kind == 2) { a.lu = l; a.gate_idx = 5; a.gpost_idx = 3; a.res_w = 1.0f; a.do_norm = 1; a.ln = l; a.sc_idx = 7; a.sh_idx = 6; a.gpre_idx = 4; }
  else { a.lu = l; a.gate_idx = 8; a.gpost_idx = 5; a.res_w = 0.5f;
    if (l < 3) { a.do_norm = 1; a.ln = l + 1; a.sc_idx = 1; a.sh_idx = 0; a.gpre_idx = 0; }
    else { a.do_norm = 0; a.out_f32 = 1; a.xout_ctx = p.out + O_YP; a.xout_lat = p.out + O_YS; } }
  return a;
}
DI void run_phase(KP4 kp, int ph, unsigned char* smem, unsigned long long* tc) {
  MKP;
  if (ph == 0) { phase_init(p, smem); return; }
  const int bid = lbid(), nb = gridDim.x;
  const bool g2 = (bid & 7) < 2;
  const int vb2 = (bid >> 3) * 6 + ((bid & 7) - 2), nvb2 = (nb >> 3) * 6;
  int ew_kind = -1, ew_l = 0, ew_lo = 0, ew_hi = M_TOT, ew_vb = bid, ew_nvb = nb;
  if (ph == N_PHASES - 1) { ew_kind = 3; ew_l = 3; ew_lo = R_SPLIT; }
  else {
    const int l = (ph - 1) / PPL, j = (ph - 1) % PPL;
    switch (j) {
      case 0: convert_layer(p, l, smem);
        if (l == 0) { ew_kind = 0; } else { ew_kind = 3; ew_l = l - 1; ew_lo = R_SPLIT; } break;
      case 1: case 11: phase_gemm_gu(p, j == 11 ? 1 : 0, smem); break;
      case 2: case 3: case 12: case 13: {
        const int i = j >= 12 ? 1 : 0, round = j & 1;
        if (round == 0 || g2) phase_gemm_down(p, i, smem, round);
        else { ew_kind = i ? 3 : 1; ew_l = l; ew_hi = R_SPLIT; ew_vb = vb2; ew_nvb = nvb2; }
      } break;
      case 4: ew_kind = 1; ew_l = l; ew_lo = R_SPLIT; break;
      case 5: phase_gemm_win(p, l, smem); break;
      case 6: phase_prep(p, l, smem, (unsigned*)(GAS unsigned*)(kq->ws + OFF_BAR) + 3610 + l); break;
      case 7: phase_qkv(p, l, smem, (unsigned*)(GAS unsigned*)(kq->ws + OFF_BAR) + 3670 + l); break;
      case 8: phase_mixers(p, l, smem, (unsigned*)(GAS unsigned*)(kq->ws + OFF_BAR) + 3620 + l * 8, tc); break;
      case 9: phase_gemm_wout(p, smem); break;
      case 10: ew_kind = 2; ew_l = l; break;
    }
  }
  if (ew_kind >= 0) { const EwArgs a = ew_args(p, ew_kind, ew_l, ew_lo, ew_hi, ew_vb, ew_nvb); phase_ew(p, a); }
}

__global__ void __launch_bounds__(NT, 2) fwd_kernel(PArg pa, int ph_lo, int ph_hi) {
  extern __shared__ __attribute__((aligned(16))) unsigned char smem[];
  KP4 kp = (KP4)__builtin_amdgcn_kernarg_segment_ptr();
#if MULTI_LAUNCH
  unsigned long long tdummy = 0; for (int ph = ph_lo; ph < ph_hi; ++ph) run_phase(kp, ph, smem, &tdummy);
#else
  cg::grid_group grid = cg::this_grid();
  __shared__ uint4 xb_words;
  if (ltid() == 0) { xb_words = make_uint4(0u, 0u, 0u, 0u); if (PROBE_SPIN >= 9) ((volatile unsigned long long*)(smem + S_ITEM_OFF + 16))[1] = 0ull; }
  __syncthreads();
  const XcdBarrier xb = xcd_barrier_post((unsigned*)(pa.ws + OFF_BAR), (volatile LAS unsigned*)&xb_words);
#ifndef PROBE_SPIN
#define PROBE_SPIN 0
#endif
  unsigned long long tacc = 0;
  for (int ph = ph_lo; ph < ph_hi; ++ph) {
    const unsigned long long t0 = PROBE_SPIN ? __builtin_amdgcn_s_memrealtime() : 0ull;
    run_phase(kp, ph, smem, &tacc);
    if (ph + 1 < ph_hi) { if (ph == ph_lo) grid.sync(); else xcd_barrier(xb); }
    if (PROBE_SPIN) {
      const int j = (ph - 1) % PPL;
      const bool lay = ph >= 1 && ph < N_PHASES - 1;
      bool hit = false;
      if (PROBE_SPIN == 1) hit = lay && (j == 1 || j == 11);
      if (PROBE_SPIN == 2) hit = lay && (j == 2 || j == 3 || j == 12 || j == 13);
      if (PROBE_SPIN == 3) hit = ph == 0;
      if (PROBE_SPIN == 4) hit = lay && j == 6;
      if (PROBE_SPIN == 5) hit = lay && j == 8;
      if (PROBE_SPIN == 6) hit = lay && j == 7;
      if (PROBE_SPIN == 7) hit = lay && (j == 5 || j == 9);
      if (PROBE_SPIN == 8) hit = (lay && (j == 0 || j == 4 || j == 10)) || ph == N_PHASES - 1;
      if (hit) tacc += __builtin_amdgcn_s_memrealtime() - t0;
    }
  }
  if (PROBE_SPIN && blockIdx.x == 0 && threadIdx.x == 0) {
    if (PROBE_SPIN >= 9) tacc = ((volatile unsigned long long*)(smem + S_ITEM_OFF + 16))[1];
    const unsigned long long te = __builtin_amdgcn_s_memrealtime();
    while (__builtin_amdgcn_s_memrealtime() - te < tacc * 4ull) __builtin_amdgcn_s_sleep(8);
  }
#endif
}

extern "C" void kernel_launch(void* const* d_in, const int* in_sizes, int n_in, void* d_out, int out_size, void* d_ws, size_t ws_size,
                              hipStream_t stream) {
  PArg p{};
  for (int i = 0; i < 25; ++i) p.in[i] = (const float*)d_in[i];
  p.out = (float*)d_out;
  p.ws = (unsigned char*)d_ws;
  if (WS_NEED > ws_size) { fprintf(stderr, "workspace too small: need %zu have %zu\n", (size_t)WS_NEED, ws_size); return; }
#if MULTI_LAUNCH
  for (int ph = 0; ph < N_PHASES; ++ph) hipLaunchKernelGGL(fwd_kernel, dim3(256), dim3(NT), LDS_TOTAL, stream, p, ph, ph + 1);
#else
  static int grid_blocks = 0;
  if (!grid_blocks) {
    int dev = 0, cus = 0, per_cu = 0;
    (void)hipGetDevice(&dev);
    (void)hipDeviceGetAttribute(&cus, hipDeviceAttributeMultiprocessorCount, dev);
    if (hipFuncSetAttribute((const void*)fwd_kernel, hipFuncAttributeMaxDynamicSharedMemorySize, LDS_TOTAL) != hipSuccess) { fprintf(stderr, "hipFuncSetAttribute failed\n"); grid_blocks = -1; return; }
    (void)hipOccupancyMaxActiveBlocksPerMultiprocessor(&per_cu, fwd_kernel, NT, LDS_TOTAL);
    if (per_cu < 1) fprintf(stderr, "note: occupancy query reports %d blocks per CU\n", per_cu);
    (void)hipGetLastError();
    grid_blocks = cus;
  }
  if (grid_blocks < 0) return;
  (void)hipMemsetAsync((unsigned char*)d_ws + OFF_BAR, 0, 16384, stream);
  int lo = 0, hi = N_PHASES;
  void* args[] = {&p, &lo, &hi};
  hipError_t e = hipLaunchCooperativeKernel((void*)fwd_kernel, dim3(grid_blocks), dim3(NT), args, LDS_TOTAL, stream);
  if (e != hipSuccess) fprintf(stderr, "cooperative launch failed: %s (grid %d)\n", hipGetErrorString(e), grid_blocks);
#endif
}
```
